# Optimizing an MI355X kernel written in HIP

```python
import math
import numpy as np
import jax
import jax.numpy as jnp
from jax import lax

D_MODEL = 1024
BATCH = 4
SEQ = 8192
DEPTH = 4

GRID_W = 64
CTX_LEN = 256
N_MIXERS = 3
N_LAYERS_A = (DEPTH + 2) // N_MIXERS
N_LAYERS_B = (DEPTH + 1) // N_MIXERS
N_LAYERS_C = DEPTH // N_MIXERS

HEAD_DIM = 64
NORM_EPS = 1e-6
A_Q_HEADS = D_MODEL // HEAD_DIM
A_KV_HEADS = A_Q_HEADS // 4
A_WINDOW = 128
A_BLOCK = 128
ROPE_BASE = 10000.0
HY_WIDTH = D_MODEL
HY_ORDER = 2
HY_EMB_DIM = 33
HY_FILTER_DIM = 64
HY_SHORT = 3
HY_FAST_DECAY = 0.3
HY_SLOW_DECAY = 1.5
HY_TARGET = 1e-2
C_HEADS = D_MODEL // HEAD_DIM
NA_ROWS = 8
NA_COLS = 16
N_EXPERTS = 16
EC_CAPACITY = 2
EXPERT_FF = 2 * D_MODEL
F32 = jnp.float32

kernel_name = 'hybrid_diffusion_trunk'


def rms_norm(x, g):
    x32 = x.astype(F32)
    y = x32 * lax.rsqrt(jnp.mean(x32 * x32, axis=-1, keepdims=True) + NORM_EPS)
    return y.astype(x.dtype) * g.astype(x.dtype)


def modulate(x, g, shift, scale):
    return rms_norm(x, g) * (1 + scale) + shift


def axial_rope_tables(n_tok):
    t = jnp.arange(n_tok)
    row = (t // GRID_W).astype(F32)
    col = (t % GRID_W).astype(F32)
    axis_dim = HEAD_DIM // 2
    inv_freq = 1.0 / (ROPE_BASE ** (jnp.arange(0, axis_dim, 2, dtype=F32) / axis_dim))
    ang = jnp.concatenate([row[:, None] * inv_freq, col[:, None] * inv_freq], axis=-1)
    return jnp.cos(ang), jnp.sin(ang)


def _rotate(x, cos, sin):
    m = x.shape[-1] // 2
    x1, x2 = x[..., :m], x[..., m:]
    return jnp.concatenate([x1 * cos - x2 * sin, x2 * cos + x1 * sin], axis=-1)


def apply_axial_rope(x, cos, sin):
    axis_dim = HEAD_DIM // 2
    m = axis_dim // 2
    cos = cos[None, :, None, :].astype(x.dtype)
    sin = sin[None, :, None, :].astype(x.dtype)
    return jnp.concatenate([
        _rotate(x[..., :axis_dim], cos[..., :m], sin[..., :m]),
        _rotate(x[..., axis_dim:], cos[..., m:], sin[..., m:])], axis=-1)


def mixer_window_gqa(u, uc, w_in, w_out, q_g, k_g, sink, need_ctx):
    b, n, _ = u.shape
    n_ctx = uc.shape[1]
    hkv, grp, dh = A_KV_HEADS, A_Q_HEADS // A_KV_HEADS, HEAD_DIM
    qw, kvw = A_Q_HEADS * dh, A_KV_HEADS * dh
    scale = dh ** -0.5
    p = u @ w_in
    q = rms_norm(p[..., :qw].reshape(b, n, A_Q_HEADS, dh), q_g)
    k = rms_norm(p[..., qw:qw + kvw].reshape(b, n, hkv, dh), k_g)
    v = p[..., qw + kvw:].reshape(b, n, hkv, dh)
    kc = rms_norm((uc @ w_in[:, qw:qw + kvw]).reshape(b, n_ctx, hkv, dh), k_g)
    vc = (uc @ w_in[:, qw + kvw:]).reshape(b, n_ctx, hkv, dh)
    cos, sin = axial_rope_tables(n)
    q_rot = apply_axial_rope(q, cos, sin)
    k_rot = apply_axial_rope(k, cos, sin)
    nb = n // A_BLOCK
    span = 3 * A_BLOCK

    def to_blocks(t):
        return t.reshape(b, nb, A_BLOCK, hkv, grp, dh).transpose(1, 0, 2, 3, 4, 5)

    pad = ((0, 0), (A_BLOCK, A_BLOCK), (0, 0), (0, 0))
    k_pad = jnp.pad(k_rot, pad)
    v_pad = jnp.pad(v, pad)
    rel = np.arange(A_BLOCK)[:, None] - (np.arange(span)[None, :] - A_BLOCK)
    band = np.abs(rel) <= A_WINDOW
    sink_hg = sink.astype(F32).reshape(hkv, grp)

    def block(args):
        qb, qb_plain, i = args
        start = i * A_BLOCK
        kw = lax.dynamic_slice_in_dim(k_pad, start, span, axis=1)
        vw = lax.dynamic_slice_in_dim(v_pad, start, span, axis=1)
        key_pos = start - A_BLOCK + jnp.arange(span)
        valid = jnp.asarray(band) & ((key_pos >= 0) & (key_pos < n))[None, :]
        s_loc = jnp.einsum('bqhgd,bkhd->bhgqk', qb, kw).astype(F32) * scale
        s_loc = jnp.where(valid, s_loc, -jnp.inf)
        s_ctx = jnp.einsum('bqhgd,bkhd->bhgqk', qb_plain, kc).astype(F32) * scale
        s_sink = jnp.broadcast_to(sink_hg[None, :, :, None, None], s_loc.shape[:-1] + (1,))
        prob = jax.nn.softmax(jnp.concatenate([s_loc, s_ctx, s_sink], axis=-1), axis=-1)
        p_loc = prob[..., :span].astype(v.dtype)
        p_ctx = prob[..., span:span + n_ctx].astype(v.dtype)
        return (jnp.einsum('bhgqk,bkhd->bqhgd', p_loc, vw)
                + jnp.einsum('bhgqk,bkhd->bqhgd', p_ctx, vc))

    o = lax.map(block, (to_blocks(q_rot), to_blocks(q), jnp.arange(nb)))
    y = o.transpose(1, 0, 2, 3, 4, 5).reshape(b, n, qw) @ w_out
    yc = None
    if need_ctx:
        qc = rms_norm((uc @ w_in[:, :qw]).reshape(b, n_ctx, hkv, grp, dh), q_g)
        s = jnp.einsum('bqhgd,bkhd->bhgqk', qc, kc).astype(F32) * scale
        s_sink = jnp.broadcast_to(sink_hg[None, :, :, None, None], s.shape[:-1] + (1,))
        prob = jax.nn.softmax(jnp.concatenate([s, s_sink], axis=-1), axis=-1)[..., :n_ctx]
        oc = jnp.einsum('bhgqk,bkhd->bqhgd', prob.astype(vc.dtype), vc)
        yc = oc.reshape(b, n_ctx, qw) @ w_out
    return y, yc


def hyena_filters(n, w1, b1, f1, w2, b2, f2, w3):
    t = jnp.linspace(0.0, 1.0, n, dtype=F32)[:, None]
    bands = (HY_EMB_DIM - 1) // 2
    w = 2.0 * math.pi * jnp.arange(n, dtype=F32)[:, None] / n
    f = jnp.linspace(1e-4, bands - 1, bands, dtype=F32)[None, :]
    z = jnp.concatenate([t, jnp.cos(f * w), -jnp.sin(f * w)], axis=-1)
    h = jnp.sin(f1.astype(F32) * (z @ w1.astype(F32) + b1.astype(F32)))
    h = jnp.sin(f2.astype(F32) * (h @ w2.astype(F32) + b2.astype(F32)))
    h = h @ w3.astype(F32)
    max_decay = math.log(HY_TARGET) / HY_FAST_DECAY
    min_decay = math.log(HY_TARGET) / HY_SLOW_DECAY
    deltas = jnp.linspace(min_decay, max_decay, HY_WIDTH, dtype=F32)
    decay = jnp.exp(-t * jnp.abs(deltas)[None, :])
    return h.reshape(n, HY_ORDER, 2, HY_WIDTH) * decay[:, None, None, :]


def two_sided_filter(h_fwd, h_bwd):
    n, d = h_fwd.shape
    k = jnp.concatenate([h_fwd, jnp.zeros((1, d), F32), h_bwd[1:][::-1]], axis=0)
    return k * lax.rsqrt(jnp.sum(k * k, axis=0, keepdims=True) + NORM_EPS)


def long_conv(z, k, bias):
    n = z.shape[1]
    z32 = z.astype(F32)
    zf = jnp.fft.rfft(z32, n=2 * n, axis=1)
    kf = jnp.fft.rfft(k, n=2 * n, axis=0)
    y = jnp.fft.irfft(zf * kf[None], n=2 * n, axis=1)[:, :n]
    return (y + z32 * bias.astype(F32)).astype(z.dtype)


def hyena_sequence(u, w_in, short_w, short_b, w1, b1, f1, w2, b2, f2, w3, fbias, w_out):
    n = u.shape[1]
    p = u @ w_in
    half = HY_SHORT // 2
    pp = jnp.pad(p, ((0, 0), (half, half), (0, 0)))
    p = sum(pp[:, j:j + n] * short_w[j] for j in range(HY_SHORT)) + short_b
    v, x1, x2 = jnp.split(p, 3, axis=-1)
    filt = hyena_filters(n, w1, b1, f1, w2, b2, f2, w3)
    z = v
    for o, gate in enumerate((x1, x2)):
        k = two_sided_filter(filt[:, o, 0], filt[:, o, 1])
        z = gate * long_conv(z, k, fbias[o])
    return z @ w_out


def mixer_hyena(u, uc, w_in, short_w, short_b, w1, b1, f1, w2, b2, f2, w3, fbias, w_out, need_ctx):
    y = hyena_sequence(u, w_in, short_w, short_b, w1, b1, f1, w2, b2, f2, w3, fbias, w_out)
    yc = None
    if need_ctx:
        yc = hyena_sequence(uc, w_in, short_w, short_b, w1, b1, f1, w2, b2, f2, w3, fbias, w_out)
    return y, yc


def mixer_neighbourhood(u, uc, w_in, w_out, q_g, k_g, rpb, need_ctx):
    b, n, _ = u.shape
    n_ctx = uc.shape[1]
    nh, dh = C_HEADS, HEAD_DIM
    hw = nh * dh
    scale = dh ** -0.5
    rows = n // GRID_W
    kr = min(NA_ROWS, rows)
    kc_n = NA_COLS
    p = u @ w_in
    q = rms_norm(p[..., :hw].reshape(b, rows, GRID_W, nh, dh), q_g)
    k = rms_norm(p[..., hw:2 * hw].reshape(b, rows, GRID_W, nh, dh), k_g)
    v = p[..., 2 * hw:].reshape(b, rows, GRID_W, nh, dh)
    ck = rms_norm((uc @ w_in[:, hw:2 * hw]).reshape(b, n_ctx, nh, dh), k_g)
    cv = (uc @ w_in[:, 2 * hw:]).reshape(b, n_ctx, nh, dh)
    col = np.arange(GRID_W)
    col_start = np.clip(col - kc_n // 2, 0, GRID_W - kc_n)
    col_idx = col_start[:, None] + np.arange(kc_n)[None, :]
    col_off = col_idx - col[:, None] + (NA_COLS - 1)
    n_loc = kr * kc_n

    def row_block(args):
        qr, r = args
        r0 = jnp.clip(r - kr // 2, 0, rows - kr)
        k_win = lax.dynamic_slice_in_dim(k, r0, kr, axis=1)[:, :, col_idx]
        v_win = lax.dynamic_slice_in_dim(v, r0, kr, axis=1)[:, :, col_idx]
        row_off = r0 + jnp.arange(kr) - r + (NA_ROWS - 1)
        bias = rpb[:, row_off[:, None, None], col_off[None, :, :]].astype(F32)
        s_loc = (jnp.einsum('bwhd,brwchd->bhwrc', qr, k_win).astype(F32) * scale
                 + bias.transpose(0, 2, 1, 3)[None])
        s_ctx = jnp.einsum('bwhd,bkhd->bhwk', qr, ck).astype(F32) * scale
        prob = jax.nn.softmax(jnp.concatenate([s_loc.reshape(b, nh, GRID_W, n_loc), s_ctx], axis=-1), axis=-1)
        p_loc = prob[..., :n_loc].reshape(b, nh, GRID_W, kr, kc_n).astype(v.dtype)
        p_ctx = prob[..., n_loc:].astype(v.dtype)
        return (jnp.einsum('bhwrc,brwchd->bwhd', p_loc, v_win)
                + jnp.einsum('bhwk,bkhd->bwhd', p_ctx, cv))

    o = lax.map(row_block, (q.transpose(1, 0, 2, 3, 4), jnp.arange(rows)))
    y = o.transpose(1, 0, 2, 3, 4).reshape(b, n, hw) @ w_out
    yc = None
    if need_ctx:
        qc = rms_norm((uc @ w_in[:, :hw]).reshape(b, n_ctx, nh, dh), q_g)
        s = jnp.einsum('bqhd,bkhd->bhqk', qc, ck).astype(F32) * scale
        prob = jax.nn.softmax(s, axis=-1)
        oc = jnp.einsum('bhqk,bkhd->bqhd', prob.astype(cv.dtype), cv)
        yc = oc.reshape(b, n_ctx, hw) @ w_out
    return y, yc


def expert_choice_ffn(u, router_w, w_gate, w_up, w_down):
    n, d = u.shape[1], u.shape[2]
    cap = EC_CAPACITY * n // N_EXPERTS
    aff = jax.nn.softmax((u @ router_w).astype(F32), axis=-1)

    def one_set(args):
        ub, ab = args
        g, idx = lax.top_k(ab.T, cap)
        xs = ub[idx]
        hid = (jax.nn.silu(jnp.einsum('ecd,edf->ecf', xs, w_gate))
               * jnp.einsum('ecd,edf->ecf', xs, w_up))
        ye = jnp.einsum('ecf,efd->ecd', hid, w_down) * g[..., None].astype(ub.dtype)
        return jnp.zeros_like(ub).at[idx.reshape(-1)].add(ye.reshape(-1, d))

    return lax.map(one_set, (u, aff))


def setup_inputs(seed: int = 0) -> dict:
    key = jax.random.key(seed)
    ks = jax.random.split(key, 34)

    def nrm(i, shape, s):
        return jax.random.normal(ks[i], shape, F32) * s

    d = D_MODEL
    qkv_a = (A_Q_HEADS + 2 * A_KV_HEADS) * HEAD_DIM
    qw_a = A_Q_HEADS * HEAD_DIM
    hw_c = C_HEADS * HEAD_DIM
    return {
        'x': nrm(0, (BATCH, SEQ, d), 1.0),
        'c': nrm(1, (BATCH, d), 1.0),
        'ctx': nrm(2, (BATCH, CTX_LEN, d), 1.0),
        'c_ctx': nrm(3, (d,), 1.0),
        'ada_w': nrm(4, (DEPTH, d, 6 * d), 0.5 * d ** -0.5),
        'ada_b': nrm(5, (DEPTH, 6 * d), 0.02),
        'norm_mix_g': 1.0 + nrm(6, (DEPTH, d), 0.05),
        'norm_ffn_g': 1.0 + nrm(7, (DEPTH, d), 0.05),
        'router_w': nrm(8, (DEPTH, d, N_EXPERTS), d ** -0.5),
        'exp_w_gate': nrm(9, (DEPTH, N_EXPERTS, d, EXPERT_FF), d ** -0.5),
        'exp_w_up': nrm(10, (DEPTH, N_EXPERTS, d, EXPERT_FF), d ** -0.5),
        'exp_w_down': nrm(11, (DEPTH, N_EXPERTS, EXPERT_FF, d), EXPERT_FF ** -0.5),
        'a_w_in': nrm(12, (N_LAYERS_A, d, qkv_a), d ** -0.5),
        'a_w_out': nrm(13, (N_LAYERS_A, qw_a, d), qw_a ** -0.5),
        'a_q_g': 1.0 + nrm(14, (N_LAYERS_A, HEAD_DIM), 0.05),
        'a_k_g': 1.0 + nrm(15, (N_LAYERS_A, HEAD_DIM), 0.05),
        'a_sink': nrm(16, (N_LAYERS_A, A_Q_HEADS), 0.5),
        'b_w_in': nrm(17, (N_LAYERS_B, d, 3 * HY_WIDTH), d ** -0.5),
        'b_short_w': nrm(18, (N_LAYERS_B, HY_SHORT, 3 * HY_WIDTH), HY_SHORT ** -0.5),
        'b_short_b': nrm(19, (N_LAYERS_B, 3 * HY_WIDTH), 0.02),
        'b_w1': nrm(20, (N_LAYERS_B, HY_EMB_DIM, HY_FILTER_DIM), HY_EMB_DIM ** -0.5),
        'b_b1': nrm(21, (N_LAYERS_B, HY_FILTER_DIM), 0.1),
        'b_f1': 1.0 + nrm(22, (N_LAYERS_B, HY_FILTER_DIM), 0.1),
        'b_w2': nrm(23, (N_LAYERS_B, HY_FILTER_DIM, HY_FILTER_DIM), HY_FILTER_DIM ** -0.5),
        'b_b2': nrm(24, (N_LAYERS_B, HY_FILTER_DIM), 0.1),
        'b_f2': 1.0 + nrm(25, (N_LAYERS_B, HY_FILTER_DIM), 0.1),
        'b_w3': nrm(26, (N_LAYERS_B, HY_FILTER_DIM, HY_ORDER * 2 * HY_WIDTH), HY_FILTER_DIM ** -0.5),
        'b_bias': nrm(27, (N_LAYERS_B, HY_ORDER, HY_WIDTH), 0.5),
        'b_w_out': nrm(28, (N_LAYERS_B, HY_WIDTH, d), HY_WIDTH ** -0.5),
        'c_w_in': nrm(29, (N_LAYERS_C, d, 3 * hw_c), d ** -0.5),
        'c_w_out': nrm(30, (N_LAYERS_C, hw_c, d), hw_c ** -0.5),
        'c_q_g': 1.0 + nrm(31, (N_LAYERS_C, HEAD_DIM), 0.05),
        'c_k_g': 1.0 + nrm(32, (N_LAYERS_C, HEAD_DIM), 0.05),
        'c_rpb': nrm(33, (N_LAYERS_C, C_HEADS, 2 * NA_ROWS - 1, 2 * NA_COLS - 1), 0.5),
    }


def reference(x, c, ctx, c_ctx, ada_w, ada_b, norm_mix_g, norm_ffn_g, router_w, exp_w_gate, exp_w_up,
              exp_w_down, a_w_in, a_w_out, a_q_g, a_k_g, a_sink, b_w_in, b_short_w, b_short_b, b_w1, b_b1,
              b_f1, b_w2, b_b2, b_f2, b_w3, b_bias, b_w_out, c_w_in, c_w_out, c_q_g, c_k_g, c_rpb):
    h, hc = x, ctx
    silu_c = jax.nn.silu(c)
    silu_cc = jax.nn.silu(c_ctx)
    for i in range(DEPTH):
        last = i == DEPTH - 1
        mod = silu_c @ ada_w[i] + ada_b[i]
        modc = silu_cc @ ada_w[i] + ada_b[i]
        sh1, sc1, g1, sh2, sc2, g2 = jnp.split(mod[:, None, :], 6, axis=-1)
        csh1, csc1, cg1, csh2, csc2, cg2 = jnp.split(modc, 6, axis=-1)
        u = modulate(h, norm_mix_g[i], sh1, sc1)
        uc = modulate(hc, norm_mix_g[i], csh1, csc1)
        kind, j = i % N_MIXERS, i // N_MIXERS
        if kind == 0:
            y, yc = mixer_window_gqa(u, uc, a_w_in[j], a_w_out[j], a_q_g[j], a_k_g[j], a_sink[j], not last)
        elif kind == 1:
            y, yc = mixer_hyena(u, uc, b_w_in[j], b_short_w[j], b_short_b[j], b_w1[j], b_b1[j], b_f1[j],
                                b_w2[j], b_b2[j], b_f2[j], b_w3[j], b_bias[j], b_w_out[j], not last)
        else:
            y, yc = mixer_neighbourhood(u, uc, c_w_in[j], c_w_out[j], c_q_g[j], c_k_g[j], c_rpb[j], not last)
        h = h + g1 * y
        u2 = modulate(h, norm_ffn_g[i], sh2, sc2)
        h = h + g2 * expert_choice_ffn(u2, router_w[i], exp_w_gate[i], exp_w_up[i], exp_w_down[i])
        if not last:
            hc = hc + cg1 * yc
            uc2 = modulate(hc, norm_ffn_g[i], csh2, csc2)
            hc = hc + cg2 * expert_choice_ffn(uc2, router_w[i], exp_w_gate[i], exp_w_up[i], exp_w_down[i])
    return h
```

```cpp
#include <hip/hip_runtime.h>
#include <cstdio>
#include <cstdint>

#ifndef ONE_LAUNCH
#define ONE_LAUNCH 1
#endif

#define LAS __attribute__((address_space(3)))
#define GAS __attribute__((address_space(1)))
typedef _Float16 f16;
typedef _Float16 f16x8 __attribute__((ext_vector_type(8)));
typedef _Float16 f16x4 __attribute__((ext_vector_type(4)));
typedef _Float16 f16x2 __attribute__((ext_vector_type(2)));
typedef short v4i16 __attribute__((ext_vector_type(4)));
typedef float f32x4 __attribute__((ext_vector_type(4)));
typedef float f32x2 __attribute__((ext_vector_type(2)));
typedef unsigned u32x4 __attribute__((ext_vector_type(4)));
typedef unsigned u32x2 __attribute__((ext_vector_type(2)));
typedef int v4i32 __attribute__((ext_vector_type(4)));
typedef int v8i32 __attribute__((ext_vector_type(8)));

constexpr int D = 1024, NB = 4, T = 8192, NCX = 256, DEPTH = 4;
constexpr int RL = NB * T, RC = NB * NCX, R = RL + RC;
constexpr int NE = 16, CAPL = 1024, CAPC = 32, FF = 2048, EROWS = 4352, ETILES = 17;
constexpr float NORM_EPS = 1e-6f;
constexpr float LOG2E = 1.4426950408889634f;
constexpr float QSCALE = 0.125f * LOG2E;
constexpr float ZSCALE = 1.0f / 64.0f, ZUNSCALE = 64.0f;

constexpr size_t MiB = 1u << 20;
constexpr size_t WS_CTL = 0, CTL_ZERO_BYTES = 64 * 1024;
constexpr size_t WS_MOD = 1 * MiB;
constexpr size_t WS_ROPE = WS_MOD + 512 * 1024;
constexpr size_t WS_H2L = 2 * MiB;
constexpr size_t WS_H2C = 4 * MiB;
constexpr size_t WS_HC = 5 * MiB;
constexpr size_t WS_AFFL = 9 * MiB;
constexpr size_t WS_AFFC = 11 * MiB;
constexpr size_t WS_INV = 12 * MiB;
constexpr size_t WS_ROWIDX = 14 * MiB;
constexpr size_t WS_WA_IN = 16 * MiB;
constexpr size_t WS_WA_OUT = 22 * MiB;
constexpr size_t WS_WB_IN = 26 * MiB;
constexpr size_t WS_WB_OUT = 32 * MiB;
constexpr size_t WS_WC_IN = 34 * MiB;
constexpr size_t WS_WC_OUT = 40 * MiB;
constexpr size_t WS_WEGU = 42 * MiB;
constexpr size_t WS_WED = 170 * MiB;
constexpr size_t WS_U = 234 * MiB;
constexpr size_t WS_P = 300 * MiB;
constexpr size_t WS_O = 498 * MiB;
constexpr size_t WS_ZT = 564 * MiB;
constexpr size_t WS_ATT = 630 * MiB;
constexpr size_t WS_BIG = 830 * MiB;
constexpr size_t WS_H2A = 1102 * MiB;
constexpr size_t WS_W3T = 1107 * MiB;
constexpr size_t WS_FTC = 1110 * MiB;
constexpr size_t WS_WEGU2 = 1114 * MiB;
constexpr size_t WS_WED2 = 1242 * MiB;
constexpr size_t WS_HH = 1306 * MiB;
constexpr size_t WS_END = 1372 * MiB;
constexpr size_t WS_FTL = WS_O;

constexpr int LDS_BYTES = 147456;
constexpr int MISC_OFF = 143360;

__device__ __forceinline__ unsigned pkh(float a, float b) { f16x2 v = {(f16)a, (f16)b}; return __builtin_bit_cast(unsigned, v); }
__device__ __forceinline__ f32x2 h2f_(unsigned v) { const f16x2 h = __builtin_bit_cast(f16x2, v); return (f32x2){(float)h[0], (float)h[1]}; }
template <int M> __device__ __forceinline__ float swz_xor(float v) { return __builtin_bit_cast(float, __builtin_amdgcn_ds_swizzle(__builtin_bit_cast(int, v), 0x1f | (M << 10))); }
__device__ __forceinline__ void swap32(float v, float& a, float& b) { a = v; b = v; asm volatile("v_nop\n\tv_nop\n\tv_permlane32_swap_b32 %0, %1" : "+v"(a), "+v"(b)); }
__device__ __forceinline__ float sum_xor32(float v) { float a, b; swap32(v, a, b); return a + b; }
__device__ __forceinline__ float max_xor32(float v) { float a, b; swap32(v, a, b); return fmaxf(a, b); }
__device__ __forceinline__ float wave_sum(float v) {
    v += swz_xor<1>(v); v += swz_xor<2>(v); v += swz_xor<4>(v); v += swz_xor<8>(v); v += swz_xor<16>(v);
    return sum_xor32(v);
}
__device__ __forceinline__ void unpack8(const u32x4 w, float (&f)[8]) {
    const f16x8 h = __builtin_bit_cast(f16x8, w);
#pragma unroll
    for (int i = 0; i < 8; ++i) f[i] = (float)h[i];
}

constexpr float YE_SCALE = 16.0f;
constexpr float W8_SCALE = 64.0f; constexpr int W8_SCALE_E8M0 = 127 - 6, A8_SCALE_E8M0 = 127;
__device__ __forceinline__ float clamp8(float x) { return fminf(fmaxf(x, -448.0f), 448.0f); }
__device__ __forceinline__ unsigned pk8nc(float a, float b, float c, float d) { int w = 0; w = __builtin_amdgcn_cvt_pk_fp8_f32(a, b, w, false); w = __builtin_amdgcn_cvt_pk_fp8_f32(c, d, w, true); return (unsigned)w; }
__device__ __forceinline__ unsigned pk8(float a, float b, float c, float d) { int w = 0; w = __builtin_amdgcn_cvt_pk_fp8_f32(clamp8(a), clamp8(b), w, false); w = __builtin_amdgcn_cvt_pk_fp8_f32(clamp8(c), clamp8(d), w, true); return (unsigned)w; }
#define XB_TMO      128
#define XB_XCNT(j)  (256  + 64 * (j))
#define XB_XSUB(j)  (1280 + 64 * (j))
#define XB_XGEN(j)  (2304 + 64 * (j))
#define XB_TOP      3328
#define XB_TOPGEN   3392
#define XCD_BAR_WORDS 3456
#define XB_SPIN_CAP (1u << 18)
__device__ __forceinline__ unsigned xb_ld(unsigned* p)              { return __hip_atomic_load(p, __ATOMIC_RELAXED, __HIP_MEMORY_SCOPE_AGENT); }
__device__ __forceinline__ unsigned xb_add(unsigned* p, unsigned v) { return __hip_atomic_fetch_add(p, v, __ATOMIC_RELAXED, __HIP_MEMORY_SCOPE_AGENT); }
__device__ __forceinline__ unsigned xb_xcc_id() { return (unsigned)__builtin_amdgcn_s_getreg((3 << 11) | 20) & 0xFu; }
#define XB_SPIN(cond, bar) do { unsigned _sp = 0; while (cond) { __builtin_amdgcn_s_sleep(1); \
    if ((++_sp & 255u) == 0u) { if (xb_ld(&(bar)[XB_TMO])) break; if (_sp > XB_SPIN_CAP) { atomicAdd(&(bar)[XB_TMO], 1u); break; } } } } while (0)
struct XcdBarrier { unsigned* bar; unsigned x; volatile LAS unsigned* st; };
__device__ __forceinline__ XcdBarrier xcd_barrier_post(unsigned* bar, volatile LAS unsigned* st) {
    XcdBarrier b; b.bar = bar; b.x = xb_xcc_id(); b.st = st;
    if (threadIdx.x == 0) (void)xb_add(&bar[XB_XCNT(b.x)], 1u);
    return b;
}
__device__ __forceinline__ void xcd_barrier_complete(unsigned* bar, unsigned x, unsigned& nloc, unsigned& nx) {
    const unsigned G = gridDim.x * gridDim.y * gridDim.z;
    unsigned sum, cnt, mine, sp = 0u;
    for (;;) {
        sum = 0u; cnt = 0u; mine = 0u;
#pragma unroll
        for (unsigned j = 0; j < 16; ++j) { const unsigned c = xb_ld(&bar[XB_XCNT(j)]); sum += c; cnt += (c > 0u) ? 1u : 0u; mine = (j == x) ? c : mine; }
        if (sum == G) break;
        __builtin_amdgcn_s_sleep(1);
        if ((++sp & 255u) == 0u) { if (xb_ld(&bar[XB_TMO])) break; if (sp > XB_SPIN_CAP) { atomicAdd(&bar[XB_TMO], 1u); break; } }
    }
    nloc = mine > 0u ? mine : 1u; nx = cnt > 0u ? cnt : 1u;
}
__device__ __forceinline__ void xcd_barrier(const XcdBarrier& b) {
    asm volatile("s_waitcnt vmcnt(0)" ::: "memory");
    __syncthreads();
    if (threadIdx.x == 0) {
        unsigned* bar = b.bar;
        __builtin_amdgcn_s_waitcnt(0);
        unsigned nloc = b.st[0], nx = b.st[1];
        if (nloc == 0u) { xcd_barrier_complete(bar, b.x, nloc, nx); b.st[0] = nloc; b.st[1] = nx; }
        const unsigned old = xb_add(&bar[XB_XSUB(b.x)], 1u);
        const unsigned gen = old / nloc;
        if (old + 1u == (gen + 1u) * nloc) {
            __builtin_amdgcn_fence(__ATOMIC_RELEASE, "agent");
            asm volatile("s_waitcnt vmcnt(0)" ::: "memory");
            const unsigned og = xb_add(&bar[XB_TOP], 1u);
            const unsigned tg = og / nx;
            if (og + 1u == (tg + 1u) * nx) xb_add(&bar[XB_TOPGEN], 1u);
            else XB_SPIN(xb_ld(&bar[XB_TOPGEN]) == tg, bar);
            __builtin_amdgcn_fence(__ATOMIC_ACQUIRE, "agent");
            xb_add(&bar[XB_XGEN(b.x)], 1u);
            asm volatile("s_waitcnt vmcnt(0)" ::: "memory");
        } else {
            XB_SPIN(xb_ld(&bar[XB_XGEN(b.x)]) == gen, bar);
            __builtin_amdgcn_fence(__ATOMIC_ACQUIRE, "agent");
            asm volatile("s_waitcnt vmcnt(0)" ::: "memory");
        }
    }
    __syncthreads();
}

namespace pg8 {
constexpr int BM = 256, BK = 64, HALF = 128, HTB = HALF * BK * 2, STAGE_BYTES = 8 * HTB, NXCD = 8, WGM = 8;
__host__ __device__ __forceinline__ int lds_byte(int r, int c) { const int st = (r >> 4) * 2 + (c >> 5), rr = r & 15, cc = c & 31, ob = rr * 64 + cc * 2; return st * 1024 + (ob ^ (((ob >> 9) & 1) << 5)); }
__host__ __device__ __forceinline__ void stage_rc(int b, int& Rr, int& C) { const int st = b / 1024, sb = b % 1024, swz = sb ^ (((sb >> 9) & 1) << 5); Rr = (st >> 1) * 16 + swz / 64; C = (st & 1) * 32 + (swz % 64) / 2; }
__host__ __device__ __forceinline__ int perm32(int rho) { const int n = rho >> 4, i = rho & 15; return 8 * (i >> 2) + 4 * n + (i & 3); }

struct Unit { int pm, pn, pb; };
struct Gemm { const f16* A; const f16* Bt; int K; const int* ridx; };

struct StaticOrder {
    int nM, nN, nwg, G, c;
    __device__ void init(int M, int N, int G_, int c_) { nM = M / BM; nN = N / BM; nwg = nM * nN; G = G_; c = c_; }
    __device__ bool next(int i, Unit& u) const {
        const long L = (long)i * G + c; if (L >= nwg) return false;
        int wgid = (int)L; { const int q = nwg / NXCD, r = nwg % NXCD, xcd = wgid % NXCD, off = wgid / NXCD; wgid = (xcd < r ? xcd * (q + 1) : r * (q + 1) + (xcd - r) * q) + off; }
        const int nig = WGM * nN, gid = wgid / nig, fm = gid * WGM, gsz = (nM - fm) < WGM ? (nM - fm) : WGM;
        u.pm = fm + ((wgid % nig) % gsz); u.pn = (wgid % nig) / gsz; u.pb = u.pn; return true;
    }
};
struct GroupedOrder {
    int nMe, nN, G, c;
    __device__ void init(int nMe_, int nN_, int G_, int c_) { nMe = nMe_; nN = nN_; G = G_; c = c_; }
    __device__ bool next(int i, Unit& u) const {
        const int per = nMe * nN; int e, r;
        if ((G & 7) == 0) { const int x = c & 7, j = c >> 3, w = i * (G >> 3) + j; if (w >= 2 * per) return false; e = 2 * x + w / per; r = w % per; }
        else { const long L = (long)i * G + c; if (L >= (long)NE * per) return false; e = (int)(L / per); r = (int)(L % per); }
        const int nig = WGM * nN, gid = r / nig, fm = gid * WGM, gsz = (nMe - fm) < WGM ? (nMe - fm) : WGM;
        u.pm = e * ETILES + fm + ((r % nig) % gsz); u.pn = (r % nig) / gsz; u.pb = e * nN + u.pn; return true;
    }
};

struct EpiStoreF16 {
    static constexpr bool PERM = true, SWAP = false; static constexpr int BPERM = 0;
    f16* O; int ldc;
    __device__ __forceinline__ void operator()(const f32x4 (&acc)[2][2][4][2], const Unit& u, int wr, int wc, int fr_, int fq_) const {
        int fr = fr_, fq = fq_; asm volatile("" : "+v"(fr), "+v"(fq));
        const int row0 = u.pm * BM + wr * 64 + fr, col0 = u.pn * BM + wc * 32 + 8 * fq;
#pragma unroll
        for (int ai = 0; ai < 2; ++ai)
#pragma unroll
            for (int m = 0; m < 4; ++m) { f16* rowp = O + (size_t)(row0 + ai * HALF + m * 16) * ldc + col0;
#pragma unroll
                for (int bj = 0; bj < 2; ++bj) { const f32x4 v0 = acc[ai][bj][m][0], v1 = acc[ai][bj][m][1];
                    u32x4 w; w.x = pkh(v0[0], v0[1]); w.y = pkh(v0[2], v0[3]); w.z = pkh(v1[0], v1[1]); w.w = pkh(v1[2], v1[3]);
                    *(u32x4*)(rowp + bj * HALF) = w; } }
    }
};
struct EpiStoreF8 {
    static constexpr bool PERM = true, SWAP = false; static constexpr int BPERM = 0;
    unsigned char* O; int ldc; float sc;
    __device__ __forceinline__ void operator()(const f32x4 (&acc)[2][2][4][2], const Unit& u, int wr, int wc, int fr_, int fq_) const {
        int fr = fr_, fq = fq_; asm volatile("" : "+v"(fr), "+v"(fq));
        const int row0 = u.pm * BM + wr * 64 + fr, col0 = u.pn * BM + wc * 32 + 8 * fq;
#pragma unroll
        for (int ai = 0; ai < 2; ++ai)
#pragma unroll
            for (int m = 0; m < 4; ++m) { unsigned char* rowp = O + (size_t)(row0 + ai * HALF + m * 16) * ldc + col0;
#pragma unroll
                for (int bj = 0; bj < 2; ++bj) { const f32x4 v0 = acc[ai][bj][m][0] * sc, v1 = acc[ai][bj][m][1] * sc;
                    u32x2 w; w.x = pk8(v0[0], v0[1], v0[2], v0[3]); w.y = pk8(v1[0], v1[1], v1[2], v1[3]);
                    *(u32x2*)(rowp + bj * HALF) = w; } }
    }
};
__device__ __forceinline__ float silu_mul(float g, float u) { return g * __builtin_amdgcn_rcpf(1.0f + __builtin_amdgcn_exp2f(-g * LOG2E)) * u; }
struct EpiSwiGLU {
    static constexpr bool PERM = true, SWAP = false; static constexpr int BPERM = 0;
    unsigned char* O;
    __device__ __forceinline__ void operator()(const f32x4 (&acc)[2][2][4][2], const Unit& u, int wr, int wc, int fr_, int fq_) const {
        int fr = fr_, fq = fq_; asm volatile("" : "+v"(fr), "+v"(fq));
        const int row0 = u.pm * BM + wr * 64 + fr, col0 = u.pn * HALF + wc * 32 + 8 * fq;
#pragma unroll
        for (int ai = 0; ai < 2; ++ai)
#pragma unroll
            for (int m = 0; m < 4; ++m) { unsigned char* rowp = O + (size_t)(row0 + ai * HALF + m * 16) * FF + col0;
                const f32x4 g0 = acc[ai][0][m][0], g1 = acc[ai][0][m][1], u0 = acc[ai][1][m][0], u1 = acc[ai][1][m][1];
                u32x2 w; w.x = pk8(silu_mul(g0[0], u0[0]), silu_mul(g0[1], u0[1]), silu_mul(g0[2], u0[2]), silu_mul(g0[3], u0[3]));
                w.y = pk8(silu_mul(g1[0], u1[0]), silu_mul(g1[1], u1[1]), silu_mul(g1[2], u1[2]), silu_mul(g1[3], u1[3]));
                *(u32x2*)rowp = w; }
    }
};
struct EpiResidual {
    static constexpr bool PERM = false, SWAP = false; static constexpr int BPERM = 0;
    const float* x_l; const float* x_c; f16* HH; bool first; const float* gate; float scale;
    __device__ __forceinline__ void operator()(const f32x4 (&acc)[2][2][4][2], const Unit& u, int wr, int wc, int fr, int fq) const {
        const bool isc = u.pm >= 128; const int bb = isc ? 4 : (u.pm >> 5);
        const float* hin = isc ? x_c + (size_t)(u.pm - 128) * BM * D : x_l + (size_t)u.pm * BM * D;
        f16* hh = HH + (size_t)u.pm * BM * D;
        const int row0 = wr * 64 + fr, col0 = u.pn * BM + wc * 32 + 4 * fq;
        f32x4 gv[2][2];
#pragma unroll
        for (int bj = 0; bj < 2; ++bj)
#pragma unroll
            for (int n = 0; n < 2; ++n) gv[bj][n] = *(const f32x4*)(gate + bb * 6144 + col0 + bj * HALF + n * 16) * scale;
#pragma unroll
        for (int ai = 0; ai < 2; ++ai)
#pragma unroll
            for (int m = 0; m < 4; ++m) { const size_t off = (size_t)(row0 + ai * HALF + m * 16) * D + col0;
#pragma unroll
                for (int bj = 0; bj < 2; ++bj)
#pragma unroll
                    for (int n = 0; n < 2; ++n) { f32x4 hv;
                        if (first) hv = *(const f32x4*)(hin + off + bj * HALF + n * 16);
                        else { const f16x4 t = *(const f16x4*)(hh + off + bj * HALF + n * 16); hv = (f32x4){(float)t[0], (float)t[1], (float)t[2], (float)t[3]}; }
                        const f32x4 o = hv + gv[bj][n] * acc[ai][bj][m][n]; u32x2 w; w.x = pkh(o.x, o.y); w.y = pkh(o.z, o.w);
                        *(u32x2*)(hh + off + bj * HALF + n * 16) = w; } }
    }
};
struct EpiTransposeF16 {
    static constexpr bool PERM = false, SWAP = true; static constexpr int BPERM = 0;
    f16* PT; f16* PTC;
    __device__ __forceinline__ void operator()(const f32x4 (&acc)[2][2][4][2], const Unit& u, int wr, int wc, int fr, int fq) const {
        const bool isc = u.pm >= 128;
        const int b = isc ? (u.pm - 128) : (u.pm >> 5); const int t0 = isc ? 0 : (u.pm & 31) * BM; const int len = isc ? NCX : T;
        f16* base = (isc ? PTC : PT) + (size_t)b * 3072 * len;
        const int col0 = u.pn * BM + wc * 32 + fr, tt0 = t0 + wr * 64 + 4 * fq;
#pragma unroll
        for (int bj = 0; bj < 2; ++bj)
#pragma unroll
            for (int n = 0; n < 2; ++n) { f16* cp = base + (size_t)(col0 + bj * HALF + n * 16) * len + tt0;
#pragma unroll
                for (int ai = 0; ai < 2; ++ai)
#pragma unroll
                    for (int m = 0; m < 4; ++m) { const f32x4 v = acc[ai][bj][m][n]; u32x2 w; w.x = pkh(v[0], v[1]); w.y = pkh(v[2], v[3]); *(u32x2*)(cp + ai * HALF + m * 16) = w; } }
    }
};

struct EpiFilterT {
    static constexpr bool PERM = false, SWAP = true; static constexpr int BPERM = 0;
    f16* FTL; float* FTC;
    __device__ __forceinline__ void operator()(const f32x4 (&acc)[2][2][4][2], const Unit& u, int wr, int wc, int fr, int fq) const {
        const bool isc = u.pm >= 32;
        const int col0 = u.pn * BM + wc * 32 + fr, tt0 = (isc ? 0 : u.pm * BM) + wr * 64 + 4 * fq;
#pragma unroll
        for (int bj = 0; bj < 2; ++bj)
#pragma unroll
            for (int n = 0; n < 2; ++n) {
                if (isc) { float* cp = FTC + (size_t)(col0 + bj * HALF + n * 16) * NCX + tt0;
#pragma unroll
                    for (int ai = 0; ai < 2; ++ai)
#pragma unroll
                        for (int m = 0; m < 4; ++m) *(f32x4*)(cp + ai * HALF + m * 16) = acc[ai][bj][m][n]; }
                else { f16* cp = FTL + (size_t)(col0 + bj * HALF + n * 16) * T + tt0;
#pragma unroll
                    for (int ai = 0; ai < 2; ++ai)
#pragma unroll
                        for (int m = 0; m < 4; ++m) { const f32x4 v = acc[ai][bj][m][n]; u32x2 w; w.x = pkh(v[0], v[1]); w.y = pkh(v[2], v[3]); *(u32x2*)(cp + ai * HALF + m * 16) = w; } } }
    }
};
template <class Epi, class Sched, bool GATHER = false, bool FP8 = false>
__device__ __forceinline__ void gemm_phase(LAS unsigned char* lds, const int tid, const Gemm g, const Sched& S, const Epi& E) {
    const int wid = __builtin_amdgcn_readfirstlane(tid >> 6), lane = tid & 63, wr = wid >> 2, wc = wid & 3, fr = lane & 15, fq = lane >> 4;
    const int K = g.K, nt = K / BK;
    unsigned voffA[2], voffB[2]; int rowA[2]; unsigned colA[2];
#pragma unroll
    for (int i = 0; i < 2; ++i) { int Rr, C; stage_rc(tid * 16 + i * 8192, Rr, C); const int Rb = Epi::PERM ? ((Rr & ~31) + perm32(Rr & 31)) : Rr;
        voffA[i] = (unsigned)(Rr * K + C) * 2u; voffB[i] = (unsigned)(Rb * K + C) * 2u; rowA[i] = Rr; colA[i] = (unsigned)C * 2u; }
    unsigned voffB2[2][2];
#pragma unroll
    for (int h_ = 0; h_ < 2; ++h_)
#pragma unroll
        for (int i_ = 0; i_ < 2; ++i_) voffB2[h_][i_] = (unsigned)((64 * (rowA[i_] >> 5) + 32 * h_ + (rowA[i_] & 31)) * K) * 2u + colA[i_];
#define PG8_STAGE_B(bufoff, bbase, h) do { if constexpr (Epi::BPERM == 2) PG8_STAGE(bufoff, bbase, voffB2[h]); else PG8_STAGE(bufoff, (bbase) + (h) * hstep, voffB); } while (0)
    unsigned gcur[2][2], gnxt[2][2];
#define PG8_LOADG(dst, u) do { _Pragma("unroll") for (int h_ = 0; h_ < 2; ++h_) _Pragma("unroll") for (int i_ = 0; i_ < 2; ++i_) \
        dst[h_][i_] = (unsigned)g.ridx[(u).pm * BM + h_ * HALF + rowA[i_]] * (unsigned)(K * 2) + colA[i_]; } while (0)
#define PG8_STAGE_A(bufoff, kb, h, nx) do { if constexpr (GATHER) { unsigned o_[2]; o_[0] = (nx) ? gnxt[h][0] : gcur[h][0]; o_[1] = (nx) ? gnxt[h][1] : gcur[h][1]; PG8_STAGE(bufoff, (const char*)g.A + (kb), o_); } \
        else PG8_STAGE(bufoff, ((nx) ? nA : cA) + (kb) + (h) * hstep, voffA); } while (0)
    const size_t kstep = (size_t)(BK * 2);
    const size_t hstep = (size_t)HALF * K * 2;
    const size_t tstep = 2 * hstep;
    const unsigned ldsw = (unsigned)wid * 1024u;
    const int aoff = lds_byte(wr * 64 + fr, fq * 8), boff = lds_byte(wc * 32 + fr, fq * 8);
#define PG8_SA(b, h) (((b) * 2 + (h)) * HTB)
#define PG8_SB(b, h) ((4 + (b) * 2 + (h)) * HTB)
#define PG8_STAGE(bufoff, gbase, voff) do { _Pragma("unroll") for (int _i = 0; _i < 2; ++_i) \
        __builtin_amdgcn_global_load_lds((const unsigned*)((const char*)(gbase) + (voff)[_i]), (LAS unsigned*)(lds + (bufoff) + ldsw + _i * 8192), 16, 0, 0); } while (0)
#define PG8_LDA(dst, b, h) do { _Pragma("unroll") for (int m = 0; m < 4; ++m) _Pragma("unroll") for (int k = 0; k < 2; ++k) dst[m][k] = *(const LAS f16x8*)(lds + PG8_SA(b, h) + aoff + m * 2048 + k * 1024); } while (0)
#define PG8_LDB(dst, b, h) do { _Pragma("unroll") for (int n = 0; n < 2; ++n) _Pragma("unroll") for (int k = 0; k < 2; ++k) dst[n][k] = *(const LAS f16x8*)(lds + PG8_SB(b, h) + boff + n * 2048 + k * 1024); } while (0)
#define PG8_CAT(x0, x1) __builtin_shufflevector(__builtin_bit_cast(v4i32, x0), __builtin_bit_cast(v4i32, x1), 0, 1, 2, 3, 4, 5, 6, 7)
#define PG8_MMA(ai, bj, At, Bt) do { __builtin_amdgcn_s_setprio(1); \
        if constexpr (FP8) { _Pragma("unroll") for (int m = 0; m < 4; ++m) _Pragma("unroll") for (int n = 0; n < 2; ++n) \
            { const v8i32 b8_ = PG8_CAT(Bt[n][0], Bt[n][1]), a8_ = PG8_CAT(At[m][0], At[m][1]); \
              asm("v_mfma_scale_f32_16x16x128_f8f6f4 %0, %1, %2, %0, %3, %4 op_sel_hi:[0,0,0]" : "+v"(acc[ai][bj][m][n]) : "v"(b8_), "v"(a8_), "v"(sc8w), "v"(sc8a)); } } \
        else { _Pragma("unroll") for (int m = 0; m < 4; ++m) _Pragma("unroll") for (int n = 0; n < 2; ++n) _Pragma("unroll") for (int k = 0; k < 2; ++k) \
        acc[ai][bj][m][n] = Epi::SWAP ? __builtin_amdgcn_mfma_f32_16x16x32_f16(At[m][k], Bt[n][k], acc[ai][bj][m][n], 0, 0, 0) \
                                      : __builtin_amdgcn_mfma_f32_16x16x32_f16(Bt[n][k], At[m][k], acc[ai][bj][m][n], 0, 0, 0); } __builtin_amdgcn_s_setprio(0); } while (0)
#define PG8_WAIT_V(n) asm volatile("s_waitcnt vmcnt(" #n ")" ::: "memory")
#define PG8_WAIT_L(n) asm volatile("s_waitcnt lgkmcnt(" #n ")" ::: "memory")
#define PG8_BAR __builtin_amdgcn_s_barrier()
#define PG8_SCHED __builtin_amdgcn_sched_barrier(0)
    Unit cur, nxt; int ui = 0;
    if (!S.next(0, cur)) return;
    const int sc8w = W8_SCALE_E8M0, sc8a = A8_SCALE_E8M0;
    f32x4 acc[2][2][4][2];
#pragma unroll
    for (int a = 0; a < 2; ++a)
#pragma unroll
        for (int b = 0; b < 2; ++b)
#pragma unroll
            for (int m = 0; m < 4; ++m)
#pragma unroll
                for (int n = 0; n < 2; ++n) acc[a][b][m][n] = (f32x4){0.f, 0.f, 0.f, 0.f};
    f16x8 At[4][2], B0[2][2], B1[2][2];
    const char* cA = (const char*)g.A + (size_t)cur.pm * tstep; const char* cB = (const char*)g.Bt + (size_t)cur.pb * tstep; const char* nA = cA;
    if constexpr (GATHER) { PG8_LOADG(gcur, cur); PG8_LOADG(gnxt, cur); }
    PG8_STAGE_B(PG8_SB(0, 0), cB, 0); PG8_STAGE_B(PG8_SB(0, 1), cB, 1); PG8_STAGE_A(PG8_SA(0, 0), 0, 0, false); PG8_STAGE_A(PG8_SA(0, 1), 0, 1, false);
    if (wr == 1) PG8_BAR;
    PG8_WAIT_V(2); PG8_BAR;
    PG8_STAGE_B(PG8_SB(1, 0), cB + kstep, 0); PG8_STAGE_A(PG8_SA(1, 0), kstep, 0, false); PG8_STAGE_B(PG8_SB(1, 1), cB + kstep, 1);
    PG8_WAIT_V(6); PG8_BAR;
    for (;;) {
        const bool has_next = S.next(ui + 1, nxt);
        nA = has_next ? (const char*)g.A + (size_t)nxt.pm * tstep : cA; const char* nB = has_next ? (const char*)g.Bt + (size_t)nxt.pb * tstep : cB;
        if constexpr (GATHER) { const Unit lu = has_next ? nxt : cur; PG8_LOADG(gnxt, lu); }
        for (int t = 0; t < nt; t += 2) {
            const bool last = (t == nt - 2);
            const size_t k1 = (size_t)(t + 1) * kstep, k2 = last ? 0 : (size_t)(t + 2) * kstep, k3 = k2 + kstep;
            const char* b2 = last ? nB : cB + (size_t)(t + 2) * kstep; const char* b3 = b2 + kstep;
            PG8_LDB(B0, 0, 0); PG8_LDB(B1, 0, 1); PG8_SCHED; PG8_LDA(At, 0, 0); PG8_STAGE_A(PG8_SA(1, 1), k1, 1, false);
            PG8_WAIT_V(8); PG8_WAIT_L(0); PG8_BAR; PG8_MMA(0, 0, At, B0); PG8_MMA(0, 1, At, B1); PG8_BAR; PG8_SCHED;
            PG8_LDA(At, 0, 1); PG8_STAGE_B(PG8_SB(0, 0), b2, 0); PG8_STAGE_B(PG8_SB(0, 1), b2, 1); PG8_STAGE_A(PG8_SA(0, 0), k2, 0, last);
            PG8_WAIT_V(8); PG8_WAIT_L(0); PG8_BAR; PG8_MMA(1, 0, At, B0); PG8_MMA(1, 1, At, B1); PG8_BAR; PG8_SCHED;
            PG8_LDB(B0, 1, 0); PG8_LDB(B1, 1, 1); PG8_SCHED; PG8_LDA(At, 1, 0); PG8_STAGE_A(PG8_SA(0, 1), k2, 1, last);
            PG8_WAIT_V(8); PG8_WAIT_L(0); PG8_BAR; PG8_MMA(0, 0, At, B0); PG8_MMA(0, 1, At, B1); PG8_BAR; PG8_SCHED;
            PG8_LDA(At, 1, 1); PG8_STAGE_B(PG8_SB(1, 0), b3, 0); PG8_STAGE_B(PG8_SB(1, 1), b3, 1); PG8_STAGE_A(PG8_SA(1, 0), k3, 0, last);
            PG8_WAIT_V(8); PG8_WAIT_L(0); PG8_BAR; PG8_MMA(1, 0, At, B0); PG8_MMA(1, 1, At, B1); PG8_BAR; PG8_SCHED;
        }
        if (wr == 0) PG8_BAR;
        if constexpr (FP8) asm volatile("s_nop 15\n\ts_nop 15" ::: "memory");
        E(acc, cur, wr, wc, fr, fq);
        if (!has_next) break;
#pragma unroll
        for (int a = 0; a < 2; ++a)
#pragma unroll
            for (int b = 0; b < 2; ++b)
#pragma unroll
                for (int m = 0; m < 4; ++m)
#pragma unroll
                    for (int n = 0; n < 2; ++n) acc[a][b][m][n] = (f32x4){0.f, 0.f, 0.f, 0.f};
        cur = nxt; cA = nA; cB = nB; ++ui;
        if constexpr (GATHER) {
#pragma unroll
            for (int h_ = 0; h_ < 2; ++h_)
#pragma unroll
                for (int i_ = 0; i_ < 2; ++i_) gcur[h_][i_] = gnxt[h_][i_]; }
        if (wr == 1) PG8_BAR;
    }
    PG8_WAIT_V(0);
    PG8_BAR;
#undef PG8_SA
#undef PG8_SB
#undef PG8_STAGE
#undef PG8_STAGE_A
#undef PG8_STAGE_B
#undef PG8_LOADG
#undef PG8_LDA
#undef PG8_LDB
#undef PG8_MMA
#undef PG8_CAT
#undef PG8_WAIT_V
#undef PG8_WAIT_L
#undef PG8_BAR
#undef PG8_SCHED
}
}

struct Args { const float* in[34]; float* out; unsigned char* ws; int ph_lo, ph_hi; };
struct Ctx {
    LAS unsigned char* lds; int tid, lane, wave, G, bid;
    const float* const* in; float* out; unsigned char* ws;
};
#define IN_X 0
#define IN_C 1
#define IN_CTX 2
#define IN_CCTX 3
#define IN_ADA_W 4
#define IN_ADA_B 5
#define IN_NMIX 6
#define IN_NFFN 7
#define IN_ROUTER 8
#define IN_WGATE 9
#define IN_WUP 10
#define IN_WDOWN 11
#define IN_A_WIN 12
#define IN_A_WOUT 13
#define IN_A_QG 14
#define IN_A_KG 15
#define IN_A_SINK 16
#define IN_B_WIN 17
#define IN_B_SW 18
#define IN_B_SB 19
#define IN_B_W1 20
#define IN_B_B1 21
#define IN_B_F1 22
#define IN_B_W2 23
#define IN_B_B2 24
#define IN_B_F2 25
#define IN_B_W3 26
#define IN_B_BIAS 27
#define IN_B_WOUT 28
#define IN_C_WIN 29
#define IN_C_WOUT 30
#define IN_C_QG 31
#define IN_C_KG 32
#define IN_C_RPB 33

__device__ __forceinline__ void transpose_item(const float* W, int K, int N, f16* WT, int k0, int n0, int dst_row0, LAS float* scr, int lane) {
    float v[64];
    const float* src = W + (size_t)k0 * N + n0 + lane;
#pragma unroll
    for (int kk = 0; kk < 64; ++kk) v[kk] = src[(size_t)kk * N];
#pragma unroll
    for (int kk = 0; kk < 64; ++kk) scr[kk * 65 + lane] = v[kk];
    asm volatile("s_waitcnt lgkmcnt(0)" ::: "memory");
    const int c = lane & 7, ns = lane >> 3;
#pragma unroll
    for (int j = 0; j < 8; ++j) { const int n = ns + 8 * j; const LAS float* sp = scr + (8 * c) * 65 + n;
        u32x4 o; o.x = pkh(sp[0 * 65], sp[1 * 65]); o.y = pkh(sp[2 * 65], sp[3 * 65]); o.z = pkh(sp[4 * 65], sp[5 * 65]); o.w = pkh(sp[6 * 65], sp[7 * 65]);
        *(u32x4*)(WT + (size_t)(dst_row0 + n) * K + k0 + 8 * c) = o; }
    asm volatile("s_waitcnt lgkmcnt(0)" ::: "memory");
}
__device__ __forceinline__ void transpose_item8(const float* W, int K, int N, unsigned char* WT, int k0, int n0, int dst_row0, LAS float* scr, int lane) {
    float v[64];
    const float* src = W + (size_t)k0 * N + n0 + lane;
#pragma unroll
    for (int kk = 0; kk < 64; ++kk) v[kk] = src[(size_t)kk * N];
#pragma unroll
    for (int kk = 0; kk < 64; ++kk) scr[kk * 65 + lane] = v[kk] * W8_SCALE;
    asm volatile("s_waitcnt lgkmcnt(0)" ::: "memory");
    const int c = lane & 7, ns = lane >> 3;
#pragma unroll
    for (int j = 0; j < 8; ++j) { const int n = ns + 8 * j; const LAS float* sp = scr + (8 * c) * 65 + n;
        u32x2 o; o.x = pk8(sp[0 * 65], sp[1 * 65], sp[2 * 65], sp[3 * 65]); o.y = pk8(sp[4 * 65], sp[5 * 65], sp[6 * 65], sp[7 * 65]);
        *(u32x2*)(WT + (size_t)(dst_row0 + n) * K + k0 + 8 * c) = o; }
    asm volatile("s_waitcnt lgkmcnt(0)" ::: "memory");
}
__device__ __forceinline__ void transpose_matrix_items(const Ctx& C, const float* W, int K, int N, f16* WT, int& base, int gw, int NGW) {
    const int nblk = N / 64, nit = (K / 64) * nblk;
    LAS float* scr = (LAS float*)(C.lds + C.wave * 16640);
    int first = (gw - base % NGW + NGW) % NGW;
    for (int it = first; it < nit; it += NGW) { const int kb = it / nblk, nb = it % nblk; transpose_item(W, K, N, WT, 64 * kb, 64 * nb, 64 * nb, scr, C.lane); }
    base += nit;
}

__device__ __forceinline__ float silu_f(float x) { return x / (1.0f + expf(-x)); }

__device__ __forceinline__ void prologue_mod(const Ctx& C) {
    LAS float* sc = (LAS float*)C.lds;
    LAS float* red = (LAS float*)(C.lds + 32768);
    if (C.bid >= 96) return;
    for (int i = C.tid; i < 5 * 1024; i += 512) { const int bb = i >> 10, k = i & 1023; const float v = bb < 4 ? C.in[IN_C][bb * 1024 + k] : C.in[IN_CCTX][k]; sc[i] = silu_f(v); }
    __syncthreads();
    for (int u = C.bid; u < 96; u += C.G) {
        const int layer = u / 24, cg = u % 24; const float* W = C.in[IN_ADA_W] + (size_t)layer * 1024 * 6144 + cg * 256 + 4 * C.lane;
        f32x4 acc[5];
#pragma unroll
        for (int bb = 0; bb < 5; ++bb) acc[bb] = (f32x4){0.f, 0.f, 0.f, 0.f};
        const int kb = C.wave * 128;
#pragma unroll 4
        for (int k = 0; k < 128; ++k) { const f32x4 w = *(const f32x4*)(W + (size_t)(kb + k) * 6144);
#pragma unroll
            for (int bb = 0; bb < 5; ++bb) acc[bb] += w * sc[bb * 1024 + kb + k]; }
#pragma unroll
        for (int bb = 0; bb < 5; ++bb) *(LAS f32x4*)(red + (C.wave * 5 + bb) * 256 + 4 * C.lane) = acc[bb];
        __syncthreads();
        for (int i = C.tid; i < 5 * 256; i += 512) { const int bb = i >> 8, cc = i & 255; float s = C.in[IN_ADA_B][layer * 6144 + cg * 256 + cc];
#pragma unroll
            for (int w = 0; w < 8; ++w) s += red[(w * 5 + bb) * 256 + cc];
            ((float*)(C.ws + WS_MOD))[(size_t)(layer * 5 + bb) * 6144 + cg * 256 + cc] = s; }
        __syncthreads();
    }
}
__device__ __forceinline__ void prologue_tables(const Ctx& C, int gw, int NGW) {
    float* rope = (float*)(C.ws + WS_ROPE);
    for (int i = gw * 64 + C.lane; i < 128 * 16; i += NGW * 64) { const int pos = i >> 4, f = i & 15;
        const float inv = 1.0f / powf(10000.0f, (float)(2 * f) / 32.0f); const float ang = (float)pos * inv;
        rope[i] = cosf(ang); rope[2048 + i] = sinf(ang); }
    LAS float* zb = (LAS float*)(C.lds + 133120 + C.wave * 512);
    const float* w1 = C.in[IN_B_W1]; const float* b1 = C.in[IN_B_B1]; const float* f1 = C.in[IN_B_F1];
    const float* w2 = C.in[IN_B_W2]; const float* b2 = C.in[IN_B_B2]; const float* f2 = C.in[IN_B_F2];
    f16* H2A = (f16*)(C.ws + WS_H2A);
    for (int p = gw; p < T + NCX; p += NGW) {
        const bool isc = p >= T; const int t = isc ? p - T : p; const int n = isc ? NCX : T;
        float z = 0.f;
        if (C.lane == 0) z = (float)t / (float)(n - 1);
        else if (C.lane < 33) { const int k = (C.lane - 1) & 15; const float f = 1e-4f + (float)k * ((15.0f - 1e-4f) / 15.0f); const float w = (6.283185307179586f * (float)t) / (float)n;
            z = C.lane < 17 ? cosf(f * w) : -sinf(f * w); }
        zb[C.lane] = z;
        asm volatile("s_waitcnt lgkmcnt(0)" ::: "memory");
        float a = b1[C.lane];
        for (int k = 0; k < 33; ++k) a += zb[k] * w1[k * 64 + C.lane];
        const float h1 = sinf(f1[C.lane] * a);
        zb[64 + C.lane] = h1;
        asm volatile("s_waitcnt lgkmcnt(0)" ::: "memory");
        float a2 = b2[C.lane];
        for (int k = 0; k < 64; ++k) a2 += zb[64 + k] * w2[k * 64 + C.lane];
        const float h2 = sinf(f2[C.lane] * a2);
        f16* dst = H2A + (size_t)p * 256;
        dst[C.lane] = (f16)h2;
        if (C.lane < 48) *(u32x2*)(dst + 64 + 4 * C.lane) = (u32x2){0u, 0u};
        asm volatile("s_waitcnt lgkmcnt(0)" ::: "memory");
    }
    { f16* W3T = (f16*)(C.ws + WS_W3T);
      for (int r = gw; r < 4096; r += NGW) { if (C.lane < 48) *(u32x2*)(W3T + (size_t)r * 256 + 64 + 4 * C.lane) = (u32x2){0u, 0u}; } }
}
__device__ __forceinline__ void phase_prologue(const Ctx& C) {
    prologue_mod(C);
    __syncthreads();
    const int gw = C.bid * 8 + C.wave, NGW = C.G * 8;
    int base = 0;
    for (int j = 0; j < 2; ++j) transpose_matrix_items(C, C.in[IN_A_WIN] + (size_t)j * 1024 * 1536, 1024, 1536, (f16*)(C.ws + WS_WA_IN) + (size_t)j * 1536 * 1024, base, gw, NGW);
    for (int j = 0; j < 2; ++j) transpose_matrix_items(C, C.in[IN_A_WOUT] + (size_t)j * 1024 * 1024, 1024, 1024, (f16*)(C.ws + WS_WA_OUT) + (size_t)j * 1024 * 1024, base, gw, NGW);
    transpose_matrix_items(C, C.in[IN_B_WIN], 1024, 3072, (f16*)(C.ws + WS_WB_IN), base, gw, NGW);
    transpose_matrix_items(C, C.in[IN_B_WOUT], 1024, 1024, (f16*)(C.ws + WS_WB_OUT), base, gw, NGW);
    transpose_matrix_items(C, C.in[IN_C_WIN], 1024, 3072, (f16*)(C.ws + WS_WC_IN), base, gw, NGW);
    transpose_matrix_items(C, C.in[IN_C_WOUT], 1024, 1024, (f16*)(C.ws + WS_WC_OUT), base, gw, NGW);
    { LAS float* scr = (LAS float*)(C.lds + C.wave * 16640);
      const int first = (gw - base % NGW + NGW) % NGW;
      for (int it = first; it < 64; it += NGW) transpose_item(C.in[IN_B_W3], 256, 4096, (f16*)(C.ws + WS_W3T), 0, 64 * it, 64 * it, scr, C.lane);
      base += 64; }
    prologue_tables(C, gw, NGW);
}

struct PnSel { const unsigned char* yp[4]; float g[4]; unsigned mask; int cnt; };
template <bool FIRST  > __device__ __forceinline__ void phase_pn_t(const Ctx& C, int layer) {
    const int lane = C.lane;
    const int nrows = layer == DEPTH ? RL : R;
    const float* MOD = (const float*)(C.ws + WS_MOD);
    f16* HH = (f16*)(C.ws + WS_HH);
    const unsigned char* YE = C.ws + WS_ATT;
    const unsigned short* INV = (const unsigned short*)(C.ws + WS_INV);
    const float* AFFL = (const float*)(C.ws + WS_AFFL); const float* AFFC = (const float*)(C.ws + WS_AFFC);
    f16* U = (f16*)(C.ws + WS_U);
    const bool comb = !FIRST;
    const int rpb = (nrows + C.G - 1) / C.G;
    const int rb0 = min(C.bid * rpb, nrows), rb1 = min(rb0 + rpb, nrows), cnt = rb1 - rb0;
    const int r0 = rb0 + (C.wave * cnt) / 8, r1 = rb0 + ((C.wave + 1) * cnt) / 8;
    if (r0 >= r1) return;
    const unsigned lo4 = 4u * (unsigned)lane;
#define PN_HIN(row) ((row) >= RL ? C.in[IN_CTX] + (size_t)((row) - RL) * D : C.in[IN_X] + (size_t)(row) * D)
#define PN_LOAD_INV(dst, row) { const u32x4 a_ = *(const u32x4*)(INV + (size_t)(row) * 16), b_ = *(const u32x4*)(INV + (size_t)(row) * 16 + 8); \
        dst[0] = a_.x; dst[1] = a_.y; dst[2] = a_.z; dst[3] = a_.w; dst[4] = b_.x; dst[5] = b_.y; dst[6] = b_.z; dst[7] = b_.w; }
#define PN_SELECT(sel, iwv, row) { unsigned iw_[8]; _Pragma("unroll") for (int i_ = 0; i_ < 8; ++i_) iw_[i_] = __builtin_amdgcn_readfirstlane(iwv[i_]); \
        unsigned m_ = 0; _Pragma("unroll") for (int e_ = 0; e_ < 16; ++e_) m_ |= (((iw_[e_ >> 1] >> ((e_ & 1) * 16)) & 0xffffu) != 0u ? 1u : 0u) << e_; \
        sel.mask = m_; sel.cnt = __builtin_popcount(m_); const bool isc_ = (row) >= RL; const int rc_ = (row) - RL; const int b_ = isc_ ? (rc_ >> 8) : ((row) >> 13); \
        _Pragma("unroll") for (int k_ = 0; k_ < 4; ++k_) { const bool has_ = m_ != 0u; const int e_ = has_ ? __builtin_ctz(m_) : 0; m_ &= m_ - 1u; \
            unsigned w_ = iw_[0]; _Pragma("unroll") for (int i_ = 1; i_ < 8; ++i_) w_ = ((e_ >> 1) == i_) ? iw_[i_] : w_; \
            const unsigned s_ = has_ ? ((w_ >> ((e_ & 1) * 16)) & 0xffffu) : 1u; \
            sel.yp[k_] = YE + ((size_t)e_ * EROWS + (s_ - 1u)) * D; \
            const float gv_ = isc_ ? AFFC[(size_t)(b_ * 16 + e_) * NCX + (rc_ & 255)] : AFFL[(size_t)(b_ * 16 + e_) * T + ((row) & 8191)]; sel.g[k_] = gv_;   } }
    LAS unsigned char* ybuf = C.lds + C.wave * 16384;
#define PN_DMA(sel, buf) { _Pragma("unroll") for (int k_ = 0; k_ < 4; ++k_) { if (k_ < sel.cnt) { \
            __builtin_amdgcn_global_load_lds((const unsigned*)(sel.yp[k_] + 16 * lane), (LAS unsigned*)(ybuf + (buf) * 8192 + k_ * 2048), 16, 0, 0); } } }
    unsigned iw1[8], iw2[8];
    f32x4 vc[4], vn[4];
    u32x2 hc[4], hn[4];
    PnSel sc, sn;
#pragma unroll
    for (int i = 0; i < 8; ++i) { iw1[i] = 0u; iw2[i] = 0u; }
    sc.mask = 0u; sn.mask = 0u; sc.cnt = 0; sn.cnt = 0;
#pragma unroll
    for (int k = 0; k < 4; ++k) { sc.yp[k] = YE; sc.g[k] = 0.f; sn.yp[k] = YE; sn.g[k] = 0.f; }
    if (comb) { unsigned iw0[8]; PN_LOAD_INV(iw0, r0); PN_SELECT(sn, iw0, r0);
        PN_DMA(sn, (r0 & 1));
        PN_LOAD_INV(iw2, min(r0 + 1, r1 - 1)); }
#pragma unroll
    for (int j = 0; j < 4; ++j) { vc[j] = (f32x4){0.f, 0.f, 0.f, 0.f}; vn[j] = vc[j]; hc[j] = (u32x2){0u, 0u}; hn[j] = hc[j]; }
    if (FIRST) { const float* hp = PN_HIN(r0);
#pragma unroll
      for (int j = 0; j < 4; ++j) vn[j] = *(const f32x4*)(hp + lo4 + 256 * j); }
    else {
#pragma unroll
      for (int j = 0; j < 4; ++j) hn[j] = *(const u32x2*)(HH + (size_t)r0 * D + lo4 + 256 * j); }
    int cur_bb = -1; f32x4 g2v[4], gnv[4], shv[4], scv[4];
#pragma unroll
    for (int j = 0; j < 4; ++j) { g2v[j] = (f32x4){0.f, 0.f, 0.f, 0.f}; gnv[j] = g2v[j]; shv[j] = g2v[j]; scv[j] = g2v[j]; }
    for (int row = r0; row < r1; ++row) {
        const bool more = row + 1 < r1;
        const bool isc = row >= RL; const int rc = row - RL; const int b = isc ? (rc >> 8) : (row >> 13); const int bb = isc ? 4 : b;
        if (bb != cur_bb) { cur_bb = bb;
#pragma unroll
            for (int j = 0; j < 4; ++j) { if (comb) g2v[j] = *(const f32x4*)(MOD + (size_t)((layer - 1) * 5 + bb) * 6144 + 5 * 1024 + lo4 + 256 * j) * (1.0f / YE_SCALE);
                if (layer < DEPTH) { gnv[j] = *(const f32x4*)(C.in[IN_NMIX] + layer * 1024 + lo4 + 256 * j); shv[j] = *(const f32x4*)(MOD + (size_t)(layer * 5 + bb) * 6144 + lo4 + 256 * j); scv[j] = *(const f32x4*)(MOD + (size_t)(layer * 5 + bb) * 6144 + 1024 + lo4 + 256 * j); } } }
        asm volatile("s_waitcnt vmcnt(0)" ::: "memory");
        {
#pragma unroll
            for (int j = 0; j < 4; ++j) { vc[j] = vn[j]; hc[j] = hn[j]; }
            if (comb) {
#pragma unroll
                for (int k = 0; k < 4; ++k) { sc.yp[k] = sn.yp[k]; sc.g[k] = sn.g[k]; }
                sc.mask = sn.mask; sc.cnt = sn.cnt;
#pragma unroll
                for (int i = 0; i < 8; ++i) iw1[i] = iw2[i];
            }
        }
        f32x4 v[4];
#pragma unroll
        for (int j = 0; j < 4; ++j) { if (FIRST) v[j] = vc[j]; else { const f16x4 t = __builtin_bit_cast(f16x4, hc[j]); v[j] = (f32x4){(float)t[0], (float)t[1], (float)t[2], (float)t[3]}; } }
        f32x4 acc[4];
#pragma unroll
        for (int j = 0; j < 4; ++j) acc[j] = (f32x4){0.f, 0.f, 0.f, 0.f};
        if (comb) {
#pragma unroll
            for (int k = 0; k < 4; ++k) { if (k < sc.cnt) {
#pragma unroll
                for (int j = 0; j < 4; ++j) { const int y = *(const LAS int*)(ybuf + (row & 1) * 8192 + k * 2048 + 4 * lane + 256 * j);
                    const f32x2 ya = __builtin_amdgcn_cvt_pk_f32_fp8(y, false), yb = __builtin_amdgcn_cvt_pk_f32_fp8(y, true); acc[j] += (f32x4){ya[0], ya[1], yb[0], yb[1]} * sc.g[k]; } } }
            unsigned rest = sc.mask; rest &= rest - 1u; rest &= rest - 1u; rest &= rest - 1u; rest &= rest - 1u;
            while (rest) { const int e = __builtin_ctz(rest); rest &= rest - 1u;
                const unsigned s = __builtin_amdgcn_readfirstlane((unsigned)INV[(size_t)row * 16 + e]);
                const float g = isc ? AFFC[(size_t)(b * 16 + e) * NCX + (rc & 255)] : AFFL[(size_t)(b * 16 + e) * T + (row & 8191)];
                const unsigned char* ye = YE + ((size_t)e * EROWS + (s - 1u)) * D + lo4;
#pragma unroll
                for (int j = 0; j < 4; ++j) { const int y = *(const int*)(ye + 256 * j); const f32x2 ya = __builtin_amdgcn_cvt_pk_f32_fp8(y, false), yb = __builtin_amdgcn_cvt_pk_f32_fp8(y, true); acc[j] += (f32x4){ya[0], ya[1], yb[0], yb[1]} * g; } }
            asm volatile("s_waitcnt lgkmcnt(0)" ::: "memory");
        }
        { const int rn = min(row + 1, r1 - 1);
            if (comb) { PN_SELECT(sn, iw1, rn);
                PN_LOAD_INV(iw2, min(row + 2, r1 - 1));
                if (more) PN_DMA(sn, (rn & 1)); }
            if (FIRST) { const float* hp = PN_HIN(rn);
#pragma unroll
                for (int j = 0; j < 4; ++j) vn[j] = *(const f32x4*)(hp + lo4 + 256 * j); }
            else {
#pragma unroll
                for (int j = 0; j < 4; ++j) hn[j] = *(const u32x2*)(HH + (size_t)rn * D + lo4 + 256 * j); }
        }
        if (comb) {
#pragma unroll
            for (int j = 0; j < 4; ++j) { v[j] += g2v[j] * acc[j];
                if (layer == DEPTH) *(f32x4*)(C.out + (size_t)row * D + lo4 + 256 * j) = v[j];
                else { u32x2 w; w.x = pkh(v[j].x, v[j].y); w.y = pkh(v[j].z, v[j].w); *(u32x2*)(HH + (size_t)row * D + lo4 + 256 * j) = w; } }
        }
        if (layer < DEPTH) {
            float ss = 0.f;
#pragma unroll
            for (int j = 0; j < 4; ++j) ss += (v[j].x * v[j].x + v[j].y * v[j].y) + (v[j].z * v[j].z + v[j].w * v[j].w);
            const float rstd = 1.0f / sqrtf(wave_sum(ss) * (1.0f / D) + NORM_EPS);
#pragma unroll
            for (int j = 0; j < 4; ++j) { const f32x4 u = (v[j] * rstd) * gnv[j] * (scv[j] + 1.0f) + shv[j]; u32x2 w; w.x = pkh(u.x, u.y); w.y = pkh(u.z, u.w);
                *(u32x2*)(U + (size_t)row * D + lo4 + 256 * j) = w; }
        }
    }
#undef PN_HIN
#undef PN_LOAD_INV
#undef PN_SELECT
#undef PN_DMA
}
__device__ __forceinline__ void phase_pn(const Ctx& C, int layer) { if (layer == 0) phase_pn_t<true>(C, 0); else phase_pn_t<false>(C, layer); }
__device__ __forceinline__ void phase_pf(const Ctx& C, int layer) {
    int lane = C.lane, wave = C.wave; asm volatile("" : "+v"(lane));
    const int nrows = layer == DEPTH - 1 ? RL : R;
    const int ngroups = nrows >> 4;
    const int g0 = (int)(((long)C.bid * ngroups) / C.G), g1 = (int)(((long)(C.bid + 1) * ngroups) / C.G);
    LAS float* part = (LAS float*)C.lds;
    const float* MOD = (const float*)(C.ws + WS_MOD);
    const f16* HH = (const f16*)(C.ws + WS_HH);
    float* AFFL = (float*)(C.ws + WS_AFFL); float* AFFC = (float*)(C.ws + WS_AFFC);
    unsigned* INVw = (unsigned*)(C.ws + WS_INV);
    unsigned char* U8 = C.ws + WS_U;
    int* ROWIDX = (int*)(C.ws + WS_ROWIDX);
    { const int gw = C.bid * 8 + wave; if (gw < 64) { const int i = gw * 64 + lane; ROWIDX[(i >> 8) * EROWS + 4096 + (i & 255)] = 0; } }
    const float* Wr = C.in[IN_ROUTER] + (size_t)layer * 1024 * 16;
    const int q = lane >> 4, e = lane & 15, kb = 128 * wave + 8 * q;
    __syncthreads();
    f16x8 Bf[4]; unsigned gsh[4][4], shh[4][4]; float s2 = 0.f; int cur_bb = -1;
#pragma unroll
    for (int j = 0; j < 4; ++j) { Bf[j] = (f16x8){0, 0, 0, 0, 0, 0, 0, 0};
#pragma unroll
        for (int i = 0; i < 4; ++i) { gsh[j][i] = 0u; shh[j][i] = 0u; } }
    u32x4 xn[4];
    if (g0 < g1) {
#pragma unroll
        for (int j = 0; j < 4; ++j) xn[j] = *(const u32x4*)(HH + (size_t)(16 * g0 + e) * D + kb + 32 * j); }
    for (int g = g0; g < g1; ++g) {
        const int row0 = 16 * g; const bool isc = row0 >= RL; const int bb = isc ? 4 : (row0 >> 13);
        LAS float* pw = part + ((g & 1) * 8) * 288;
        if (bb != cur_bb) { cur_bb = bb;
            const float* gn = C.in[IN_NFFN] + layer * 1024; const float* sh = MOD + (size_t)(layer * 5 + bb) * 6144 + 3 * 1024; const float* sc = sh + 1024;
            float s2p = 0.f;
#pragma unroll
            for (int j = 0; j < 4; ++j) { const int k0 = kb + 32 * j;
                const f32x4 ga = *(const f32x4*)(gn + k0), gb = *(const f32x4*)(gn + k0 + 4), sa = *(const f32x4*)(sc + k0), sb2 = *(const f32x4*)(sc + k0 + 4), ha = *(const f32x4*)(sh + k0), hb = *(const f32x4*)(sh + k0 + 4);
                float gs[8], hv[8];
#pragma unroll
                for (int i = 0; i < 4; ++i) { gs[i] = ga[i] * (sa[i] + 1.0f); gs[4 + i] = gb[i] * (sb2[i] + 1.0f); hv[i] = ha[i]; hv[4 + i] = hb[i]; }
                f16x8 bfr;
#pragma unroll
                for (int i = 0; i < 8; ++i) { const float wv = Wr[(size_t)(k0 + i) * 16 + e]; bfr[i] = (f16)(gs[i] * wv); s2p += hv[i] * wv; }
                Bf[j] = bfr;
#pragma unroll
                for (int i = 0; i < 4; ++i) { gsh[j][i] = pkh(gs[2 * i], gs[2 * i + 1]); shh[j][i] = pkh(hv[2 * i], hv[2 * i + 1]); } }
            s2p += swz_xor<16>(s2p); s2 = sum_xor32(s2p); }
        f16x8 xa[4];
#pragma unroll
        for (int j = 0; j < 4; ++j) xa[j] = __builtin_bit_cast(f16x8, xn[j]);
        { const int gn2 = min(g + 1, g1 - 1);
#pragma unroll
          for (int j = 0; j < 4; ++j) xn[j] = *(const u32x4*)(HH + (size_t)(16 * gn2 + e) * D + kb + 32 * j); }
        f32x4 acc = (f32x4){0.f, 0.f, 0.f, 0.f}; float ss = 0.f;
#pragma unroll
        for (int j = 0; j < 4; ++j) { acc = __builtin_amdgcn_mfma_f32_16x16x32_f16(xa[j], Bf[j], acc, 0, 0, 0);
#pragma unroll
            for (int i = 0; i < 8; ++i) { const float xv = (float)xa[j][i]; ss += xv * xv; } }
        ss += swz_xor<16>(ss); ss = sum_xor32(ss);
        LAS float* mine = pw + wave * 288;
#pragma unroll
        for (int i = 0; i < 4; ++i) mine[(4 * q + i) * 16 + e] = acc[i];
        if (lane < 16) { mine[256 + lane] = ss; mine[272 + lane] = s2; }
        __syncthreads();
        float sst = 0.f;
#pragma unroll
        for (int w2 = 0; w2 < 8; ++w2) sst += pw[w2 * 288 + 256 + e];
        const float rstd = 1.0f / sqrtf(sst * (1.0f / D) + NORM_EPS);
        unsigned char* up = U8 + (size_t)(row0 + e) * D + kb;
#pragma unroll
        for (int j = 0; j < 4; ++j) { float u[8];
#pragma unroll
            for (int i = 0; i < 4; ++i) { const f32x2 gsv = h2f_(gsh[j][i]), shv = h2f_(shh[j][i]);
                u[2 * i] = ((float)xa[j][2 * i] * rstd) * gsv[0] + shv[0]; u[2 * i + 1] = ((float)xa[j][2 * i + 1] * rstd) * gsv[1] + shv[1]; }
            u32x2 o; o.x = pk8(u[0], u[1], u[2], u[3]); o.y = pk8(u[4], u[5], u[6], u[7]);
            *(u32x2*)(up + 32 * j) = o; }
        { const int r = 2 * wave + ((lane >> 4) & 1);
          float lgt = 0.f, sr = 0.f, s2t = 0.f;
#pragma unroll
          for (int w2 = 0; w2 < 8; ++w2) { lgt += pw[w2 * 288 + r * 16 + e]; sr += pw[w2 * 288 + 256 + r]; s2t += pw[w2 * 288 + 272 + e]; }
          lgt = lgt * (1.0f / sqrtf(sr * (1.0f / D) + NORM_EPS)) + s2t;
          float mx = lgt; mx = fmaxf(mx, swz_xor<1>(mx)); mx = fmaxf(mx, swz_xor<2>(mx)); mx = fmaxf(mx, swz_xor<4>(mx)); mx = fmaxf(mx, swz_xor<8>(mx));
          const float pe = expf(lgt - mx);
          float sum = pe; sum += swz_xor<1>(sum); sum += swz_xor<2>(sum); sum += swz_xor<4>(sum); sum += swz_xor<8>(sum);
          const float aff = pe / sum;
          const int row = row0 + r, rc = row - RL;
          float* dst = isc ? AFFC + (size_t)((rc >> 8) * 16 + e) * NCX + (rc & 255) : AFFL + (size_t)((row >> 13) * 16 + e) * T + (row & 8191);
          if (lane < 32) *dst = aff;
          if (lane < 16) INVw[(size_t)(row0 + 2 * wave) * 8 + lane] = 0u; }
    }
}

template <int EPT>
__device__ __forceinline__ void topk_unit(const Ctx& C, const float* vals, int nact  , int K, int e, int rowbase, int slotbase) {
    LAS unsigned* hist = (LAS unsigned*)C.lds;
    LAS unsigned* res = hist + 256;
    LAS unsigned* wtot = hist + 264;
    const int tid = C.tid, lane = C.lane; const bool active = tid < nact;
    unsigned key[EPT];
    if (EPT == 16) {
#pragma unroll
        for (int j = 0; j < 4; ++j) { const u32x4 w = active ? *(const u32x4*)(vals + tid * 16 + 4 * j) : (u32x4){0u, 0u, 0u, 0u}; key[4 * j] = w.x; key[4 * j + 1] = w.y; key[4 * j + 2] = w.z; key[4 * j + 3] = w.w; }
    } else {
#pragma unroll
        for (int j = 0; j < EPT; ++j) key[j] = active ? __float_as_uint(vals[tid * EPT + j]) : 0u;
    }
    unsigned prefix = 0u, mask = 0u; int remaining = K;
    for (int pass = 0; pass < 4; ++pass) {
        const int shift = 24 - 8 * pass;
        if (tid < 256) hist[tid] = 0u;
        __syncthreads();
        if (active) {
#pragma unroll
            for (int j = 0; j < EPT; ++j) if ((key[j] & mask) == prefix) __hip_atomic_fetch_add(&hist[(key[j] >> shift) & 255u], 1u, __ATOMIC_RELAXED, __HIP_MEMORY_SCOPE_WORKGROUP);
        }
        __syncthreads();
        if (C.wave == 0) {
            const unsigned c0 = hist[4 * lane], c1 = hist[4 * lane + 1], c2 = hist[4 * lane + 2], c3 = hist[4 * lane + 3];
            const unsigned tot = c0 + c1 + c2 + c3; unsigned suf = tot;
#pragma unroll
            for (int o = 1; o < 64; o <<= 1) { const unsigned t = (unsigned)__builtin_amdgcn_ds_bpermute(((lane + o) & 63) << 2, (int)suf); if (lane + o < 64) suf += t; }
            const unsigned above = suf - tot;
            if ((int)above < remaining && remaining <= (int)suf) {
                unsigned a = above; int d = -1; unsigned nr = 0;
                const unsigned cs[4] = {c0, c1, c2, c3};
#pragma unroll
                for (int bq = 3; bq >= 0; --bq) { if (d < 0) { if ((int)(a + cs[bq]) >= remaining) { d = 4 * lane + bq; nr = (unsigned)remaining - a; } else a += cs[bq]; } }
                res[0] = (unsigned)d; res[1] = nr;
            }
        }
        __syncthreads();
        const unsigned d = res[0]; remaining = (int)res[1];
        prefix |= d << shift; mask |= 0xFFu << shift;
    }
    const unsigned Tk = prefix; const int need_eq = remaining;
    unsigned gt = 0, eq = 0;
    if (active) {
#pragma unroll
        for (int j = 0; j < EPT; ++j) { gt += key[j] > Tk; eq += key[j] == Tk; }
    }
    const unsigned packed = gt | (eq << 16);
    unsigned incl = packed;
#pragma unroll
    for (int o = 1; o < 64; o <<= 1) { const unsigned t = (unsigned)__builtin_amdgcn_ds_bpermute(((lane - o) & 63) << 2, (int)incl); if (lane >= o) incl += t; }
    if (lane == 63) wtot[C.wave] = incl;
    __syncthreads();
    unsigned pre = 0;
    for (int w = 0; w < C.wave; ++w) pre += wtot[w];
    const unsigned excl = pre + incl - packed;
    unsigned gtb = excl & 0xffffu, eqb = excl >> 16;
    const unsigned total_gt = (unsigned)(K - need_eq);
    int* ROWIDX = (int*)(C.ws + WS_ROWIDX); unsigned short* INV = (unsigned short*)(C.ws + WS_INV);
    if (active) {
#pragma unroll
        for (int j = 0; j < EPT; ++j) {
            int slot = -1;
            if (key[j] > Tk) { slot = (int)gtb; ++gtb; }
            else if (key[j] == Tk) { if ((int)eqb < need_eq) slot = (int)(total_gt + eqb); ++eqb; }
            if (slot >= 0) { const int idx = tid * EPT + j; ROWIDX[e * EROWS + slotbase + slot] = rowbase + idx; INV[(size_t)(rowbase + idx) * 16 + e] = (unsigned short)(slotbase + slot + 1); }
        }
    }
    __syncthreads();
}
__device__ __forceinline__ void phase_topk(const Ctx& C, int layer) {
    const int nunits = layer == DEPTH - 1 ? 64 : 128;
    for (int u = C.bid; u < nunits; u += C.G) {
        if (u < 64) { const int b = u >> 4, e = u & 15; topk_unit<16>(C, (const float*)(C.ws + WS_AFFL) + (size_t)(b * 16 + e) * T, 512, CAPL, e, b * T, b * CAPL); }
        else { const int v = u - 64, b = v >> 4, e = v & 15; topk_unit<1>(C, (const float*)(C.ws + WS_AFFC) + (size_t)(b * 16 + e) * NCX, 256, CAPC, e, RL + b * NCX, NB * CAPL + b * CAPC); }
    }
}
constexpr int CV_ITEMS = NE * 1536;
constexpr int CV_IPB0 = 48, CV_IPB1 = 24, CV_IPB2 = 24;
__device__ __forceinline__ int cv_n0(int layer, int G) { return (G == 256 && layer >= 1) ? 192 * CV_IPB0 : 0; }
__device__ __forceinline__ int cv_idle1(int layer) { const int nwg = (R / 256) * ((layer % 3) == 0 ? 6 : 12); return 256 - nwg % 256; }
__device__ __forceinline__ int cv_n1(int layer, int G) { return G == 256 ? cv_idle1(layer) * CV_IPB1 : 0; }
__device__ __forceinline__ int cv_n2(int layer, int G) { return (G == 256 && layer < DEPTH - 1) ? 240 * CV_IPB2 : 0; }
__device__ __forceinline__ void convert_items(const Ctx& C, int layer, int first, int count  ) {
    LAS float* scr = (LAS float*)(C.lds + C.wave * 16640); const int lane = C.lane;
    unsigned char* WEGU = C.ws + ((layer & 1) ? WS_WEGU2 : WS_WEGU); unsigned char* WED = C.ws + ((layer & 1) ? WS_WED2 : WS_WED);
    const int end = min(first + count, CV_ITEMS);
    for (int it = first + C.wave; it < end; it += 8) {
        const int e = it / 1536, r = it % 1536, kind = r >> 9, q = r & 511;
        if (kind < 2) { const int kb = q >> 5, nb = q & 31, n0 = 64 * nb; const float* W = C.in[kind == 0 ? IN_WGATE : IN_WUP] + ((size_t)layer * NE + e) * 1024 * 2048;
            transpose_item8(W, 1024, 2048, WEGU + (size_t)e * 4096 * 1024, 64 * kb, n0, (n0 >> 7) * 256 + (n0 & 127) + kind * 128, scr, lane); }
        else { const int kb = q >> 4, nb = q & 15; const float* W = C.in[IN_WDOWN] + ((size_t)layer * NE + e) * 2048 * 1024;
            transpose_item8(W, 2048, 1024, WED + (size_t)e * 1024 * 2048, 64 * kb, 64 * nb, 64 * nb, scr, lane); }
    }
}
constexpr int CV_TOPK_EQ = 16;
__device__ __forceinline__ void phase_topk_convert(const Ctx& C, int layer) {
    const int ntk = min(layer == DEPTH - 1 ? 64 : 128, C.G);
    phase_topk(C, layer);
    __syncthreads();
    const int done = cv_n0(layer, C.G) + cv_n1(layer, C.G) + cv_n2(layer, C.G);
    const int rem = CV_ITEMS - done; if (rem <= 0) return;
    const int share = (rem + CV_TOPK_EQ * ntk + C.G - 1) / C.G, small = max(share - CV_TOPK_EQ, 0);
    const int first = C.bid < ntk ? C.bid * small : ntk * small + (C.bid - ntk) * share, cnt = C.bid < ntk ? small : share;
    if (first < rem) convert_items(C, layer, done + first, min(cnt, rem - first));
}

struct AttnSt { f32x4 o[4][4]; float m[4]; float l[4]; };
__device__ __forceinline__ f16x4 tr_read(const LAS char* p) { return __builtin_bit_cast(f16x4, __builtin_amdgcn_ds_read_tr16_b64_v4i16((LAS v4i16*)p)); }
template <int QLO, int QHI, int MODE>
__device__ __forceinline__ void attn_block32(AttnSt& st, const f16x8 (&q)[4][2], const f16x8 (&kf)[2][2], const LAS char* vb, int lane, int p0, int p1, const LAS float* bias) {
    const int h = lane >> 4, li = lane & 15;
    f16x8 vf[4];
    const LAS char* va = vb + (4 * h + (li >> 2)) * 160 + (li & 3) * 8;
#pragma unroll
    for (int dt = 0; dt < 4; ++dt) { const f16x4 a = tr_read(va + dt * 32), b = tr_read(va + 16 * 160 + dt * 32); vf[dt] = (f16x8){a[0], a[1], a[2], a[3], b[0], b[1], b[2], b[3]}; }
    f32x4 sa[4][2];
#pragma unroll
    for (int qt = QLO; qt < QHI; ++qt)
#pragma unroll
        for (int kt = 0; kt < 2; ++kt) { f32x4 z = (f32x4){0.f, 0.f, 0.f, 0.f};
            z = __builtin_amdgcn_mfma_f32_16x16x32_f16(kf[kt][0], q[qt][0], z, 0, 0, 0); sa[qt][kt] = __builtin_amdgcn_mfma_f32_16x16x32_f16(kf[kt][1], q[qt][1], z, 0, 0, 0); }
#pragma unroll
    for (int qp = QLO; qp < QHI; qp += 2) {
        f16x8 pf[2];
#pragma unroll
        for (int u = 0; u < 2; ++u) { const int qt = qp + u; if (qt >= QHI) continue;
            float s[8] = {sa[qt][0][0], sa[qt][0][1], sa[qt][0][2], sa[qt][0][3], sa[qt][1][0], sa[qt][1][1], sa[qt][1][2], sa[qt][1][3]};
            if (MODE == 1) {
                if (p1 < (1 << 20)) {
#pragma unroll
                    for (int i = 0; i < 8; ++i) { const int dlt = p0 + 16 * (i >> 2) + 4 * h + (i & 3) - (16 * qt + li); s[i] = (abs(dlt) <= p1) ? s[i] : -INFINITY; }
                }
            }
            if (MODE == 2) {
                const int qc = 16 * qt + li; const int cs = min(max(qc - 8, 0), 48);
#pragma unroll
                for (int i = 0; i < 8; ++i) { const int kc = p0 + 16 * (i >> 2) + 4 * h + (i & 3); const bool ok = (unsigned)(kc - cs) < 16u; const int bi = min(max(p1 + kc - qc + 15, 0), 464);
                    s[i] += bias[bi]; s[i] = ok ? s[i] : -INFINITY; }
            }
            float mx = fmaxf(fmaxf(fmaxf(s[0], s[1]), fmaxf(s[2], s[3])), fmaxf(fmaxf(s[4], s[5]), fmaxf(s[6], s[7])));
            mx = fmaxf(mx, swz_xor<16>(mx)); mx = max_xor32(mx);
            if (__builtin_amdgcn_ballot_w64(mx > st.m[qt] + 8.0f) != 0ull) {
                const float mnew = fmaxf(st.m[qt], mx); const float alpha = __builtin_amdgcn_exp2f(st.m[qt] - mnew);
                st.l[qt] *= alpha; st.m[qt] = mnew;
#pragma unroll
                for (int dt = 0; dt < 4; ++dt) st.o[dt][qt] = st.o[dt][qt] * alpha;
            }
            const float mcur = st.m[qt];
            float rs = 0.f;
#pragma unroll
            for (int i = 0; i < 8; ++i) { s[i] = __builtin_amdgcn_exp2f(s[i] - mcur); rs += s[i]; }
            st.l[qt] += rs;
            pf[u] = (f16x8){(f16)s[0], (f16)s[1], (f16)s[2], (f16)s[3], (f16)s[4], (f16)s[5], (f16)s[6], (f16)s[7]};
        }
#pragma unroll
        for (int u = 0; u < 2; ++u) { const int qt = qp + u; if (qt >= QHI) continue;
#pragma unroll
            for (int dt = 0; dt < 4; ++dt) st.o[dt][qt] = __builtin_amdgcn_mfma_f32_16x16x32_f16(vf[dt], pf[u], st.o[dt][qt], 0, 0, 0); }
        __builtin_amdgcn_sched_barrier(0);
    }
}
__device__ __forceinline__ void attn_init(AttnSt& st, float m0, float l0) {
#pragma unroll
    for (int qt = 0; qt < 4; ++qt) { st.m[qt] = m0; st.l[qt] = l0;
#pragma unroll
        for (int dt = 0; dt < 4; ++dt) st.o[dt][qt] = (f32x4){0.f, 0.f, 0.f, 0.f}; }
}
__device__ __forceinline__ void attn_store(AttnSt& st, f16* O, size_t row0, int col0, int lane) {
    const int h = lane >> 4, li = lane & 15;
#pragma unroll
    for (int qt = 0; qt < 4; ++qt) { float l = st.l[qt]; l += swz_xor<16>(l); l = sum_xor32(l); const float inv = 1.0f / l;
        f16* rp = O + row0 * D + col0;
        const unsigned lo2 = (unsigned)(li * D + 4 * h) + (unsigned)(16 * qt * D);
#pragma unroll
        for (int dt = 0; dt < 4; ++dt) { const f32x4 v = st.o[dt][qt] * inv; u32x2 w; w.x = pkh(v[0], v[1]); w.y = pkh(v[2], v[3]); *(u32x2*)(rp + (lo2 + (unsigned)(16 * dt))) = w; } }
}
__device__ __forceinline__ void load_q(f16x8 (&q)[4][2], const f16* Q  , int lane) {
    const unsigned loff = (unsigned)((lane & 15) * 64 + 8 * (lane >> 4));
#pragma unroll
    for (int qt = 0; qt < 4; ++qt)
#pragma unroll
        for (int ks = 0; ks < 2; ++ks) q[qt][ks] = *(const f16x8*)(Q + (loff + (unsigned)(qt * 1024 + ks * 32)));
}

constexpr size_t AT_QR = 0, AT_QP = 64 * MiB, AT_KR = 128 * MiB, AT_VV = 144 * MiB, AT_QC = 160 * MiB, AT_KC = 162 * MiB, AT_VC = 163 * MiB;
constexpr size_t CT_Q = 0, CT_K = 64 * MiB, CT_V = 128 * MiB, CT_QC = 192 * MiB, CT_KC = 194 * MiB, CT_VC = 196 * MiB;
template <int KIND  > struct EpiQKV {
    static constexpr bool PERM = false, SWAP = false; static constexpr int BPERM = 2;
    unsigned char* AT; const float* qg; const float* kg; const float* rope; bool need_ctx;
    __device__ __forceinline__ void operator()(const f32x4 (&acc)[2][2][4][2], const pg8::Unit& u, int wr, int wc, int fr_, int fq_) const {
        int fr = fr_, fq = fq_; asm volatile("" : "+v"(fr), "+v"(fq));
        const bool isc = u.pm >= 128; const int b = isc ? (u.pm - 128) : (u.pm >> 5); const int t0 = isc ? 0 : (u.pm & 31) * 256; const int len = isc ? NCX : T;
        int role, head, nh;
        if (KIND == 0) { role = u.pn < 4 ? 0 : (u.pn == 4 ? 1 : 2); head = (u.pn < 4 ? 4 * u.pn : 0) + wc; nh = role == 0 ? 16 : 4; }
        else { role = u.pn >> 2; head = 4 * (u.pn & 3) + wc; nh = 16; }
        if (role == 0 && isc && !need_ctx) return;
        size_t off0, off1 = 0;
        if (KIND == 0) { if (role == 0) { off0 = isc ? AT_QC : AT_QP; off1 = AT_QR; } else if (role == 1) off0 = isc ? AT_KC : AT_KR; else off0 = isc ? AT_VC : AT_VV; }
        else { if (role == 0) off0 = isc ? CT_QC : CT_Q; else if (role == 1) off0 = isc ? CT_KC : CT_K; else off0 = isc ? CT_VC : CT_V; }
        f16* dst0 = (f16*)(AT + off0) + (size_t)(b * nh + head) * len * 64; f16* dst1 = (f16*)(AT + off1) + (size_t)(b * nh + head) * len * 64;
        const float* gp = role == 0 ? qg : kg;
        f32x4 gv[2][2];
#pragma unroll
        for (int bj = 0; bj < 2; ++bj)
#pragma unroll
            for (int n = 0; n < 2; ++n) gv[bj][n] = *(const f32x4*)(gp + 32 * bj + 16 * n + 4 * fq);
        const float osc = role == 0 ? QSCALE : 1.0f;
        const bool rot = (KIND == 0) && !isc && role < 2;
#pragma unroll
        for (int ai = 0; ai < 2; ++ai)
#pragma unroll
            for (int m = 0; m < 4; ++m) {
                const int t = t0 + ai * 128 + wr * 64 + m * 16 + fr;
                f32x4 y[2][2];
#pragma unroll
                for (int bj = 0; bj < 2; ++bj)
#pragma unroll
                    for (int n = 0; n < 2; ++n) y[bj][n] = acc[ai][bj][m][n];
                if (role < 2) {
                    float ss = 0.f;
#pragma unroll
                    for (int bj = 0; bj < 2; ++bj)
#pragma unroll
                        for (int n = 0; n < 2; ++n) ss += (y[bj][n].x * y[bj][n].x + y[bj][n].y * y[bj][n].y) + (y[bj][n].z * y[bj][n].z + y[bj][n].w * y[bj][n].w);
                    ss += swz_xor<16>(ss); ss = sum_xor32(ss);
                    const float r = 1.0f / sqrtf(ss * (1.0f / 64.0f) + NORM_EPS);
#pragma unroll
                    for (int bj = 0; bj < 2; ++bj)
#pragma unroll
                        for (int n = 0; n < 2; ++n) y[bj][n] = y[bj][n] * r * gv[bj][n];
                }
                f16* p0 = dst0 + (size_t)t * 64 + 4 * fq;
                if (!(KIND == 0 && role == 1 && !isc)) {
#pragma unroll
                    for (int bj = 0; bj < 2; ++bj)
#pragma unroll
                        for (int n = 0; n < 2; ++n) { const f32x4 v = y[bj][n] * osc; u32x2 w; w.x = pkh(v.x, v.y); w.y = pkh(v.z, v.w); *(u32x2*)(p0 + 32 * bj + 16 * n) = w; }
                }
                if (rot) {
                    f16* p1 = (role == 0 ? dst1 : dst0) + (size_t)t * 64 + 4 * fq;
#pragma unroll
                    for (int bj = 0; bj < 2; ++bj) { const int pos = bj == 0 ? (t >> 6) : (t & 63);
                        const f32x4 cs = *(const f32x4*)(rope + pos * 16 + 4 * fq), sn = *(const f32x4*)(rope + 2048 + pos * 16 + 4 * fq);
                        const f32x4 r0 = (y[bj][0] * cs - y[bj][1] * sn) * osc, r1 = (y[bj][1] * cs + y[bj][0] * sn) * osc;
                        u32x2 w0, w1; w0.x = pkh(r0.x, r0.y); w0.y = pkh(r0.z, r0.w); w1.x = pkh(r1.x, r1.y); w1.y = pkh(r1.z, r1.w);
                        *(u32x2*)(p1 + 32 * bj) = w0; *(u32x2*)(p1 + 32 * bj + 16) = w1; }
                }
            }
    }
};
__device__ __forceinline__ void head_norm8(const float (&x)[8], const float* g, float (&y)[8]) {
    float ss = 0.f;
#pragma unroll
    for (int i = 0; i < 8; ++i) ss += x[i] * x[i];
    ss += swz_xor<1>(ss); ss += swz_xor<2>(ss); ss += swz_xor<4>(ss);
    const float r = 1.0f / sqrtf(ss * (1.0f / 64.0f) + NORM_EPS);
#pragma unroll
    for (int i = 0; i < 8; ++i) y[i] = x[i] * r * g[i];
}
__device__ __forceinline__ u32x4 pack8(const float (&y)[8], float sc) { u32x4 w; w.x = pkh(y[0] * sc, y[1] * sc); w.y = pkh(y[2] * sc, y[3] * sc); w.z = pkh(y[4] * sc, y[5] * sc); w.w = pkh(y[6] * sc, y[7] * sc); return w; }
__device__ __forceinline__ void phase_prep_a(const Ctx& C, int j  , bool need_ctx) {
    const int gw = C.bid * 8 + C.wave, NGW = C.G * 8, lane = C.lane;
    const f16* P = (const f16*)(C.ws + WS_P); unsigned char* AT = C.ws + WS_ATT;
    const float* rope = (const float*)(C.ws + WS_ROPE);
    const int d0 = 8 * (lane & 7), sub = lane & 7;
    float qg[8], kg[8];
#pragma unroll
    for (int i = 0; i < 8; ++i) { qg[i] = C.in[IN_A_QG][j * 64 + d0 + i]; kg[i] = C.in[IN_A_KG][j * 64 + d0 + i]; }
    for (int row = gw; row < R; row += NGW) {
        const bool isc = row >= RL; const int rc = row - RL; const int b = isc ? (rc >> 8) : (row >> 13); const int t = isc ? (rc & 255) : (row & 8191); const int len = isc ? NCX : T;
        const f16* pr = P + (size_t)row * 1536;
        const int pos = (sub < 4) ? (t >> 6) : (t & 63); const int f0 = 8 * (sub & 1);
        float cs[8], sn[8];
#pragma unroll
        for (int i = 0; i < 8; ++i) { cs[i] = rope[pos * 16 + f0 + i]; sn[i] = rope[2048 + pos * 16 + f0 + i]; }
        const bool is_x1 = !(sub & 2);
#pragma unroll
        for (int jj = 0; jj < 3; ++jj) {
            float x[8], y[8]; unpack8(*(const u32x4*)(pr + 512 * jj + 8 * lane), x);
            const bool isv = (jj == 2) && (lane >= 32);
            head_norm8(x, jj < 2 ? qg : kg, y);
            float ro[8];
#pragma unroll
            for (int i = 0; i < 8; ++i) { const float py = swz_xor<2>(y[i]); ro[i] = is_x1 ? y[i] * cs[i] - py * sn[i] : y[i] * cs[i] + py * sn[i]; }
            if (jj < 2) {
                const int hq = 8 * jj + (lane >> 3);
                if (!isc) { const size_t o = ((size_t)(b * 16 + hq) * T + t) * 64 + d0; *(u32x4*)((f16*)(AT + AT_QP) + o) = pack8(y, QSCALE); *(u32x4*)((f16*)(AT + AT_QR) + o) = pack8(ro, QSCALE); }
                else if (need_ctx) { const size_t o = ((size_t)(b * 16 + hq) * NCX + t) * 64 + d0; *(u32x4*)((f16*)(AT + AT_QC) + o) = pack8(y, QSCALE); }
            } else {
                const int hk = (lane & 31) >> 3; const size_t o = ((size_t)(b * 4 + hk) * len + t) * 64 + d0;
                f16* dst = (f16*)(AT + (isv ? (isc ? AT_VC : AT_VV) : (isc ? AT_KC : AT_KR))) + o;
                *(u32x4*)dst = isv ? pack8(x, 1.0f) : (isc ? pack8(y, 1.0f) : pack8(ro, 1.0f));
            }
        }
    }
}
__device__ __forceinline__ void phase_prep_c(const Ctx& C, bool need_ctx) {
    const int gw = C.bid * 8 + C.wave, NGW = C.G * 8, lane = C.lane;
    const f16* P = (const f16*)(C.ws + WS_P); unsigned char* AT = C.ws + WS_ATT;
    const int d0 = 8 * (lane & 7);
    float qg[8], kg[8];
#pragma unroll
    for (int i = 0; i < 8; ++i) { qg[i] = C.in[IN_C_QG][d0 + i]; kg[i] = C.in[IN_C_KG][d0 + i]; }
    for (int row = gw; row < R; row += NGW) {
        const bool isc = row >= RL; const int rc = row - RL; const int b = isc ? (rc >> 8) : (row >> 13); const int t = isc ? (rc & 255) : (row & 8191); const int len = isc ? NCX : T;
        const f16* pr = P + (size_t)row * 3072;
#pragma unroll
        for (int jj = 0; jj < 6; ++jj) {
            float x[8], y[8]; unpack8(*(const u32x4*)(pr + 512 * jj + 8 * lane), x);
            head_norm8(x, jj < 2 ? qg : kg, y);
            const int hh = 8 * (jj & 1) + (lane >> 3); const size_t o = ((size_t)(b * 16 + hh) * len + t) * 64 + d0;
            if (jj < 2) { if (!isc) *(u32x4*)((f16*)(AT + CT_Q) + o) = pack8(y, QSCALE); else if (need_ctx) *(u32x4*)((f16*)(AT + CT_QC) + o) = pack8(y, QSCALE); }
            else if (jj < 4) *(u32x4*)((f16*)(AT + (isc ? CT_KC : CT_K)) + o) = pack8(y, 1.0f);
            else *(u32x4*)((f16*)(AT + (isc ? CT_VC : CT_V)) + o) = pack8(x, 1.0f);
        }
    }
}

__device__ __forceinline__ void phase_attn_a(const Ctx& C, int j, bool need_ctx) {
    const int lane = C.lane, tid = C.tid, wave = C.wave;
    unsigned char* AT = C.ws + WS_ATT; f16* O = (f16*)(C.ws + WS_O);
    const int nctx = need_ctx ? 32 : 0, nunits = nctx + 1024;
    const int g = wave >> 1, half = wave & 1;
    const int srow = tid >> 3, sch = tid & 7;
    for (int u = C.bid; u < nunits; u += C.G) {
        const bool cu = u < nctx;
        int b, hk, i;
        if (cu) { b = u >> 3; hk = (u >> 1) & 3; i = u & 1; } else { const int v = u - nctx; b = v >> 8; i = (v >> 2) & 63; hk = v & 3; }
        const int hq = hk * 4 + g;
        const int q0 = i * 128 + half * 64;
        const f16* KRb = (const f16*)(AT + AT_KR) + (size_t)(b * 4 + hk) * T * 64; const f16* VVb = (const f16*)(AT + AT_VV) + (size_t)(b * 4 + hk) * T * 64;
        const f16* KCb = (const f16*)(AT + AT_KC) + (size_t)(b * 4 + hk) * NCX * 64; const f16* VCb = (const f16*)(AT + AT_VC) + (size_t)(b * 4 + hk) * NCX * 64;
        const f16* QRw = cu ? (const f16*)(AT + AT_QC) + ((size_t)(b * 16 + hq) * NCX + q0) * 64 : (const f16*)(AT + AT_QR) + ((size_t)(b * 16 + hq) * T + q0) * 64;
        const f16* QPw = cu ? QRw : (const f16*)(AT + AT_QP) + ((size_t)(b * 16 + hq) * T + q0) * 64;
        f16x8 q[4][2];
        load_q(q, QRw, lane);
        AttnSt st; attn_init(st, C.in[IN_A_SINK][j * 16 + hq] * LOG2E, (lane < 16) ? 1.0f : 0.0f);
        const int c_lo = cu ? 0 : (i == 0 ? 2 : 0), c_hi = cu ? 0 : (i == 63 ? 4 : 6), nl = c_hi - c_lo, nch = nl + 4;
        const unsigned soff = (unsigned)(srow * 64 + 8 * sch);
        u32x4 kreg, vreg;
        { const bool loc = 0 < nl; const int kp0 = (i - 1) * 128 + 64 * c_lo;
          const f16* ks = loc ? KRb + (size_t)kp0 * 64 : KCb; const f16* vs = loc ? VVb + (size_t)kp0 * 64 : VCb;
          kreg = *(const u32x4*)(ks + soff); vreg = *(const u32x4*)(vs + soff); }
#define ATTN_A_CHUNK { \
            LAS char* kb = (LAS char*)C.lds + (k & 1) * 20480; LAS char* vbuf = kb + 10240; \
            *(LAS u32x4*)(kb + srow * 160 + sch * 16) = kreg; *(LAS u32x4*)(vbuf + srow * 160 + sch * 16) = vreg; \
            __syncthreads(); \
            { const int k1 = min(k + 1, nch - 1); const bool loc1 = k1 < nl; const int kp1 = (i - 1) * 128 + 64 * (c_lo + k1); const int cc = k1 - nl;        \
                const f16* ks = loc1 ? KRb + (size_t)kp1 * 64 : KCb + (size_t)(64 * cc) * 64; const f16* vs = loc1 ? VVb + (size_t)kp1 * 64 : VCb + (size_t)(64 * cc) * 64; \
                kreg = *(const u32x4*)(ks + soff); vreg = *(const u32x4*)(vs + soff); } \
            const bool loc = k < nl; const int kp0 = (i - 1) * 128 + 64 * (c_lo + k); \
            _Pragma("unroll 1") for (int blk = 0; blk < 2; ++blk) { \
                const LAS char* kblk = kb + blk * 32 * 160; const LAS char* vblk = vbuf + blk * 32 * 160; \
                const int kb0 = kp0 + 32 * blk; \
                if (loc && (kb0 + 31 < q0 - 128 || kb0 > q0 + 63 + 128)) continue; \
                f16x8 kf[2][2]; \
                _Pragma("unroll") for (int kt = 0; kt < 2; ++kt) _Pragma("unroll") for (int ks = 0; ks < 2; ++ks) kf[kt][ks] = *(const LAS f16x8*)(kblk + (16 * kt + (lane & 15)) * 160 + (lane >> 4) * 16 + ks * 64); \
                const bool edge = loc && !(kb0 >= q0 + 63 - 128 && kb0 + 31 <= q0 + 128); \
                attn_block32<0, 4, 1>(st, q, kf, vblk, lane, loc ? kb0 - q0 : 0, edge ? 128 : (1 << 24), nullptr); } }
        int k = 0;
#pragma unroll 1
        for (; k < nl; ++k) ATTN_A_CHUNK
        if (!cu) { load_q(q, QPw, lane); __builtin_amdgcn_sched_barrier(0); }
#pragma unroll 1
        for (; k < nch; ++k) ATTN_A_CHUNK
#undef ATTN_A_CHUNK
        const size_t orow = cu ? (size_t)RL + b * NCX + q0 : (size_t)b * T + q0;
        attn_store(st, O, orow, hq * 64, lane);
        __syncthreads();
    }
}

__device__ __forceinline__ void load_kf(f16x8 (&kf)[2][2], const f16* Kp  , int lane) {
#pragma unroll
    for (int kt = 0; kt < 2; ++kt)
#pragma unroll
        for (int ks = 0; ks < 2; ++ks) kf[kt][ks] = *(const f16x8*)(Kp + ((unsigned)((lane & 15) * 64 + 8 * (lane >> 4)) + (unsigned)(kt * 1024 + ks * 32)));
}
__device__ __forceinline__ void load_vrows(u32x4 (&vr)[4], const f16* Vp, int lane) {
#pragma unroll
    for (int jj = 0; jj < 4; ++jj) vr[jj] = *(const u32x4*)(Vp + ((unsigned)((lane >> 3) * 64 + 8 * (lane & 7)) + (unsigned)(jj * 512)));
}
__device__ __forceinline__ void store_vrows(const u32x4 (&vr)[4], LAS char* vb, int lane) {
#pragma unroll
    for (int jj = 0; jj < 4; ++jj) *(LAS u32x4*)(vb + ((lane >> 3) + 8 * jj) * 160 + (lane & 7) * 16) = vr[jj];
}
__device__ __forceinline__ void phase_attn_c(const Ctx& C, bool need_ctx) {
    const int lane = C.lane, gw = C.bid * 8 + C.wave, NGW = C.G * 8;
    unsigned char* AT = C.ws + WS_ATT; f16* O = (f16*)(C.ws + WS_O);
    LAS char* vbase = (LAS char*)C.lds + C.wave * 10240;
    LAS float* bias = (LAS float*)(C.lds + 81920 + C.wave * 2048);
    const int nlat = NB * 16 * 128, nunits = nlat + (need_ctx ? NB * 16 * 4 : 0);
    for (int u = gw; u < nunits; u += NGW) {
        const bool cu = u >= nlat;
        int b, hh, r;
        if (cu) { const int v = u - nlat; b = v >> 6; hh = (v >> 2) & 15; r = v & 3; } else { b = u >> 11; hh = (u >> 7) & 15; r = u & 127; }
        const f16* Kc = (const f16*)(AT + CT_KC) + (size_t)(b * 16 + hh) * NCX * 64; const f16* Vc = (const f16*)(AT + CT_VC) + (size_t)(b * 16 + hh) * NCX * 64;
        const f16* Kl = (const f16*)(AT + CT_K) + (size_t)(b * 16 + hh) * T * 64; const f16* Vl = (const f16*)(AT + CT_V) + (size_t)(b * 16 + hh) * T * 64;
        f16x8 q[4][2];
        if (cu) load_q(q, (const f16*)(AT + CT_QC) + ((size_t)(b * 16 + hh) * NCX + 64 * r) * 64, lane);
        else load_q(q, (const f16*)(AT + CT_Q) + ((size_t)(b * 16 + hh) * T + 64 * r) * 64, lane);
        if (!cu) { const float* rp = C.in[IN_C_RPB] + hh * 465; for (int i2 = lane; i2 < 465; i2 += 64) bias[i2] = rp[i2] * LOG2E; }
        AttnSt st; attn_init(st, -INFINITY, 0.0f);
        const int r0 = min(max(r - 4, 0), 120);
        const int nblk = cu ? 8 : 24;
        f16x8 kf[2][2], kn[2][2]; u32x4 vr[4];
        load_kf(kf, Kc, lane); load_vrows(vr, Vc, lane); store_vrows(vr, vbase, lane);
#define ATTN_C_STEP(CALL) { \
            const int n1 = n + 1; const bool more = n1 < nblk; \
            const f16* kp = Kc; const f16* vp = Vc; \
            if (more) { if (n1 < 8) { kp = Kc + (size_t)32 * n1 * 64; vp = Vc + (size_t)32 * n1 * 64; } else { const size_t tok = (size_t)(r0 + ((n1 - 8) >> 1)) * 64 + 32 * ((n1 - 8) & 1); kp = Kl + tok * 64; vp = Vl + tok * 64; } } \
            load_kf(kn, kp, lane); load_vrows(vr, vp, lane); \
            const LAS char* vb = vbase + (n & 1) * 5120; \
            CALL; \
            if (more) { store_vrows(vr, vbase + (n1 & 1) * 5120, lane); } \
            _Pragma("unroll") for (int a = 0; a < 2; ++a) _Pragma("unroll") for (int c2 = 0; c2 < 2; ++c2) kf[a][c2] = kn[a][c2]; }
#pragma unroll 1
        for (int n = 0; n < 8; ++n) ATTN_C_STEP((attn_block32<0, 4, 0>(st, q, kf, vb, lane, 0, 0, nullptr)))
#pragma unroll 1
        for (int n = 8; n < nblk; ++n) ATTN_C_STEP((attn_block32<0, 4, 2>(st, q, kf, vb, lane, 32 * ((n - 8) & 1), (r0 + ((n - 8) >> 1) - r + 7) * 31, bias)))
#undef ATTN_C_STEP
        const size_t orow = cu ? (size_t)RL + b * NCX + 64 * r : (size_t)b * T + 64 * r;
        attn_store(st, O, orow, hh * 64, lane);
    }
}

constexpr int FN = 16384;
__host__ __device__ constexpr int brev_c(int k, int bits) { int r = 0; for (int i = 0; i < bits; ++i) if (k & (1 << i)) r |= 1 << (bits - 1 - i); return r; }
__device__ __forceinline__ int swz(int i) { return i ^ ((i >> 4) & 7) ^ (((i >> 7) & 1) << 4) ^ ((((i >> 7) ^ (i >> 8)) & 1) << 3); }
__device__ __forceinline__ f32x2 cmul(f32x2 x, f32x2 w) { f32x2 t, r;
    asm("v_pk_mul_f32 %0, %1, %2 op_sel_hi:[0,1]" : "=v"(t) : "v"(x), "v"(w));
    asm("v_pk_fma_f32 %0, %1, %2, %3 op_sel:[1,1,0] op_sel_hi:[1,0,1] neg_lo:[0,1,0]" : "=v"(r) : "v"(x), "v"(w), "v"(t));
    return r; }
template <bool NR, bool NI> __device__ __forceinline__ f32x2 cmulk(f32x2 x, f32x2 K) { f32x2 t, r;
    if (!NR && !NI) { asm("v_pk_mul_f32 %0, %1, %2 op_sel_hi:[0,1]" : "=v"(t) : "v"(x), "s"(K));
                      asm("v_pk_fma_f32 %0, %1, %2, %3 op_sel:[1,1,0] op_sel_hi:[1,0,1] neg_lo:[0,1,0]" : "=v"(r) : "v"(x), "s"(K), "v"(t)); }
    if (!NR && NI)  { asm("v_pk_mul_f32 %0, %1, %2 op_sel_hi:[0,1] neg_hi:[0,1]" : "=v"(t) : "v"(x), "s"(K));
                      asm("v_pk_fma_f32 %0, %1, %2, %3 op_sel:[1,1,0] op_sel_hi:[1,0,1]" : "=v"(r) : "v"(x), "s"(K), "v"(t)); }
    if (NR && !NI)  { asm("v_pk_mul_f32 %0, %1, %2 op_sel_hi:[0,1] neg_lo:[0,1]" : "=v"(t) : "v"(x), "s"(K));
                      asm("v_pk_fma_f32 %0, %1, %2, %3 op_sel:[1,1,0] op_sel_hi:[1,0,1] neg_lo:[0,1,0] neg_hi:[0,1,0]" : "=v"(r) : "v"(x), "s"(K), "v"(t)); }
    if (NR && NI)   { asm("v_pk_mul_f32 %0, %1, %2 op_sel_hi:[0,1] neg_lo:[0,1] neg_hi:[0,1]" : "=v"(t) : "v"(x), "s"(K));
                      asm("v_pk_fma_f32 %0, %1, %2, %3 op_sel:[1,1,0] op_sel_hi:[1,0,1] neg_hi:[0,1,0]" : "=v"(r) : "v"(x), "s"(K), "v"(t)); }
    return r; }
__device__ __forceinline__ f32x2 dif_sub_rot(f32x2 a, f32x2 b) { f32x2 r; asm("v_pk_add_f32 %0, %1, %2 op_sel:[1,1] op_sel_hi:[0,0] neg_lo:[0,1] neg_hi:[1,0]" : "=v"(r) : "v"(a), "v"(b)); return r; }
__device__ __forceinline__ f32x2 add_irot(f32x2 a, f32x2 b) { f32x2 r; asm("v_pk_add_f32 %0, %1, %2 op_sel:[0,1] op_sel_hi:[1,0] neg_lo:[0,1]" : "=v"(r) : "v"(a), "v"(b)); return r; }
__device__ __forceinline__ f32x2 sub_irot(f32x2 a, f32x2 b) { f32x2 r; asm("v_pk_add_f32 %0, %1, %2 op_sel:[0,1] op_sel_hi:[1,0] neg_hi:[0,1]" : "=v"(r) : "v"(a), "v"(b)); return r; }
__device__ __forceinline__ f32x2 rot_mi(f32x2 a) { f32x2 r; asm("v_pk_add_f32 %0, %1, 0 op_sel:[1,0] op_sel_hi:[0,0] neg_hi:[1,0]" : "=v"(r) : "v"(a)); return r; }
template <bool INV> __device__ __forceinline__ f32x2 tw16(f32x2 x, int r16, f32x2 K1, f32x2 K2, f32x2 K3) {
    const f32x2 K = (r16 == 1 || r16 == 7) ? K1 : (r16 == 2 || r16 == 6) ? K2 : K3;
    return r16 > 4 ? cmulk<true, !INV>(x, K) : cmulk<false, !INV>(x, K);
}
template <int RR, int LGM, bool INVERSE, bool ZHI = false, bool HALFOUT = false>
__device__ __forceinline__ void fft_pass(LAS f32x2* cx, int tid) {
    constexpr int NP = 1 << RR, mlast = 1 << LGM;
    static_assert((LGM == 10 || LGM == 6 || LGM == 2) ? RR == 4 : (LGM == 0 && RR == 2), "pass shapes with a closed-form swizzled address");
    const f32x2 K1 = (f32x2){0.92387953251128674f, 0.38268343236508977f}, K2 = (f32x2){0.70710678118654752f, 0.70710678118654752f}, K3 = (f32x2){0.38268343236508977f, 0.92387953251128674f};
#pragma unroll 1
    for (int it = tid; it < (FN >> RR); it += 512) {
        const int lo = it & (mlast - 1), hi = it >> LGM;
        int pb;
        if (LGM == 10) pb = swz(lo);
        else if (LGM == 6) pb = (hi << 10) + (lo ^ ((lo >> 4) & 3));
        else if (LGM == 2) pb = (hi << 6) + lo + (((hi & 1) | ((((hi >> 1) ^ (hi >> 2)) & 1) << 1) | (((hi >> 1) & 1) << 2)) << 2);
        else pb = swz(4 * ((it & ~48) | ((it & 16) << 1) | ((it & 32) >> 1)));
#define FFT_CK6(k) ((((k) & 1) << 2) | (((((k) >> 1) ^ ((k) >> 2)) & 1) << 3) | ((((k) >> 1) & 1) << 4))
#define FFT_ADDR(k) (LGM == 10 ? pb + ((k) << 10) : LGM == 6 ? (pb ^ FFT_CK6(k)) + ((k) << 6) : LGM == 2 ? (pb ^ (((k) << 2) | (((k) >> 2) & 3))) : (pb ^ (k)))
        f32x2 x[NP];
#pragma unroll
        for (int k = 0; k < NP; ++k) { if (ZHI && k >= NP / 2) x[k] = (f32x2){0.f, 0.f}; else x[k] = cx[FFT_ADDR(k)]; }
        f32x2 w[NP];
        if (LGM > 0) {
            const float fr = (float)lo * (1.0f / (float)(NP * mlast));
            float cs = __builtin_amdgcn_cosf(fr), sn = __builtin_amdgcn_sinf(INVERSE ? fr : -fr);
            asm volatile("s_nop 1" : "+v"(cs), "+v"(sn));
            w[1] = (f32x2){cs, sn};
#pragma unroll
            for (int r = 2; r < NP; ++r) w[r] = (r & 1) == 0 ? cmul(w[r >> 1], w[r >> 1]) : cmul(w[r - 1], w[1]);
        }
        if (INVERSE && LGM > 0) {
#pragma unroll
            for (int k = 1; k < NP; ++k) x[k] = cmul(x[k], w[brev_c(k, RR)]);
        }
        if (!INVERSE) {
#pragma unroll
            for (int hs = NP >> 1; hs >= 1; hs >>= 1) {
#pragma unroll
                for (int k0 = 0; k0 < NP; ++k0) { if (k0 & hs) continue; const int k1 = k0 + hs;
                    const int r16 = (k0 & (hs - 1)) * (8 / hs);
                    const f32x2 a = x[k0], b = x[k1];
                    if (ZHI && hs == NP / 2) {
                        if (r16 == 0) x[k1] = a; else if (r16 == 4) x[k1] = rot_mi(a); else x[k1] = tw16<false>(a, r16, K1, K2, K3);
                    } else {
                        x[k0] = a + b;
                        if (r16 == 0) x[k1] = a - b; else if (r16 == 4) x[k1] = dif_sub_rot(a, b); else x[k1] = tw16<false>(a - b, r16, K1, K2, K3);
                    } }
            }
        } else {
#pragma unroll
            for (int hs = 1; hs < NP; hs <<= 1) {
#pragma unroll
                for (int k0 = 0; k0 < NP; ++k0) { if (k0 & hs) continue; const int k1 = k0 + hs;
                    const int r16 = (k0 & (hs - 1)) * (8 / hs);
                    const f32x2 a = x[k0], b = x[k1];
                    if (r16 == 4) { x[k0] = add_irot(a, b); x[k1] = sub_irot(a, b); }
                    else { const f32x2 bt = r16 == 0 ? b : tw16<true>(b, r16, K1, K2, K3); x[k0] = a + bt; x[k1] = a - bt; } }
            }
        }
        if (!INVERSE && LGM > 0) {
#pragma unroll
            for (int k = 1; k < NP; ++k) x[k] = cmul(x[k], w[brev_c(k, RR)]);
        }
#pragma unroll
        for (int k = 0; k < NP; ++k) { if (HALFOUT && k >= NP / 2) continue; cx[FFT_ADDR(k)] = x[k]; }
#undef FFT_ADDR
#undef FFT_CK6
    }
}
__device__ __forceinline__ int fft_mid_item(int tid, int jj) {
    const int lp = (tid & 15) | ((tid & 16) << 1) | ((tid & 32) >> 1);
    return (((tid >> 6) + 8 * (jj >> 2)) << 8) + ((jj & 3) << 6) + lp;
}
__device__ __forceinline__ void fft_kf_load(const u32x4* kf  , int tid, u32x4 (&kq)[8]) {
#pragma unroll
    for (int jj = 0; jj < 8; ++jj) kq[jj] = kf[fft_mid_item(tid, jj)];
}
__device__ __forceinline__ f32x2 h2f(unsigned v) { const f16x2 h = __builtin_bit_cast(f16x2, v); return (f32x2){(float)h[0], (float)h[1]}; }
__device__ __forceinline__ void fft_mid_mul(LAS f32x2* cx, const u32x4 (&kq)[8], int tid) {
#pragma unroll
    for (int jj = 0; jj < 8; ++jj) { const int it = fft_mid_item(tid, jj);
        const int pb = swz(4 * it);
        const f32x2 x0 = cx[pb], x1 = cx[pb ^ 1], x2 = cx[pb ^ 2], x3 = cx[pb ^ 3];
        const f32x2 a0 = x0 + x2, b0 = x0 - x2, a1 = x1 + x3, b1 = dif_sub_rot(x1, x3);
        f32x2 y0 = a0 + a1, y1 = a0 - a1, y2 = b0 + b1, y3 = b0 - b1;
        y0 = cmul(y0, h2f(kq[jj][0])); y1 = cmul(y1, h2f(kq[jj][1])); y2 = cmul(y2, h2f(kq[jj][2])); y3 = cmul(y3, h2f(kq[jj][3]));
        const f32x2 z0 = y0 + y1, z1 = y0 - y1, z2 = y2 + y3, z3 = y2 - y3;
        cx[pb] = z0 + z2; cx[pb ^ 1] = add_irot(z1, z3); cx[pb ^ 2] = z0 - z2; cx[pb ^ 3] = sub_irot(z1, z3);
    }
}
__device__ __forceinline__ void fft_forward(LAS f32x2* cx, int tid) {
    fft_pass<4, 10, false>(cx, tid); __syncthreads(); fft_pass<4, 6, false>(cx, tid); fft_pass<4, 2, false>(cx, tid); __syncthreads();
    fft_pass<2, 0, false>(cx, tid); __syncthreads();
}
__device__ __forceinline__ void fft_conv(LAS f32x2* cx, const u32x4* kf, int tid) {
    fft_pass<4, 10, false, true>(cx, tid); __syncthreads();
    u32x4 kq[8]; fft_kf_load(kf, tid, kq);
    fft_pass<4, 6, false>(cx, tid); fft_pass<4, 2, false>(cx, tid);
    fft_mid_mul(cx, kq, tid);
    fft_pass<4, 2, true>(cx, tid); fft_pass<4, 6, true>(cx, tid); __syncthreads();
    fft_pass<4, 10, true, false, true>(cx, tid); __syncthreads();
}
__device__ __forceinline__ float block_sum(const Ctx& C, float v, LAS float* scr  ) {
    v = wave_sum(v);
    __syncthreads();
    if (C.lane == 0) scr[C.wave] = v;
    __syncthreads();
    float s = 0.f;
#pragma unroll
    for (int w = 0; w < 8; ++w) s += scr[w];
    return s;
}
__device__ __forceinline__ float hy_delta(int c) {
    const float mind = -4.605170185988091f / 1.5f, maxd = -4.605170185988091f / 0.3f;
    return fabsf(mind + (float)c * ((maxd - mind) / 1023.0f));
}
__device__ __forceinline__ void phase_filter_spectra(const Ctx& C) {
    LAS f32x2* cx = (LAS f32x2*)C.lds;
    LAS float* w3c = (LAS float*)(C.lds + MISC_OFF + 256);
    LAS float* red = (LAS float*)(C.lds + MISC_OFF + 256 + 1024);
    const f16* FT = (const f16*)(C.ws + WS_FTL);
    unsigned* KF = (unsigned*)(C.ws + WS_BIG);
    for (int c = C.bid; c < 1024; c += C.G) {
        int tid = C.tid; asm volatile("" : "+v"(tid));
        __syncthreads();
        const float dl = hy_delta(c);
        float ss0 = 0.f, ss1 = 0.f;
        const int skw = ((C.bid * 37) & 127) * 64;
        const f16* f0 = FT + (size_t)c * T; const f16* f1 = f0 + (size_t)1024 * T; const f16* f2 = f0 + (size_t)2048 * T; const f16* f3 = f0 + (size_t)3072 * T;
#pragma unroll 4
        for (int jj = 0; jj < 8; ++jj) {
            const int t2 = 2 * ((jj * 512 + tid + (skw >> 1)) & 4095);
            const f16x2 h0 = __builtin_bit_cast(f16x2, *(const unsigned*)(f0 + t2)), h1 = __builtin_bit_cast(f16x2, *(const unsigned*)(f1 + t2)),
                        h2 = __builtin_bit_cast(f16x2, *(const unsigned*)(f2 + t2)), h3 = __builtin_bit_cast(f16x2, *(const unsigned*)(f3 + t2));
#pragma unroll
            for (int q = 0; q < 2; ++q) { const int t = t2 + q;
                const float dec = expf(-((float)t / 8191.0f) * dl);
                const f32x4 a = (f32x4){(float)h0[q], (float)h1[q], (float)h2[q], (float)h3[q]} * dec;
                cx[swz(t)] = (f32x2){a[0], a[2]};
                if (t >= 1) { cx[swz(FN - t)] = (f32x2){a[1], a[3]}; ss0 += a[1] * a[1]; ss1 += a[3] * a[3]; }
                else cx[swz(8192)] = (f32x2){0.f, 0.f};
                ss0 += a[0] * a[0]; ss1 += a[2] * a[2]; }
        }
        const float n0 = 1.0f / sqrtf(block_sum(C, ss0, red) + NORM_EPS);
        const float n1 = 1.0f / sqrtf(block_sum(C, ss1, red) + NORM_EPS);
        __syncthreads();
        fft_forward(cx, tid);
        for (int jj = 0; jj < 32; ++jj) {
            const int p = (jj * 512 + tid + 4 * skw) & (FN - 1); const int f = (int)(__brev((unsigned)p) >> 18); const int p2 = (int)(__brev((unsigned)((FN - f) & (FN - 1))) >> 18);
            const f32x2 va = cx[swz(p)], vb = cx[swz(p2)]; const float ar = va[0], ai = va[1], br = vb[0], bi = -vb[1];
            KF[((size_t)0 * 1024 + c) * FN + p] = pkh(0.5f * (ar + br) * n0, 0.5f * (ai + bi) * n0);
            KF[((size_t)1 * 1024 + c) * FN + p] = pkh(0.5f * (ai - bi) * n1, -0.5f * (ar - br) * n1);
        }
    }
}
__device__ __forceinline__ float short_conv(const f16* col, int t, int len, float w0, float w1, float w2, float bs) {
    const float lm = (float)col[max(t - 1, 0)], p0 = (float)col[t], lp = (float)col[min(t + 1, len - 1)];
    const float pm = t > 0 ? lm : 0.f, pp = t + 1 < len ? lp : 0.f;
    return pm * w0 + p0 * w1 + pp * w2 + bs;
}
__device__ __forceinline__ void short_conv8(const f16* col, int t0, float w0, float w1, float w2, float bs, float (&o)[8]) {
    const u32x4 m = *(const u32x4*)(col + t0);
    const float lm = (float)col[max(t0 - 1, 0)], rp = (float)col[min(t0 + 8, T - 1)];
    float x[8]; unpack8(m, x);
    const float left = t0 > 0 ? lm : 0.f, right = t0 + 8 < T ? rp : 0.f;
#pragma unroll
    for (int i = 0; i < 8; ++i) { const float pv = i ? x[i > 0 ? i - 1 : 0] : left, nx = i < 7 ? x[i < 7 ? i + 1 : 7] : right; o[i] = pv * w0 + x[i] * w1 + nx * w2 + bs; }
}
struct Raw8 { u32x4 ma, mb; f16 la, ra, lb, rb; };
__device__ __forceinline__ Raw8 sc_load(const f16* cola, const f16* colb, int t0) {
    Raw8 r; r.ma = *(const u32x4*)(cola + t0); r.mb = *(const u32x4*)(colb + t0);
    r.la = cola[max(t0 - 1, 0)]; r.ra = cola[min(t0 + 8, T - 1)]; r.lb = colb[max(t0 - 1, 0)]; r.rb = colb[min(t0 + 8, T - 1)];
    return r;
}
__device__ __forceinline__ void sc_compute(const Raw8& r, int t0, float w0, float w1, float w2, float bs, f32x2 (&o)[8]) {
    float xa[8], xb[8]; unpack8(r.ma, xa); unpack8(r.mb, xb);
    f32x2 x[8];
#pragma unroll
    for (int i = 0; i < 8; ++i) x[i] = (f32x2){xa[i], xb[i]};
    const f32x2 left = t0 > 0 ? (f32x2){(float)r.la, (float)r.lb} : (f32x2){0.f, 0.f}, right = t0 + 8 < T ? (f32x2){(float)r.ra, (float)r.rb} : (f32x2){0.f, 0.f};
#pragma unroll
    for (int i = 0; i < 8; ++i) { const f32x2 pv = i ? x[i > 0 ? i - 1 : 0] : left, nx = i < 7 ? x[i < 7 ? i + 1 : 7] : right; o[i] = pv * w0 + x[i] * w1 + nx * w2 + bs; }
}
__device__ __forceinline__ void phase_hyena_conv(const Ctx& C, bool need_ctx) {
    LAS f32x2* cx = (LAS f32x2*)C.lds;
    const f16* PT = (const f16*)(C.ws + WS_P); const f16* PTC = PT + (size_t)NB * 3072 * T;
    f16* ZT = (f16*)(C.ws + WS_ZT); f16* ZTC = ZT + (size_t)NB * 1024 * T;
    const u32x4* KF = (const u32x4*)(C.ws + WS_BIG);
    const float* sw = C.in[IN_B_SW]; const float* sb = C.in[IN_B_SB]; const float* fb = C.in[IN_B_BIAS];
    const int nbig = 2048, nunits = nbig + (need_ctx ? 1024 : 0);
    for (int u = C.bid; u < nunits; u += C.G) {
        int tid = C.tid; asm volatile("" : "+v"(tid));
        __syncthreads();
        if (u < nbig) {
            const int c = ((u >> 4) << 3) | (u & 7), bp = (u >> 3) & 1;
            float w[3][3], bsv[3];
#pragma unroll
            for (int s = 0; s < 3; ++s) { bsv[s] = sb[s * 1024 + c];
#pragma unroll
                for (int k = 0; k < 3; ++k) w[s][k] = sw[k * 3072 + s * 1024 + c]; }
            const float bias0 = fb[c], bias1 = fb[1024 + c];
            const f16* colv[2]; const f16* colx1[2]; const f16* colx2[2];
#pragma unroll
            for (int bi = 0; bi < 2; ++bi) { const int b = 2 * bp + bi; colv[bi] = PT + ((size_t)b * 3072 + c) * T; colx1[bi] = PT + ((size_t)b * 3072 + 1024 + c) * T; colx2[bi] = PT + ((size_t)b * 3072 + 2048 + c) * T; }
            const int skq = ((C.bid * 37) & 31) << 5;
            const float invn = 1.0f / (float)FN;
            int t0s[2], pbs[2];
#pragma unroll
            for (int jj = 0; jj < 2; ++jj) { t0s[jj] = 8 * ((jj * 512 + tid + skq) & 1023); pbs[jj] = swz(t0s[jj]); }
            Raw8 rv[2], rx1[2], rx2[2];
#pragma unroll
            for (int jj = 0; jj < 2; ++jj) rv[jj] = sc_load(colv[0], colv[1], t0s[jj]);
#pragma unroll
            for (int jj = 0; jj < 2; ++jj) rx1[jj] = sc_load(colx1[0], colx1[1], t0s[jj]);
            unsigned vh[2][8], z1h[2][8];
#pragma unroll
            for (int jj = 0; jj < 2; ++jj) { f32x2 v[8]; sc_compute(rv[jj], t0s[jj], w[0][0], w[0][1], w[0][2], bsv[0], v);
#pragma unroll
                for (int i = 0; i < 8; ++i) { cx[pbs[jj] ^ i] = v[i]; vh[jj][i] = pkh(v[i][0], v[i][1]); } }
            __syncthreads();
            fft_conv(cx, KF + ((size_t)0 * 1024 + c) * (FN / 4), tid);
#pragma unroll
            for (int jj = 0; jj < 2; ++jj) rx2[jj] = sc_load(colx2[0], colx2[1], t0s[jj]);
#pragma unroll
            for (int jj = 0; jj < 2; ++jj) { f32x2 x1[8]; sc_compute(rx1[jj], t0s[jj], w[1][0], w[1][1], w[1][2], bsv[1], x1);
#pragma unroll
                for (int i = 0; i < 8; ++i) { const f32x2 z1 = x1[i] * (cx[pbs[jj] ^ i] * invn + bias0 * h2f(vh[jj][i])); cx[pbs[jj] ^ i] = z1; z1h[jj][i] = pkh(z1[0], z1[1]); } }
            __syncthreads();
            fft_conv(cx, KF + ((size_t)1 * 1024 + c) * (FN / 4), tid);
            f16* za = ZT + ((size_t)(2 * bp) * 1024 + c) * T; f16* zb = ZT + ((size_t)(2 * bp + 1) * 1024 + c) * T;
#pragma unroll
            for (int jj = 0; jj < 2; ++jj) { f32x2 x2[8]; sc_compute(rx2[jj], t0s[jj], w[2][0], w[2][1], w[2][2], bsv[2], x2);
                float oa[8], ob[8];
#pragma unroll
                for (int i = 0; i < 8; ++i) { const f32x2 o = x2[i] * (cx[pbs[jj] ^ i] * invn + bias1 * h2f(z1h[jj][i])) * ZSCALE; oa[i] = o[0]; ob[i] = o[1]; }
                *(u32x4*)(za + t0s[jj]) = pack8(oa, 1.0f); *(u32x4*)(zb + t0s[jj]) = pack8(ob, 1.0f); }
        } else {
            const int c = u - nbig;
            LAS float* w3c = (LAS float*)C.lds;
            LAS float* kk = w3c + 256;
            LAS float* zz = kk + 1088;
            LAS float* red = zz + 1024;
            const float* FTC = (const float*)(C.ws + WS_FTC);
            float ss0 = 0.f, ss1 = 0.f; f32x4 a = (f32x4){0.f, 0.f, 0.f, 0.f};
            if (tid < 256) { const int t = tid;
                a = (f32x4){FTC[(size_t)c * NCX + t], FTC[(size_t)(1024 + c) * NCX + t], FTC[(size_t)(2048 + c) * NCX + t], FTC[(size_t)(3072 + c) * NCX + t]};
                a = a * expf(-((float)t / 255.0f) * hy_delta(c));
                ss0 = a[0] * a[0] + (t >= 1 ? a[1] * a[1] : 0.f); ss1 = a[2] * a[2] + (t >= 1 ? a[3] * a[3] : 0.f); }
            const float n0 = 1.0f / sqrtf(block_sum(C, ss0, red) + NORM_EPS);
            const float n1 = 1.0f / sqrtf(block_sum(C, ss1, red) + NORM_EPS);
            __syncthreads();
#define KKI(i) ((i) + ((i) >> 5))
            if (tid < 256) { const int t = tid; kk[KKI(255 + t)] = a[0] * n0; kk[544 + KKI(255 + t)] = a[2] * n1; if (t >= 1) { kk[KKI(255 - t)] = a[1] * n0; kk[544 + KKI(255 - t)] = a[3] * n1; } }
            float w[3][3], bsv[3];
#pragma unroll
            for (int s = 0; s < 3; ++s) { bsv[s] = sb[s * 1024 + c];
#pragma unroll
                for (int k = 0; k < 3; ++k) w[s][k] = sw[k * 3072 + s * 1024 + c]; }
            const int cb = (tid >> 6) & 3, t0 = (tid & 63) * 4; const bool act = tid < 256;
            float vv[4], x1v[4], x2v[4], z1[4];
#pragma unroll
            for (int i = 0; i < 4; ++i) { const int t = t0 + i;
                vv[i] = short_conv(PTC + ((size_t)cb * 3072 + c) * NCX, t, NCX, w[0][0], w[0][1], w[0][2], bsv[0]);
                x1v[i] = short_conv(PTC + ((size_t)cb * 3072 + 1024 + c) * NCX, t, NCX, w[1][0], w[1][1], w[1][2], bsv[1]);
                x2v[i] = short_conv(PTC + ((size_t)cb * 3072 + 2048 + c) * NCX, t, NCX, w[2][0], w[2][1], w[2][2], bsv[2]);
                if (act) zz[cb * 256 + t] = vv[i]; }
            __syncthreads();
#define CTX_CONV4(y, kbase) { float w0_ = kk[(kbase) + KKI(255 + t0)], w1_ = kk[(kbase) + KKI(256 + t0)], w2_ = kk[(kbase) + KKI(257 + t0)], w3_ = kk[(kbase) + KKI(258 + t0)]; \
                y[0] = 0.f; y[1] = 0.f; y[2] = 0.f; y[3] = 0.f; \
                _Pragma("unroll 8") for (int s_ = 0; s_ < 256; ++s_) { const float zv_ = zz[cb * 256 + s_]; const float nw_ = kk[(kbase) + KKI(max(254 + t0 - s_, 0))]; \
                    y[0] += zv_ * w0_; y[1] += zv_ * w1_; y[2] += zv_ * w2_; y[3] += zv_ * w3_; w3_ = w2_; w2_ = w1_; w1_ = w0_; w0_ = nw_; } }
            float y[4];
            if (act) { CTX_CONV4(y, 0)
#pragma unroll
                for (int i = 0; i < 4; ++i) z1[i] = x1v[i] * (y[i] + fb[c] * vv[i]); }
            __syncthreads();
            if (act) {
#pragma unroll
                for (int i = 0; i < 4; ++i) zz[cb * 256 + t0 + i] = z1[i]; }
            __syncthreads();
            if (act) { CTX_CONV4(y, 544)
                float o4[4];
#pragma unroll
                for (int i = 0; i < 4; ++i) o4[i] = x2v[i] * (y[i] + fb[1024 + c] * z1[i]) * ZSCALE;
                u32x2 wv; wv.x = pkh(o4[0], o4[1]); wv.y = pkh(o4[2], o4[3]);
                *(u32x2*)(ZTC + ((size_t)cb * 1024 + c) * NCX + t0) = wv; }
#undef CTX_CONV4
#undef KKI
        }
    }
}
__device__ __forceinline__ void phase_hyena_transpose(const Ctx& C, bool need_ctx) {
    const int gw = C.bid * 8 + C.wave, NGW = C.G * 8, lane = C.lane;
    LAS f16* tile = (LAS f16*)(C.lds + C.wave * 8448);
    const f16* ZT = (const f16*)(C.ws + WS_ZT); const f16* ZTC = ZT + (size_t)NB * 1024 * T; f16* O = (f16*)(C.ws + WS_O);
    const int nl = NB * 16 * 128, ntiles = nl + (need_ctx ? NB * 16 * 4 : 0);
    for (int it = gw; it < ntiles; it += NGW) {
        const bool isc = it >= nl; const int v = isc ? it - nl : it; const int ntt = isc ? 4 : 128, len = isc ? NCX : T;
        const int b = v / (16 * ntt), cb = (v / ntt) & 15, tb = v % ntt;
        const f16* src = (isc ? ZTC : ZT) + ((size_t)b * 1024 + cb * 64) * len + tb * 64;
#pragma unroll 8
        for (int cc = 0; cc < 64; ++cc) tile[cc * 66 + lane] = src[(size_t)cc * len + lane];
        asm volatile("s_waitcnt lgkmcnt(0)" ::: "memory");
        f16* dst = O + ((size_t)(isc ? RL + b * NCX : b * T) + tb * 64) * D + cb * 64;
#pragma unroll 8
        for (int tt = 0; tt < 64; ++tt) dst[(size_t)tt * D + lane] = tile[lane * 66 + tt];
        asm volatile("s_waitcnt lgkmcnt(0)" ::: "memory");
    }
}

constexpr int PH_PROLOGUE = 1, PH_PER_LAYER_MAX = 11;
__host__ __device__ constexpr int layer_phases(int kind) { return kind == 1 ? 10 : 8; }
__host__ __device__ constexpr int total_phases() { int n = PH_PROLOGUE; for (int i = 0; i < DEPTH; ++i) n += layer_phases(i % 3); return n + 1; }

__global__ void __launch_bounds__(512, 2) mega(Args args) {
    extern __shared__ __attribute__((aligned(16))) unsigned char lds_raw[];
    Ctx C0;
    C0.lds = (LAS unsigned char*)lds_raw; C0.tid = threadIdx.x; C0.lane = C0.tid & 63; C0.wave = __builtin_amdgcn_readfirstlane(C0.tid >> 6); C0.G = gridDim.x; C0.bid = blockIdx.x;
    C0.in = args.in; C0.out = args.out; C0.ws = args.ws;
    volatile LAS unsigned* MISC = (volatile LAS unsigned*)(C0.lds + MISC_OFF);
    if (C0.tid < 64) MISC[C0.tid] = 0u;
    __syncthreads();
    const int lo = args.ph_lo, hi = args.ph_hi;
    XcdBarrier bar; bar.bar = (unsigned*)(C0.ws + WS_CTL); bar.x = 0; bar.st = MISC + 8;
    if (hi - lo > 1) bar = xcd_barrier_post((unsigned*)(C0.ws + WS_CTL), MISC + 8);
    int pid = 0;
#ifndef PROBE_MASK
#define PROBE_MASK 0
#endif
#ifndef PROBE_KINDS
#define PROBE_KINDS 7
#endif
#define PHASE_BEGIN_G(grp) if (lo <= pid && pid < hi) { for (int rep_ = 0; rep_ < 1 + ((((PROBE_MASK) >> (grp)) & 1) && (((PROBE_KINDS) >> pkind) & 1) ? 1 : 0); ++rep_) { Ctx C = C0; asm volatile("" : "+v"(C.tid)); C.lane = C.tid & 63; C.wave = __builtin_amdgcn_readfirstlane(C.tid >> 6); \
        { unsigned long long wsl = (unsigned long long)C.ws; asm volatile("" : "+s"(wsl)); C.ws = (unsigned char*)wsl; }
#define PHASE_END   } if (pid + 1 < hi) xcd_barrier(bar); } ++pid;

    int pkind = 0;
    PHASE_BEGIN_G(0) phase_prologue(C); PHASE_END

    for (int layer = 0; layer < DEPTH; ++layer) {
        const int kind = layer % 3, j = layer / 3; const bool last = layer == DEPTH - 1; const bool need_ctx = !last;
        pkind = kind;
        PHASE_BEGIN_G(1) phase_pn(C, layer); PHASE_END
        PHASE_BEGIN_G(2)
            if (kind == 1) { pg8::Gemm g{(const f16*)(C.ws + WS_U), (const f16*)(C.ws + WS_WB_IN), 1024, nullptr}; pg8::StaticOrder S; S.init(R, 3072, C.G, C.bid);
                pg8::EpiTransposeF16 E{(f16*)(C.ws + WS_P), (f16*)(C.ws + WS_P) + (size_t)NB * 3072 * T}; pg8::gemm_phase(C.lds, C.tid, g, S, E); }
            else if (kind == 0) { pg8::Gemm g{(const f16*)(C.ws + WS_U), (const f16*)(C.ws + WS_WA_IN) + (size_t)j * 1536 * 1024, 1024, nullptr}; pg8::StaticOrder S; S.init(R, 1536, C.G, C.bid);
                EpiQKV<0> E{C.ws + WS_ATT, C.in[IN_A_QG] + j * 64, C.in[IN_A_KG] + j * 64, (const float*)(C.ws + WS_ROPE), need_ctx}; pg8::gemm_phase(C.lds, C.tid, g, S, E); }
            else { pg8::Gemm g{(const f16*)(C.ws + WS_U), (const f16*)(C.ws + WS_WC_IN), 1024, nullptr}; pg8::StaticOrder S; S.init(R, 3072, C.G, C.bid);
                EpiQKV<2> E{C.ws + WS_ATT, C.in[IN_C_QG], C.in[IN_C_KG], (const float*)(C.ws + WS_ROPE), need_ctx}; pg8::gemm_phase(C.lds, C.tid, g, S, E); }
            if (cv_n1(layer, C.G)) { const int rank = C.bid - (256 - cv_idle1(layer));
                if (rank >= 0) {
                    if (kind == 1) {
                        int kf = 256; asm volatile("" : "+s"(kf));
                        pg8::Gemm g{(const f16*)(C.ws + WS_H2A), (const f16*)(C.ws + WS_W3T), kf, nullptr}; pg8::StaticOrder S; S.init(T + NCX, 4096, cv_idle1(layer), rank);
                        pg8::EpiFilterT E{(f16*)(C.ws + WS_FTL), (float*)(C.ws + WS_FTC)}; pg8::gemm_phase(C.lds, C.tid, g, S, E); }
                    convert_items(C, layer, cv_n0(layer, C.G) + rank * CV_IPB1, CV_IPB1); } }
            else if (kind == 1) { int kf = 256; asm volatile("" : "+s"(kf));
                pg8::Gemm g{(const f16*)(C.ws + WS_H2A), (const f16*)(C.ws + WS_W3T), kf, nullptr}; pg8::StaticOrder S; S.init(T + NCX, 4096, C.G, C.bid);
                pg8::EpiFilterT E{(f16*)(C.ws + WS_FTL), (float*)(C.ws + WS_FTC)}; pg8::gemm_phase(C.lds, C.tid, g, S, E); }
        PHASE_END
        if (kind == 1) { PHASE_BEGIN_G(3) phase_filter_spectra(C); PHASE_END }
        PHASE_BEGIN_G(4)
            if (kind == 0) phase_attn_a(C, j, need_ctx); else if (kind == 1) phase_hyena_conv(C, need_ctx); else phase_attn_c(C, need_ctx);
        PHASE_END
        if (kind == 1) { PHASE_BEGIN_G(5) phase_hyena_transpose(C, need_ctx); PHASE_END }
        PHASE_BEGIN_G(6)
            { const f16* W = kind == 0 ? (const f16*)(C.ws + WS_WA_OUT) + (size_t)j * 1024 * 1024 : (kind == 1 ? (const f16*)(C.ws + WS_WB_OUT) : (const f16*)(C.ws + WS_WC_OUT));
              pg8::Gemm g{(const f16*)(C.ws + WS_O), W, 1024, nullptr}; pg8::StaticOrder S; S.init(need_ctx ? R : RL, 1024, C.G, C.bid);
              pg8::EpiResidual E{C.in[IN_X], C.in[IN_CTX], (f16*)(C.ws + WS_HH), layer == 0,
                                 (const float*)(C.ws + WS_MOD) + (size_t)layer * 5 * 6144 + 2 * 1024, kind == 1 ? ZUNSCALE : 1.0f};
              pg8::gemm_phase(C.lds, C.tid, g, S, E);
              if (cv_n2(layer, C.G) && C.bid >= 16) convert_items(C, layer, cv_n0(layer, C.G) + cv_n1(layer, C.G) + (C.bid - 16) * CV_IPB2, CV_IPB2); }
        PHASE_END
        PHASE_BEGIN_G(7) phase_pf(C, layer); PHASE_END
        PHASE_BEGIN_G(8) phase_topk_convert(C, layer); PHASE_END
        PHASE_BEGIN_G(10)
            { int kq = 512  ; asm volatile("" : "+s"(kq));
              pg8::Gemm g{(const f16*)(C.ws + WS_U), (const f16*)(C.ws + ((layer & 1) ? WS_WEGU2 : WS_WEGU)), kq, (const int*)(C.ws + WS_ROWIDX)}; pg8::GroupedOrder S; S.init(last ? 16 : 17, 16, C.G, C.bid); pg8::EpiSwiGLU E{C.ws + WS_BIG};
              pg8::gemm_phase<pg8::EpiSwiGLU, pg8::GroupedOrder, true, true>(C.lds, C.tid, g, S, E); }
        PHASE_END
        PHASE_BEGIN_G(11)
            { int kq = 1024  ; asm volatile("" : "+s"(kq));
              pg8::Gemm g{(const f16*)(C.ws + WS_BIG), (const f16*)(C.ws + ((layer & 1) ? WS_WED2 : WS_WED)), kq, nullptr}; pg8::GroupedOrder S; S.init(last ? 16 : 17, 4, C.G, C.bid); pg8::EpiStoreF8 E{C.ws + WS_ATT, 1024, YE_SCALE};
              pg8::gemm_phase<pg8::EpiStoreF8, pg8::GroupedOrder, false, true>(C.lds, C.tid, g, S, E);
              if (cv_n0(layer + 1, C.G) && layer + 1 < DEPTH && (C.bid >> 3) >= 8) convert_items(C, layer + 1, (((C.bid & 7) * 24) + ((C.bid >> 3) - 8)) * CV_IPB0, CV_IPB0); }
        PHASE_END
    }
    PHASE_BEGIN_G(1) phase_pn(C, DEPTH); PHASE_END
}

extern "C" void kernel_launch(void* const* d_in, const int* in_sizes, int n_in, void* d_out, int out_size, void* d_ws, size_t ws_size, hipStream_t stream) {
    static int grid = 0;
    if (grid == 0) {
        if (n_in != 34 || out_size != RL * D || ws_size < WS_END) { fprintf(stderr, "kernel_launch: unexpected problem (n_in %d, out %d, ws %zu < %zu)\n", n_in, out_size, ws_size, (size_t)WS_END); grid = -1; return; }
        int dev = 0, cus = 0;
        if (hipGetDevice(&dev) != hipSuccess || hipDeviceGetAttribute(&cus, hipDeviceAttributeMultiprocessorCount, dev) != hipSuccess) { grid = -1; return; }
        if (hipFuncSetAttribute((const void*)mega, hipFuncAttributeMaxDynamicSharedMemorySize, LDS_BYTES) != hipSuccess) { fprintf(stderr, "kernel_launch: hipFuncSetAttribute failed\n"); grid = -1; return; }
        int per_cu = 0;
        (void)hipOccupancyMaxActiveBlocksPerMultiprocessor(&per_cu, (const void*)mega, 512, LDS_BYTES);
        (void)hipGetLastError();
        grid = cus;
    }
    if (grid < 0) return;
    (void)hipMemsetAsync((char*)d_ws + WS_CTL, 0, CTL_ZERO_BYTES, stream);
    Args a{};
    for (int i = 0; i < 34; ++i) a.in[i] = (const float*)d_in[i];
    a.out = (float*)d_out; a.ws = (unsigned char*)d_ws;
    const int NPH = total_phases();
#if ONE_LAUNCH
    a.ph_lo = 0; a.ph_hi = NPH;
    hipLaunchKernelGGL(mega, dim3(grid), dim3(512), LDS_BYTES, stream, a);
#else
    for (int p = 0; p < NPH; ++p) { a.ph_lo = p; a.ph_hi = p + 1; hipLaunchKernelGGL(mega, dim3(grid), dim3(512), LDS_BYTES, stream, a); }
#endif
}
```

```cpp
#include <hip/hip_runtime.h>
#include <cstdio>
#include <cstdint>

#ifndef ONE_LAUNCH
#define ONE_LAUNCH 1
#endif

#define LAS __attribute__((address_space(3)))
#define GAS __attribute__((address_space(1)))
typedef _Float16 f16;
typedef _Float16 f16x8 __attribute__((ext_vector_type(8)));
typedef _Float16 f16x4 __attribute__((ext_vector_type(4)));
typedef _Float16 f16x2 __attribute__((ext_vector_type(2)));
typedef short v4i16 __attribute__((ext_vector_type(4)));
typedef float f32x4 __attribute__((ext_vector_type(4)));
typedef float f32x2 __attribute__((ext_vector_type(2)));
typedef unsigned u32x4 __attribute__((ext_vector_type(4)));
typedef unsigned u32x2 __attribute__((ext_vector_type(2)));
typedef int v4i32 __attribute__((ext_vector_type(4)));
typedef int v8i32 __attribute__((ext_vector_type(8)));

constexpr int D = 1024, NB = 4, T = 8192, NCX = 256, DEPTH = 4;
constexpr int RL = NB * T, RC = NB * NCX, R = RL + RC;
constexpr int NE = 16, CAPL = 1024, CAPC = 32, FF = 2048, EROWS = 4352, ETILES = 17;
constexpr float NORM_EPS = 1e-6f;
constexpr float LOG2E = 1.4426950408889634f;
constexpr float QSCALE = 0.125f * LOG2E;
constexpr float ZSCALE = 1.0f / 64.0f, ZUNSCALE = 64.0f;

constexpr size_t MiB = 1u << 20;
constexpr size_t WS_CTL = 0, CTL_ZERO_BYTES = 64 * 1024;
constexpr size_t WS_MOD = 1 * MiB;
constexpr size_t WS_ROPE = WS_MOD + 512 * 1024;
constexpr size_t WS_H2L = 2 * MiB;
constexpr size_t WS_H2C = 4 * MiB;
constexpr size_t WS_HC = 5 * MiB;
constexpr size_t WS_AFFL = 9 * MiB;
constexpr size_t WS_AFFC = 11 * MiB;
constexpr size_t WS_INV = 12 * MiB;
constexpr size_t WS_ROWIDX = 14 * MiB;
constexpr size_t WS_WA_IN = 16 * MiB;
constexpr size_t WS_WA_OUT = 22 * MiB;
constexpr size_t WS_WB_IN = 26 * MiB;
constexpr size_t WS_WB_OUT = 32 * MiB;
constexpr size_t WS_WC_IN = 34 * MiB;
constexpr size_t WS_WC_OUT = 40 * MiB;
constexpr size_t WS_WEGU = 42 * MiB;
constexpr size_t WS_WED = 170 * MiB;
constexpr size_t WS_U = 234 * MiB;
constexpr size_t WS_P = 300 * MiB;
constexpr size_t WS_O = 498 * MiB;
constexpr size_t WS_ZT = 564 * MiB;
constexpr size_t WS_ATT = 630 * MiB;
constexpr size_t WS_BIG = 830 * MiB;
constexpr size_t WS_H2A = 1102 * MiB;
constexpr size_t WS_W3T = 1107 * MiB;
constexpr size_t WS_FTC = 1110 * MiB;
constexpr size_t WS_WEGU2 = 1114 * MiB;
constexpr size_t WS_WED2 = 1242 * MiB;
constexpr size_t WS_HH = 1306 * MiB;
constexpr size_t WS_END = 1372 * MiB;
constexpr size_t WS_FTL = WS_O;

constexpr int LDS_BYTES = 147456;
constexpr int MISC_OFF = 143360;

__device__ __forceinline__ unsigned pkh(float a, float b) { f16x2 v = {(f16)a, (f16)b}; return __builtin_bit_cast(unsigned, v); }
__device__ __forceinline__ f32x2 h2f_(unsigned v) { const f16x2 h = __builtin_bit_cast(f16x2, v); return (f32x2){(float)h[0], (float)h[1]}; }
template <int M> __device__ __forceinline__ float swz_xor(float v) { return __builtin_bit_cast(float, __builtin_amdgcn_ds_swizzle(__builtin_bit_cast(int, v), 0x1f | (M << 10))); }
__device__ __forceinline__ void swap32(float v, float& a, float& b) { a = v; b = v; asm volatile("v_nop\n\tv_nop\n\tv_permlane32_swap_b32 %0, %1" : "+v"(a), "+v"(b)); }
__device__ __forceinline__ float sum_xor32(float v) { float a, b; swap32(v, a, b); return a + b; }
__device__ __forceinline__ float max_xor32(float v) { float a, b; swap32(v, a, b); return fmaxf(a, b); }
__device__ __forceinline__ float wave_sum(float v) {
    v += swz_xor<1>(v); v += swz_xor<2>(v); v += swz_xor<4>(v); v += swz_xor<8>(v); v += swz_xor<16>(v);
    return sum_xor32(v);
}
__device__ __forceinline__ void unpack8(const u32x4 w, float (&f)[8]) {
    const f16x8 h = __builtin_bit_cast(f16x8, w);
#pragma unroll
    for (int i = 0; i < 8; ++i) f[i] = (float)h[i];
}

constexpr float YE_SCALE = 16.0f;
constexpr float W8_SCALE = 64.0f; constexpr int W8_SCALE_E8M0 = 127 - 6, A8_SCALE_E8M0 = 127;
__device__ __forceinline__ float clamp8(float x) { return fminf(fmaxf(x, -448.0f), 448.0f); }
__device__ __forceinline__ unsigned pk8nc(float a, float b, float c, float d) { int w = 0; w = __builtin_amdgcn_cvt_pk_fp8_f32(a, b, w, false); w = __builtin_amdgcn_cvt_pk_fp8_f32(c, d, w, true); return (unsigned)w; }
__device__ __forceinline__ unsigned pk8(float a, float b, float c, float d) { int w = 0; w = __builtin_amdgcn_cvt_pk_fp8_f32(clamp8(a), clamp8(b), w, false); w = __builtin_amdgcn_cvt_pk_fp8_f32(clamp8(c), clamp8(d), w, true); return (unsigned)w; }
#define XB_TMO      128
#define XB_XCNT(j)  (256  + 64 * (j))
#define XB_XSUB(j)  (1280 + 64 * (j))
#define XB_XGEN(j)  (2304 + 64 * (j))
#define XB_TOP      3328
#define XB_TOPGEN   3392
#define XCD_BAR_WORDS 3456
#define XB_SPIN_CAP (1u << 18)
__device__ __forceinline__ unsigned xb_ld(unsigned* p)              { return __hip_atomic_load(p, __ATOMIC_RELAXED, __HIP_MEMORY_SCOPE_AGENT); }
__device__ __forceinline__ unsigned xb_add(unsigned* p, unsigned v) { return __hip_atomic_fetch_add(p, v, __ATOMIC_RELAXED, __HIP_MEMORY_SCOPE_AGENT); }
__device__ __forceinline__ unsigned xb_xcc_id() { return (unsigned)__builtin_amdgcn_s_getreg((3 << 11) | 20) & 0xFu; }
#define XB_SPIN(cond, bar) do { unsigned _sp = 0; while (cond) { __builtin_amdgcn_s_sleep(1); \
    if ((++_sp & 255u) == 0u) { if (xb_ld(&(bar)[XB_TMO])) break; if (_sp > XB_SPIN_CAP) { atomicAdd(&(bar)[XB_TMO], 1u); break; } } } } while (0)
struct XcdBarrier { unsigned* bar; unsigned x; volatile LAS unsigned* st; };
__device__ __forceinline__ XcdBarrier xcd_barrier_post(unsigned* bar, volatile LAS unsigned* st) {
    XcdBarrier b; b.bar = bar; b.x = xb_xcc_id(); b.st = st;
    if (threadIdx.x == 0) (void)xb_add(&bar[XB_XCNT(b.x)], 1u);
    return b;
}
__device__ __forceinline__ void xcd_barrier_complete(unsigned* bar, unsigned x, unsigned& nloc, unsigned& nx) {
    const unsigned G = gridDim.x * gridDim.y * gridDim.z;
    unsigned sum, cnt, mine, sp = 0u;
    for (;;) {
        sum = 0u; cnt = 0u; mine = 0u;
#pragma unroll
        for (unsigned j = 0; j < 16; ++j) { const unsigned c = xb_ld(&bar[XB_XCNT(j)]); sum += c; cnt += (c > 0u) ? 1u : 0u; mine = (j == x) ? c : mine; }
        if (sum == G) break;
        __builtin_amdgcn_s_sleep(1);
        if ((++sp & 255u) == 0u) { if (xb_ld(&bar[XB_TMO])) break; if (sp > XB_SPIN_CAP) { atomicAdd(&bar[XB_TMO], 1u); break; } }
    }
    nloc = mine > 0u ? mine : 1u; nx = cnt > 0u ? cnt : 1u;
}
__device__ __forceinline__ void xcd_barrier(const XcdBarrier& b) {
    asm volatile("s_waitcnt vmcnt(0)" ::: "memory");
    __syncthreads();
    if (threadIdx.x == 0) {
        unsigned* bar = b.bar;
        __builtin_amdgcn_s_waitcnt(0);
        unsigned nloc = b.st[0], nx = b.st[1];
        if (nloc == 0u) { xcd_barrier_complete(bar, b.x, nloc, nx); b.st[0] = nloc; b.st[1] = nx; }
        const unsigned old = xb_add(&bar[XB_XSUB(b.x)], 1u);
        const unsigned gen = old / nloc;
        if (old + 1u == (gen + 1u) * nloc) {
            __builtin_amdgcn_fence(__ATOMIC_RELEASE, "agent");
            asm volatile("s_waitcnt vmcnt(0)" ::: "memory");
            const unsigned og = xb_add(&bar[XB_TOP], 1u);
            const unsigned tg = og / nx;
            if (og + 1u == (tg + 1u) * nx) xb_add(&bar[XB_TOPGEN], 1u);
            else XB_SPIN(xb_ld(&bar[XB_TOPGEN]) == tg, bar);
            __builtin_amdgcn_fence(__ATOMIC_ACQUIRE, "agent");
            xb_add(&bar[XB_XGEN(b.x)], 1u);
            asm volatile("s_waitcnt vmcnt(0)" ::: "memory");
        } else {
            XB_SPIN(xb_ld(&bar[XB_XGEN(b.x)]) == gen, bar);
            __builtin_amdgcn_fence(__ATOMIC_ACQUIRE, "agent");
            asm volatile("s_waitcnt vmcnt(0)" ::: "memory");
        }
    }
    __syncthreads();
}

namespace pg8 {
constexpr int BM = 256, BK = 64, HALF = 128, HTB = HALF * BK * 2, STAGE_BYTES = 8 * HTB, NXCD = 8, WGM = 8;
__host__ __device__ __forceinline__ int lds_byte(int r, int c) { const int st = (r >> 4) * 2 + (c >> 5), rr = r & 15, cc = c & 31, ob = rr * 64 + cc * 2; return st * 1024 + (ob ^ (((ob >> 9) & 1) << 5)); }
__host__ __device__ __forceinline__ void stage_rc(int b, int& Rr, int& C) { const int st = b / 1024, sb = b % 1024, swz = sb ^ (((sb >> 9) & 1) << 5); Rr = (st >> 1) * 16 + swz / 64; C = (st & 1) * 32 + (swz % 64) / 2; }
__host__ __device__ __forceinline__ int perm32(int rho) { const int n = rho >> 4, i = rho & 15; return 8 * (i >> 2) + 4 * n + (i & 3); }

struct Unit { int pm, pn, pb; };
struct Gemm { const f16* A; const f16* Bt; int K; const int* ridx; };

struct StaticOrder {
    int nM, nN, nwg, G, c;
    __device__ void init(int M, int N, int G_, int c_) { nM = M / BM; nN = N / BM; nwg = nM * nN; G = G_; c = c_; }
    __device__ bool next(int i, Unit& u) const {
        const long L = (long)i * G + c; if (L >= nwg) return false;
        int wgid = (int)L; { const int q = nwg / NXCD, r = nwg % NXCD, xcd = wgid % NXCD, off = wgid / NXCD; wgid = (xcd < r ? xcd * (q + 1) : r * (q + 1) + (xcd - r) * q) + off; }
        const int nig = WGM * nN, gid = wgid / nig, fm = gid * WGM, gsz = (nM - fm) < WGM ? (nM - fm) : WGM;
        u.pm = fm + ((wgid % nig) % gsz); u.pn = (wgid % nig) / gsz; u.pb = u.pn; return true;
    }
};
struct GroupedOrder {
    int nMe, nN, G, c;
    __device__ void init(int nMe_, int nN_, int G_, int c_) { nMe = nMe_; nN = nN_; G = G_; c = c_; }
    __device__ bool next(int i, Unit& u) const {
        const int per = nMe * nN; int e, r;
        if ((G & 7) == 0) { const int x = c & 7, j = c >> 3, w = i * (G >> 3) + j; if (w >= 2 * per) return false; e = 2 * x + w / per; r = w % per; }
        else { const long L = (long)i * G + c; if (L >= (long)NE * per) return false; e = (int)(L / per); r = (int)(L % per); }
        const int nig = WGM * nN, gid = r / nig, fm = gid * WGM, gsz = (nMe - fm) < WGM ? (nMe - fm) : WGM;
        u.pm = e * ETILES + fm + ((r % nig) % gsz); u.pn = (r % nig) / gsz; u.pb = e * nN + u.pn; return true;
    }
};

struct EpiStoreF16 {
    static constexpr bool PERM = true, SWAP = false; static constexpr int BPERM = 0;
    f16* O; int ldc;
    __device__ __forceinline__ void operator()(const f32x4 (&acc)[2][2][4][2], const Unit& u, int wr, int wc, int fr_, int fq_) const {
        int fr = fr_, fq = fq_; asm volatile("" : "+v"(fr), "+v"(fq));
        const int row0 = u.pm * BM + wr * 64 + fr, col0 = u.pn * BM + wc * 32 + 8 * fq;
#pragma unroll
        for (int ai = 0; ai < 2; ++ai)
#pragma unroll
            for (int m = 0; m < 4; ++m) { f16* rowp = O + (size_t)(row0 + ai * HALF + m * 16) * ldc + col0;
#pragma unroll
                for (int bj = 0; bj < 2; ++bj) { const f32x4 v0 = acc[ai][bj][m][0], v1 = acc[ai][bj][m][1];
                    u32x4 w; w.x = pkh(v0[0], v0[1]); w.y = pkh(v0[2], v0[3]); w.z = pkh(v1[0], v1[1]); w.w = pkh(v1[2], v1[3]);
                    *(u32x4*)(rowp + bj * HALF) = w; } }
    }
};
struct EpiStoreF8 {
    static constexpr bool PERM = true, SWAP = false; static constexpr int BPERM = 0;
    unsigned char* O; int ldc; float sc;
    __device__ __forceinline__ void operator()(const f32x4 (&acc)[2][2][4][2], const Unit& u, int wr, int wc, int fr_, int fq_) const {
        int fr = fr_, fq = fq_; asm volatile("" : "+v"(fr), "+v"(fq));
        const int row0 = u.pm * BM + wr * 64 + fr, col0 = u.pn * BM + wc * 32 + 8 * fq;
#pragma unroll
        for (int ai = 0; ai < 2; ++ai)
#pragma unroll
            for (int m = 0; m < 4; ++m) { unsigned char* rowp = O + (size_t)(row0 + ai * HALF + m * 16) * ldc + col0;
#pragma unroll
                for (int bj = 0; bj < 2; ++bj) { const f32x4 v0 = acc[ai][bj][m][0] * sc, v1 = acc[ai][bj][m][1] * sc;
                    u32x2 w; w.x = pk8(v0[0], v0[1], v0[2], v0[3]); w.y = pk8(v1[0], v1[1], v1[2], v1[3]);
                    *(u32x2*)(rowp + bj * HALF) = w; } }
    }
};
__device__ __forceinline__ float silu_mul(float g, float u) { return g * __builtin_amdgcn_rcpf(1.0f + __builtin_amdgcn_exp2f(-g * LOG2E)) * u; }
struct EpiSwiGLU {
    static constexpr bool PERM = true, SWAP = false; static constexpr int BPERM = 0;
    unsigned char* O;
    __device__ __forceinline__ void operator()(const f32x4 (&acc)[2][2][4][2], const Unit& u, int wr, int wc, int fr_, int fq_) const {
        int fr = fr_, fq = fq_; asm volatile("" : "+v"(fr), "+v"(fq));
        const int row0 = u.pm * BM + wr * 64 + fr, col0 = u.pn * HALF + wc * 32 + 8 * fq;
#pragma unroll
        for (int ai = 0; ai < 2; ++ai)
#pragma unroll
            for (int m = 0; m < 4; ++m) { unsigned char* rowp = O + (size_t)(row0 + ai * HALF + m * 16) * FF + col0;
                const f32x4 g0 = acc[ai][0][m][0], g1 = acc[ai][0][m][1], u0 = acc[ai][1][m][0], u1 = acc[ai][1][m][1];
                u32x2 w; w.x = pk8(silu_mul(g0[0], u0[0]), silu_mul(g0[1], u0[1]), silu_mul(g0[2], u0[2]), silu_mul(g0[3], u0[3]));
                w.y = pk8(silu_mul(g1[0], u1[0]), silu_mul(g1[1], u1[1]), silu_mul(g1[2], u1[2]), silu_mul(g1[3], u1[3]));
                *(u32x2*)rowp = w; }
    }
};
struct EpiResidual {
    static constexpr bool PERM = false, SWAP = false; static constexpr int BPERM = 0;
    const float* x_l; const float* x_c; f16* HH; bool first; const float* gate; float scale;
    __device__ __forceinline__ void operator()(const f32x4 (&acc)[2][2][4][2], const Unit& u, int wr, int wc, int fr, int fq) const {
        const bool isc = u.pm >= 128; const int bb = isc ? 4 : (u.pm >> 5);
        const float* hin = isc ? x_c + (size_t)(u.pm - 128) * BM * D : x_l + (size_t)u.pm * BM * D;
        f16* hh = HH + (size_t)u.pm * BM * D;
        const int row0 = wr * 64 + fr, col0 = u.pn * BM + wc * 32 + 4 * fq;
        f32x4 gv[2][2];
#pragma unroll
        for (int bj = 0; bj < 2; ++bj)
#pragma unroll
            for (int n = 0; n < 2; ++n) gv[bj][n] = *(const f32x4*)(gate + bb * 6144 + col0 + bj * HALF + n * 16) * scale;
#pragma unroll
        for (int ai = 0; ai < 2; ++ai)
#pragma unroll
            for (int m = 0; m < 4; ++m) { const size_t off = (size_t)(row0 + ai * HALF + m * 16) * D + col0;
#pragma unroll
                for (int bj = 0; bj < 2; ++bj)
#pragma unroll
                    for (int n = 0; n < 2; ++n) { f32x4 hv;
                        if (first) hv = *(const f32x4*)(hin + off + bj * HALF + n * 16);
                        else { const f16x4 t = *(const f16x4*)(hh + off + bj * HALF + n * 16); hv = (f32x4){(float)t[0], (float)t[1], (float)t[2], (float)t[3]}; }
                        const f32x4 o = hv + gv[bj][n] * acc[ai][bj][m][n]; u32x2 w; w.x = pkh(o.x, o.y); w.y = pkh(o.z, o.w);
                        *(u32x2*)(hh + off + bj * HALF + n * 16) = w; } }
    }
};
struct EpiTransposeF16 {
    static constexpr bool PERM = false, SWAP = true; static constexpr int BPERM = 0;
    f16* PT; f16* PTC;
    __device__ __forceinline__ void operator()(const f32x4 (&acc)[2][2][4][2], const Unit& u, int wr, int wc, int fr, int fq) const {
        const bool isc = u.pm >= 128;
        const int b = isc ? (u.pm - 128) : (u.pm >> 5); const int t0 = isc ? 0 : (u.pm & 31) * BM; const int len = isc ? NCX : T;
        f16* base = (isc ? PTC : PT) + (size_t)b * 3072 * len;
        const int col0 = u.pn * BM + wc * 32 + fr, tt0 = t0 + wr * 64 + 4 * fq;
#pragma unroll
        for (int bj = 0; bj < 2; ++bj)
#pragma unroll
            for (int n = 0; n < 2; ++n) { f16* cp = base + (size_t)(col0 + bj * HALF + n * 16) * len + tt0;
#pragma unroll
                for (int ai = 0; ai < 2; ++ai)
#pragma unroll
                    for (int m = 0; m < 4; ++m) { const f32x4 v = acc[ai][bj][m][n]; u32x2 w; w.x = pkh(v[0], v[1]); w.y = pkh(v[2], v[3]); *(u32x2*)(cp + ai * HALF + m * 16) = w; } }
    }
};

struct EpiFilterT {
    static constexpr bool PERM = false, SWAP = true; static constexpr int BPERM = 0;
    f16* FTL; float* FTC;
    __device__ __forceinline__ void operator()(const f32x4 (&acc)[2][2][4][2], const Unit& u, int wr, int wc, int fr, int fq) const {
        const bool isc = u.pm >= 32;
        const int col0 = u.pn * BM + wc * 32 + fr, tt0 = (isc ? 0 : u.pm * BM) + wr * 64 + 4 * fq;
#pragma unroll
        for (int bj = 0; bj < 2; ++bj)
#pragma unroll
            for (int n = 0; n < 2; ++n) {
                if (isc) { float* cp = FTC + (size_t)(col0 + bj * HALF + n * 16) * NCX + tt0;
#pragma unroll
                    for (int ai = 0; ai < 2; ++ai)
#pragma unroll
                        for (int m = 0; m < 4; ++m) *(f32x4*)(cp + ai * HALF + m * 16) = acc[ai][bj][m][n]; }
                else { f16* cp = FTL + (size_t)(col0 + bj * HALF + n * 16) * T + tt0;
#pragma unroll
                    for (int ai = 0; ai < 2; ++ai)
#pragma unroll
                        for (int m = 0; m < 4; ++m) { const f32x4 v = acc[ai][bj][m][n]; u32x2 w; w.x = pkh(v[0], v[1]); w.y = pkh(v[2], v[3]); *(u32x2*)(cp + ai * HALF + m * 16) = w; } } }
    }
};
template <class Epi, class Sched, bool GATHER = false, bool FP8 = false>
__device__ __forceinline__ void gemm_phase(LAS unsigned char* lds, const int tid, const Gemm g, const Sched& S, const Epi& E) {
    const int wid = __builtin_amdgcn_readfirstlane(tid >> 6), lane = tid & 63, wr = wid >> 2, wc = wid & 3, fr = lane & 15, fq = lane >> 4;
    const int K = g.K, nt = K / BK;
    unsigned voffA[2], voffB[2]; int rowA[2]; unsigned colA[2];
#pragma unroll
    for (int i = 0; i < 2; ++i) { int Rr, C; stage_rc(tid * 16 + i * 8192, Rr, C); const int Rb = Epi::PERM ? ((Rr & ~31) + perm32(Rr & 31)) : Rr;
        voffA[i] = (unsigned)(Rr * K + C) * 2u; voffB[i] = (unsigned)(Rb * K + C) * 2u; rowA[i] = Rr; colA[i] = (unsigned)C * 2u; }
    unsigned voffB2[2][2];
#pragma unroll
    for (int h_ = 0; h_ < 2; ++h_)
#pragma unroll
        for (int i_ = 0; i_ < 2; ++i_) voffB2[h_][i_] = (unsigned)((64 * (rowA[i_] >> 5) + 32 * h_ + (rowA[i_] & 31)) * K) * 2u + colA[i_];
#define PG8_STAGE_B(bufoff, bbase, h) do { if constexpr (Epi::BPERM == 2) PG8_STAGE(bufoff, bbase, voffB2[h]); else PG8_STAGE(bufoff, (bbase) + (h) * hstep, voffB); } while (0)
    unsigned gcur[2][2], gnxt[2][2];
#define PG8_LOADG(dst, u) do { _Pragma("unroll") for (int h_ = 0; h_ < 2; ++h_) _Pragma("unroll") for (int i_ = 0; i_ < 2; ++i_) \
        dst[h_][i_] = (unsigned)g.ridx[(u).pm * BM + h_ * HALF + rowA[i_]] * (unsigned)(K * 2) + colA[i_]; } while (0)
#define PG8_STAGE_A(bufoff, kb, h, nx) do { if constexpr (GATHER) { unsigned o_[2]; o_[0] = (nx) ? gnxt[h][0] : gcur[h][0]; o_[1] = (nx) ? gnxt[h][1] : gcur[h][1]; PG8_STAGE(bufoff, (const char*)g.A + (kb), o_); } \
        else PG8_STAGE(bufoff, ((nx) ? nA : cA) + (kb) + (h) * hstep, voffA); } while (0)
    const size_t kstep = (size_t)(BK * 2);
    const size_t hstep = (size_t)HALF * K * 2;
    const size_t tstep = 2 * hstep;
    const unsigned ldsw = (unsigned)wid * 1024u;
    const int aoff = lds_byte(wr * 64 + fr, fq * 8), boff = lds_byte(wc * 32 + fr, fq * 8);
#define PG8_SA(b, h) (((b) * 2 + (h)) * HTB)
#define PG8_SB(b, h) ((4 + (b) * 2 + (h)) * HTB)
#define PG8_STAGE(bufoff, gbase, voff) do { _Pragma("unroll") for (int _i = 0; _i < 2; ++_i) \
        __builtin_amdgcn_global_load_lds((const unsigned*)((const char*)(gbase) + (voff)[_i]), (LAS unsigned*)(lds + (bufoff) + ldsw + _i * 8192), 16, 0, 0); } while (0)
#define PG8_LDA(dst, b, h) do { _Pragma("unroll") for (int m = 0; m < 4; ++m) _Pragma("unroll") for (int k = 0; k < 2; ++k) dst[m][k] = *(const LAS f16x8*)(lds + PG8_SA(b, h) + aoff + m * 2048 + k * 1024); } while (0)
#define PG8_LDB(dst, b, h) do { _Pragma("unroll") for (int n = 0; n < 2; ++n) _Pragma("unroll") for (int k = 0; k < 2; ++k) dst[n][k] = *(const LAS f16x8*)(lds + PG8_SB(b, h) + boff + n * 2048 + k * 1024); } while (0)
#define PG8_CAT(x0, x1) __builtin_shufflevector(__builtin_bit_cast(v4i32, x0), __builtin_bit_cast(v4i32, x1), 0, 1, 2, 3, 4, 5, 6, 7)
#define PG8_MMA(ai, bj, At, Bt) do { __builtin_amdgcn_s_setprio(1); \
        if constexpr (FP8) { _Pragma("unroll") for (int m = 0; m < 4; ++m) _Pragma("unroll") for (int n = 0; n < 2; ++n) \
            { const v8i32 b8_ = PG8_CAT(Bt[n][0], Bt[n][1]), a8_ = PG8_CAT(At[m][0], At[m][1]); \
              asm("v_mfma_scale_f32_16x16x128_f8f6f4 %0, %1, %2, %0, %3, %4 op_sel_hi:[0,0,0]" : "+v"(acc[ai][bj][m][n]) : "v"(b8_), "v"(a8_), "v"(sc8w), "v"(sc8a)); } } \
        else { _Pragma("unroll") for (int m = 0; m < 4; ++m) _Pragma("unroll") for (int n = 0; n < 2; ++n) _Pragma("unroll") for (int k = 0; k < 2; ++k) \
        acc[ai][bj][m][n] = Epi::SWAP ? __builtin_amdgcn_mfma_f32_16x16x32_f16(At[m][k], Bt[n][k], acc[ai][bj][m][n], 0, 0, 0) \
                                      : __builtin_amdgcn_mfma_f32_16x16x32_f16(Bt[n][k], At[m][k], acc[ai][bj][m][n], 0, 0, 0); } __builtin_amdgcn_s_setprio(0); } while (0)
#define PG8_WAIT_V(n) asm volatile("s_waitcnt vmcnt(" #n ")" ::: "memory")
#define PG8_WAIT_L(n) asm volatile("s_waitcnt lgkmcnt(" #n ")" ::: "memory")
#define PG8_BAR __builtin_amdgcn_s_barrier()
#define PG8_SCHED __builtin_amdgcn_sched_barrier(0)
    Unit cur, nxt; int ui = 0;
    if (!S.next(0, cur)) return;
    const int sc8w = W8_SCALE_E8M0, sc8a = A8_SCALE_E8M0;
    f32x4 acc[2][2][4][2];
#pragma unroll
    for (int a = 0; a < 2; ++a)
#pragma unroll
        for (int b = 0; b < 2; ++b)
#pragma unroll
            for (int m = 0; m < 4; ++m)
#pragma unroll
                for (int n = 0; n < 2; ++n) acc[a][b][m][n] = (f32x4){0.f, 0.f, 0.f, 0.f};
    f16x8 At[4][2], B0[2][2], B1[2][2];
    const char* cA = (const char*)g.A + (size_t)cur.pm * tstep; const char* cB = (const char*)g.Bt + (size_t)cur.pb * tstep; const char* nA = cA;
    if constexpr (GATHER) { PG8_LOADG(gcur, cur); PG8_LOADG(gnxt, cur); }
    PG8_STAGE_B(PG8_SB(0, 0), cB, 0); PG8_STAGE_B(PG8_SB(0, 1), cB, 1); PG8_STAGE_A(PG8_SA(0, 0), 0, 0, false); PG8_STAGE_A(PG8_SA(0, 1), 0, 1, false);
    if (wr == 1) PG8_BAR;
    PG8_WAIT_V(2); PG8_BAR;
    PG8_STAGE_B(PG8_SB(1, 0), cB + kstep, 0); PG8_STAGE_A(PG8_SA(1, 0), kstep, 0, false); PG8_STAGE_B(PG8_SB(1, 1), cB + kstep, 1);
    PG8_WAIT_V(6); PG8_BAR;
    for (;;) {
        const bool has_next = S.next(ui + 1, nxt);
        nA = has_next ? (const char*)g.A + (size_t)nxt.pm * tstep : cA; const char* nB = has_next ? (const char*)g.Bt + (size_t)nxt.pb * tstep : cB;
        if constexpr (GATHER) { const Unit lu = has_next ? nxt : cur; PG8_LOADG(gnxt, lu); }
        for (int t = 0; t < nt; t += 2) {
            const bool last = (t == nt - 2);
            const size_t k1 = (size_t)(t + 1) * kstep, k2 = last ? 0 : (size_t)(t + 2) * kstep, k3 = k2 + kstep;
            const char* b2 = last ? nB : cB + (size_t)(t + 2) * kstep; const char* b3 = b2 + kstep;
            PG8_LDB(B0, 0, 0); PG8_LDB(B1, 0, 1); PG8_SCHED; PG8_LDA(At, 0, 0); PG8_STAGE_A(PG8_SA(1, 1), k1, 1, false);
            PG8_WAIT_V(8); PG8_WAIT_L(0); PG8_BAR; PG8_MMA(0, 0, At, B0); PG8_MMA(0, 1, At, B1); PG8_BAR; PG8_SCHED;
            PG8_LDA(At, 0, 1); PG8_STAGE_B(PG8_SB(0, 0), b2, 0); PG8_STAGE_B(PG8_SB(0, 1), b2, 1); PG8_STAGE_A(PG8_SA(0, 0), k2, 0, last);
            PG8_WAIT_V(8); PG8_WAIT_L(0); PG8_BAR; PG8_MMA(1, 0, At, B0); PG8_MMA(1, 1, At, B1); PG8_BAR; PG8_SCHED;
            PG8_LDB(B0, 1, 0); PG8_LDB(B1, 1, 1); PG8_SCHED; PG8_LDA(At, 1, 0); PG8_STAGE_A(PG8_SA(0, 1), k2, 1, last);
            PG8_WAIT_V(8); PG8_WAIT_L(0); PG8_BAR; PG8_MMA(0, 0, At, B0); PG8_MMA(0, 1, At, B1); PG8_BAR; PG8_SCHED;
            PG8_LDA(At, 1, 1); PG8_STAGE_B(PG8_SB(1, 0), b3, 0); PG8_STAGE_B(PG8_SB(1, 1), b3, 1); PG8_STAGE_A(PG8_SA(1, 0), k3, 0, last);
            PG8_WAIT_V(8); PG8_WAIT_L(0); PG8_BAR; PG8_MMA(1, 0, At, B0); PG8_MMA(1, 1, At, B1); PG8_BAR; PG8_SCHED;
        }
        if (wr == 0) PG8_BAR;
        if constexpr (FP8) asm volatile("s_nop 15\n\ts_nop 15" ::: "memory");
        E(acc, cur, wr, wc, fr, fq);
        if (!has_next) break;
#pragma unroll
        for (int a = 0; a < 2; ++a)
#pragma unroll
            for (int b = 0; b < 2; ++b)
#pragma unroll
                for (int m = 0; m < 4; ++m)
#pragma unroll
                    for (int n = 0; n < 2; ++n) acc[a][b][m][n] = (f32x4){0.f, 0.f, 0.f, 0.f};
        cur = nxt; cA = nA; cB = nB; ++ui;
        if constexpr (GATHER) {
#pragma unroll
            for (int h_ = 0; h_ < 2; ++h_)
#pragma unroll
                for (int i_ = 0; i_ < 2; ++i_) gcur[h_][i_] = gnxt[h_][i_]; }
        if (wr == 1) PG8_BAR;
    }
    PG8_WAIT_V(0);
    PG8_BAR;
#undef PG8_SA
#undef PG8_SB
#undef PG8_STAGE
#undef PG8_STAGE_A
#undef PG8_STAGE_B
#undef PG8_LOADG
#undef PG8_LDA
#undef PG8_LDB
#undef PG8_MMA
#undef PG8_CAT
#undef PG8_WAIT_V
#undef PG8_WAIT_L
#undef PG8_BAR
#undef PG8_SCHED
}
}

struct Args { const float* in[34]; float* out; unsigned char* ws; int ph_lo, ph_hi; };
struct Ctx {
    LAS unsigned char* lds; int tid, lane, wave, G, bid;
    const float* const* in; float* out; unsigned char* ws;
};
#define IN_X 0
#define IN_C 1
#define IN_CTX 2
#define IN_CCTX 3
#define IN_ADA_W 4
#define IN_ADA_B 5
#define IN_NMIX 6
#define IN_NFFN 7
#define IN_ROUTER 8
#define IN_WGATE 9
#define IN_WUP 10
#define IN_WDOWN 11
#define IN_A_WIN 12
#define IN_A_WOUT 13
#define IN_A_QG 14
#define IN_A_KG 15
#define IN_A_SINK 16
#define IN_B_WIN 17
#define IN_B_SW 18
#define IN_B_SB 19
#define IN_B_W1 20
#define IN_B_B1 21
#define IN_B_F1 22
#define IN_B_W2 23
#define IN_B_B2 24
#define IN_B_F2 25
#define IN_B_W3 26
#define IN_B_BIAS 27
#define IN_B_WOUT 28
#define IN_C_WIN 29
#define IN_C_WOUT 30
#define IN_C_QG 31
#define IN_C_KG 32
#define IN_C_RPB 33

__device__ __forceinline__ void transpose_item(const float* W, int K, int N, f16* WT, int k0, int n0, int dst_row0, LAS float* scr, int lane) {
    float v[64];
    const float* src = W + (size_t)k0 * N + n0 + lane;
#pragma unroll
    for (int kk = 0; kk < 64; ++kk) v[kk] = src[(size_t)kk * N];
#pragma unroll
    for (int kk = 0; kk < 64; ++kk) scr[kk * 65 + lane] = v[kk];
    asm volatile("s_waitcnt lgkmcnt(0)" ::: "memory");
    const int c = lane & 7, ns = lane >> 3;
#pragma unroll
    for (int j = 0; j < 8; ++j) { const int n = ns + 8 * j; const LAS float* sp = scr + (8 * c) * 65 + n;
        u32x4 o; o.x = pkh(sp[0 * 65], sp[1 * 65]); o.y = pkh(sp[2 * 65], sp[3 * 65]); o.z = pkh(sp[4 * 65], sp[5 * 65]); o.w = pkh(sp[6 * 65], sp[7 * 65]);
        *(u32x4*)(WT + (size_t)(dst_row0 + n) * K + k0 + 8 * c) = o; }
    asm volatile("s_waitcnt lgkmcnt(0)" ::: "memory");
}
__device__ __forceinline__ void transpose_item8(const float* W, int K, int N, unsigned char* WT, int k0, int n0, int dst_row0, LAS float* scr, int lane) {
    float v[64];
    const float* src = W + (size_t)k0 * N + n0 + lane;
#pragma unroll
    for (int kk = 0; kk < 64; ++kk) v[kk] = src[(size_t)kk * N];
#pragma unroll
    for (int kk = 0; kk < 64; ++kk) scr[kk * 65 + lane] = v[kk] * W8_SCALE;
    asm volatile("s_waitcnt lgkmcnt(0)" ::: "memory");
    const int c = lane & 7, ns = lane >> 3;
#pragma unroll
    for (int j = 0; j < 8; ++j) { const int n = ns + 8 * j; const LAS float* sp = scr + (8 * c) * 65 + n;
        u32x2 o; o.x = pk8(sp[0 * 65], sp[1 * 65], sp[2 * 65], sp[3 * 65]); o.y = pk8(sp[4 * 65], sp[5 * 65], sp[6 * 65], sp[7 * 65]);
        *(u32x2*)(WT + (size_t)(dst_row0 + n) * K + k0 + 8 * c) = o; }
    asm volatile("s_waitcnt lgkmcnt(0)" ::: "memory");
}
__device__ __forceinline__ void transpose_matrix_items(const Ctx& C, const float* W, int K, int N, f16* WT, int& base, int gw, int NGW) {
    const int nblk = N / 64, nit = (K / 64) * nblk;
    LAS float* scr = (LAS float*)(C.lds + C.wave * 16640);
    int first = (gw - base % NGW + NGW) % NGW;
    for (int it = first; it < nit; it += NGW) { const int kb = it / nblk, nb = it % nblk; transpose_item(W, K, N, WT, 64 * kb, 64 * nb, 64 * nb, scr, C.lane); }
    base += nit;
}

__device__ __forceinline__ float silu_f(float x) { return x / (1.0f + expf(-x)); }

__device__ __forceinline__ void prologue_mod(const Ctx& C) {
    LAS float* sc = (LAS float*)C.lds;
    LAS float* red = (LAS float*)(C.lds + 32768);
    if (C.bid >= 96) return;
    for (int i = C.tid; i < 5 * 1024; i += 512) { const int bb = i >> 10, k = i & 1023; const float v = bb < 4 ? C.in[IN_C][bb * 1024 + k] : C.in[IN_CCTX][k]; sc[i] = silu_f(v); }
    __syncthreads();
    for (int u = C.bid; u < 96; u += C.G) {
        const int layer = u / 24, cg = u % 24; const float* W = C.in[IN_ADA_W] + (size_t)layer * 1024 * 6144 + cg * 256 + 4 * C.lane;
        f32x4 acc[5];
#pragma unroll
        for (int bb = 0; bb < 5; ++bb) acc[bb] = (f32x4){0.f, 0.f, 0.f, 0.f};
        const int kb = C.wave * 128;
#pragma unroll 4
        for (int k = 0; k < 128; ++k) { const f32x4 w = *(const f32x4*)(W + (size_t)(kb + k) * 6144);
#pragma unroll
            for (int bb = 0; bb < 5; ++bb) acc[bb] += w * sc[bb * 1024 + kb + k]; }
#pragma unroll
        for (int bb = 0; bb < 5; ++bb) *(LAS f32x4*)(red + (C.wave * 5 + bb) * 256 + 4 * C.lane) = acc[bb];
        __syncthreads();
        for (int i = C.tid; i < 5 * 256; i += 512) { const int bb = i >> 8, cc = i & 255; float s = C.in[IN_ADA_B][layer * 6144 + cg * 256 + cc];
#pragma unroll
            for (int w = 0; w < 8; ++w) s += red[(w * 5 + bb) * 256 + cc];
            ((float*)(C.ws + WS_MOD))[(size_t)(layer * 5 + bb) * 6144 + cg * 256 + cc] = s; }
        __syncthreads();
    }
}
__device__ __forceinline__ void prologue_tables(const Ctx& C, int gw, int NGW) {
    float* rope = (float*)(C.ws + WS_ROPE);
    for (int i = gw * 64 + C.lane; i < 128 * 16; i += NGW * 64) { const int pos = i >> 4, f = i & 15;
        const float inv = 1.0f / powf(10000.0f, (float)(2 * f) / 32.0f); const float ang = (float)pos * inv;
        rope[i] = cosf(ang); rope[2048 + i] = sinf(ang); }
    LAS float* zb = (LAS float*)(C.lds + 133120 + C.wave * 512);
    const float* w1 = C.in[IN_B_W1]; const float* b1 = C.in[IN_B_B1]; const float* f1 = C.in[IN_B_F1];
    const float* w2 = C.in[IN_B_W2]; const float* b2 = C.in[IN_B_B2]; const float* f2 = C.in[IN_B_F2];
    f16* H2A = (f16*)(C.ws + WS_H2A);
    for (int p = gw; p < T + NCX; p += NGW) {
        const bool isc = p >= T; const int t = isc ? p - T : p; const int n = isc ? NCX : T;
        float z = 0.f;
        if (C.lane == 0) z = (float)t / (float)(n - 1);
        else if (C.lane < 33) { const int k = (C.lane - 1) & 15; const float f = 1e-4f + (float)k * ((15.0f - 1e-4f) / 15.0f); const float w = (6.283185307179586f * (float)t) / (float)n;
            z = C.lane < 17 ? cosf(f * w) : -sinf(f * w); }
        zb[C.lane] = z;
        asm volatile("s_waitcnt lgkmcnt(0)" ::: "memory");
        float a = b1[C.lane];
        for (int k = 0; k < 33; ++k) a += zb[k] * w1[k * 64 + C.lane];
        const float h1 = sinf(f1[C.lane] * a);
        zb[64 + C.lane] = h1;
        asm volatile("s_waitcnt lgkmcnt(0)" ::: "memory");
        float a2 = b2[C.lane];
        for (int k = 0; k < 64; ++k) a2 += zb[64 + k] * w2[k * 64 + C.lane];
        const float h2 = sinf(f2[C.lane] * a2);
        f16* dst = H2A + (size_t)p * 256;
        dst[C.lane] = (f16)h2;
        if (C.lane < 48) *(u32x2*)(dst + 64 + 4 * C.lane) = (u32x2){0u, 0u};
        asm volatile("s_waitcnt lgkmcnt(0)" ::: "memory");
    }
    { f16* W3T = (f16*)(C.ws + WS_W3T);
      for (int r = gw; r < 4096; r += NGW) { if (C.lane < 48) *(u32x2*)(W3T + (size_t)r * 256 + 64 + 4 * C.lane) = (u32x2){0u, 0u}; } }
}
__device__ __forceinline__ void phase_prologue(const Ctx& C) {
    prologue_mod(C);
    __syncthreads();
    const int gw = C.bid * 8 + C.wave, NGW = C.G * 8;
    int base = 0;
    for (int j = 0; j < 2; ++j) transpose_matrix_items(C, C.in[IN_A_WIN] + (size_t)j * 1024 * 1536, 1024, 1536, (f16*)(C.ws + WS_WA_IN) + (size_t)j * 1536 * 1024, base, gw, NGW);
    for (int j = 0; j < 2; ++j) transpose_matrix_items(C, C.in[IN_A_WOUT] + (size_t)j * 1024 * 1024, 1024, 1024, (f16*)(C.ws + WS_WA_OUT) + (size_t)j * 1024 * 1024, base, gw, NGW);
    transpose_matrix_items(C, C.in[IN_B_WIN], 1024, 3072, (f16*)(C.ws + WS_WB_IN), base, gw, NGW);
    transpose_matrix_items(C, C.in[IN_B_WOUT], 1024, 1024, (f16*)(C.ws + WS_WB_OUT), base, gw, NGW);
    transpose_matrix_items(C, C.in[IN_C_WIN], 1024, 3072, (f16*)(C.ws + WS_WC_IN), base, gw, NGW);
    transpose_matrix_items(C, C.in[IN_C_WOUT], 1024, 1024, (f16*)(C.ws + WS_WC_OUT), base, gw, NGW);
    { LAS float* scr = (LAS float*)(C.lds + C.wave * 16640);
      const int first = (gw - base % NGW + NGW) % NGW;
      for (int it = first; it < 64; it += NGW) transpose_item(C.in[IN_B_W3], 256, 4096, (f16*)(C.ws + WS_W3T), 0, 64 * it, 64 * it, scr, C.lane);
      base += 64; }
    prologue_tables(C, gw, NGW);
}

struct PnSel { const unsigned char* yp[4]; float g[4]; unsigned mask; int cnt; };
template <bool FIRST  > __device__ __forceinline__ void phase_pn_t(const Ctx& C, int layer) {
    const int lane = C.lane;
    const int nrows = layer == DEPTH ? RL : R;
    const float* MOD = (const float*)(C.ws + WS_MOD);
    f16* HH = (f16*)(C.ws + WS_HH);
    const unsigned char* YE = C.ws + WS_ATT;
    const unsigned short* INV = (const unsigned short*)(C.ws + WS_INV);
    const float* AFFL = (const float*)(C.ws + WS_AFFL); const float* AFFC = (const float*)(C.ws + WS_AFFC);
    f16* U = (f16*)(C.ws + WS_U);
    const bool comb = !FIRST;
    const int rpb = (nrows + C.G - 1) / C.G;
    const int rb0 = min(C.bid * rpb, nrows), rb1 = min(rb0 + rpb, nrows), cnt = rb1 - rb0;
    const int r0 = rb0 + (C.wave * cnt) / 8, r1 = rb0 + ((C.wave + 1) * cnt) / 8;
    if (r0 >= r1) return;
    const unsigned lo4 = 4u * (unsigned)lane;
#define PN_HIN(row) ((row) >= RL ? C.in[IN_CTX] + (size_t)((row) - RL) * D : C.in[IN_X] + (size_t)(row) * D)
#define PN_LOAD_INV(dst, row) { const u32x4 a_ = *(const u32x4*)(INV + (size_t)(row) * 16), b_ = *(const u32x4*)(INV + (size_t)(row) * 16 + 8); \
        dst[0] = a_.x; dst[1] = a_.y; dst[2] = a_.z; dst[3] = a_.w; dst[4] = b_.x; dst[5] = b_.y; dst[6] = b_.z; dst[7] = b_.w; }
#define PN_SELECT(sel, iwv, row) { unsigned iw_[8]; _Pragma("unroll") for (int i_ = 0; i_ < 8; ++i_) iw_[i_] = __builtin_amdgcn_readfirstlane(iwv[i_]); \
        unsigned m_ = 0; _Pragma("unroll") for (int e_ = 0; e_ < 16; ++e_) m_ |= (((iw_[e_ >> 1] >> ((e_ & 1) * 16)) & 0xffffu) != 0u ? 1u : 0u) << e_; \
        sel.mask = m_; sel.cnt = __builtin_popcount(m_); const bool isc_ = (row) >= RL; const int rc_ = (row) - RL; const int b_ = isc_ ? (rc_ >> 8) : ((row) >> 13); \
        _Pragma("unroll") for (int k_ = 0; k_ < 4; ++k_) { const bool has_ = m_ != 0u; const int e_ = has_ ? __builtin_ctz(m_) : 0; m_ &= m_ - 1u; \
            unsigned w_ = iw_[0]; _Pragma("unroll") for (int i_ = 1; i_ < 8; ++i_) w_ = ((e_ >> 1) == i_) ? iw_[i_] : w_; \
            const unsigned s_ = has_ ? ((w_ >> ((e_ & 1) * 16)) & 0xffffu) : 1u; \
            sel.yp[k_] = YE + ((size_t)e_ * EROWS + (s_ - 1u)) * D; \
            const float gv_ = isc_ ? AFFC[(size_t)(b_ * 16 + e_) * NCX + (rc_ & 255)] : AFFL[(size_t)(b_ * 16 + e_) * T + ((row) & 8191)]; sel.g[k_] = gv_;   } }
    LAS unsigned char* ybuf = C.lds + C.wave * 16384;
#define PN_DMA(sel, buf) { _Pragma("unroll") for (int k_ = 0; k_ < 4; ++k_) { if (k_ < sel.cnt) { \
            __builtin_amdgcn_global_load_lds((const unsigned*)(sel.yp[k_] + 16 * lane), (LAS unsigned*)(ybuf + (buf) * 8192 + k_ * 2048), 16, 0, 0); } } }
    unsigned iw1[8], iw2[8];
    f32x4 vc[4], vn[4];
    u32x2 hc[4], hn[4];
    PnSel sc, sn;
#pragma unroll
    for (int i = 0; i < 8; ++i) { iw1[i] = 0u; iw2[i] = 0u; }
    sc.mask = 0u; sn.mask = 0u; sc.cnt = 0; sn.cnt = 0;
#pragma unroll
    for (int k = 0; k < 4; ++k) { sc.yp[k] = YE; sc.g[k] = 0.f; sn.yp[k] = YE; sn.g[k] = 0.f; }
    if (comb) { unsigned iw0[8]; PN_LOAD_INV(iw0, r0); PN_SELECT(sn, iw0, r0);
        PN_DMA(sn, (r0 & 1));
        PN_LOAD_INV(iw2, min(r0 + 1, r1 - 1)); }
#pragma unroll
    for (int j = 0; j < 4; ++j) { vc[j] = (f32x4){0.f, 0.f, 0.f, 0.f}; vn[j] = vc[j]; hc[j] = (u32x2){0u, 0u}; hn[j] = hc[j]; }
    if (FIRST) { const float* hp = PN_HIN(r0);
#pragma unroll
      for (int j = 0; j < 4; ++j) vn[j] = *(const f32x4*)(hp + lo4 + 256 * j); }
    else {
#pragma unroll
      for (int j = 0; j < 4; ++j) hn[j] = *(const u32x2*)(HH + (size_t)r0 * D + lo4 + 256 * j); }
    int cur_bb = -1; f32x4 g2v[4], gnv[4], shv[4], scv[4];
#pragma unroll
    for (int j = 0; j < 4; ++j) { g2v[j] = (f32x4){0.f, 0.f, 0.f, 0.f}; gnv[j] = g2v[j]; shv[j] = g2v[j]; scv[j] = g2v[j]; }
    for (int row = r0; row < r1; ++row) {
        const bool more = row + 1 < r1;
        const bool isc = row >= RL; const int rc = row - RL; const int b = isc ? (rc >> 8) : (row >> 13); const int bb = isc ? 4 : b;
        if (bb != cur_bb) { cur_bb = bb;
#pragma unroll
            for (int j = 0; j < 4; ++j) { if (comb) g2v[j] = *(const f32x4*)(MOD + (size_t)((layer - 1) * 5 + bb) * 6144 + 5 * 1024 + lo4 + 256 * j) * (1.0f / YE_SCALE);
                if (layer < DEPTH) { gnv[j] = *(const f32x4*)(C.in[IN_NMIX] + layer * 1024 + lo4 + 256 * j); shv[j] = *(const f32x4*)(MOD + (size_t)(layer * 5 + bb) * 6144 + lo4 + 256 * j); scv[j] = *(const f32x4*)(MOD + (size_t)(layer * 5 + bb) * 6144 + 1024 + lo4 + 256 * j); } } }
        asm volatile("s_waitcnt vmcnt(0)" ::: "memory");
        {
#pragma unroll
            for (int j = 0; j < 4; ++j) { vc[j] = vn[j]; hc[j] = hn[j]; }
            if (comb) {
#pragma unroll
                for (int k = 0; k < 4; ++k) { sc.yp[k] = sn.yp[k]; sc.g[k] = sn.g[k]; }
                sc.mask = sn.mask; sc.cnt = sn.cnt;
#pragma unroll
                for (int i = 0; i < 8; ++i) iw1[i] = iw2[i];
            }
        }
        f32x4 v[4];
#pragma unroll
        for (int j = 0; j < 4; ++j) { if (FIRST) v[j] = vc[j]; else { const f16x4 t = __builtin_bit_cast(f16x4, hc[j]); v[j] = (f32x4){(float)t[0], (float)t[1], (float)t[2], (float)t[3]}; } }
        f32x4 acc[4];
#pragma unroll
        for (int j = 0; j < 4; ++j) acc[j] = (f32x4){0.f, 0.f, 0.f, 0.f};
        if (comb) {
#pragma unroll
            for (int k = 0; k < 4; ++k) { if (k < sc.cnt) {
#pragma unroll
                for (int j = 0; j < 4; ++j) { const int y = *(const LAS int*)(ybuf + (row & 1) * 8192 + k * 2048 + 4 * lane + 256 * j);
                    const f32x2 ya = __builtin_amdgcn_cvt_pk_f32_fp8(y, false), yb = __builtin_amdgcn_cvt_pk_f32_fp8(y, true); acc[j] += (f32x4){ya[0], ya[1], yb[0], yb[1]} * sc.g[k]; } } }
            unsigned rest = sc.mask; rest &= rest - 1u; rest &= rest - 1u; rest &= rest - 1u; rest &= rest - 1u;
            while (rest) { const int e = __builtin_ctz(rest); rest &= rest - 1u;
                const unsigned s = __builtin_amdgcn_readfirstlane((unsigned)INV[(size_t)row * 16 + e]);
                const float g = isc ? AFFC[(size_t)(b * 16 + e) * NCX + (rc & 255)] : AFFL[(size_t)(b * 16 + e) * T + (row & 8191)];
                const unsigned char* ye = YE + ((size_t)e * EROWS + (s - 1u)) * D + lo4;
#pragma unroll
                for (int j = 0; j < 4; ++j) { const int y = *(const int*)(ye + 256 * j); const f32x2 ya = __builtin_amdgcn_cvt_pk_f32_fp8(y, false), yb = __builtin_amdgcn_cvt_pk_f32_fp8(y, true); acc[j] += (f32x4){ya[0], ya[1], yb[0], yb[1]} * g; } }
            asm volatile("s_waitcnt lgkmcnt(0)" ::: "memory");
        }
        { const int rn = min(row + 1, r1 - 1);
            if (comb) { PN_SELECT(sn, iw1, rn);
                PN_LOAD_INV(iw2, min(row + 2, r1 - 1));
                if (more) PN_DMA(sn, (rn & 1)); }
            if (FIRST) { const float* hp = PN_HIN(rn);
#pragma unroll
                for (int j = 0; j < 4; ++j) vn[j] = *(const f32x4*)(hp + lo4 + 256 * j); }
            else {
#pragma unroll
                for (int j = 0; j < 4; ++j) hn[j] = *(const u32x2*)(HH + (size_t)rn * D + lo4 + 256 * j); }
        }
        if (comb) {
#pragma unroll
            for (int j = 0; j < 4; ++j) { v[j] += g2v[j] * acc[j];
                if (layer == DEPTH) *(f32x4*)(C.out + (size_t)row * D + lo4 + 256 * j) = v[j];
                else { u32x2 w; w.x = pkh(v[j].x, v[j].y); w.y = pkh(v[j].z, v[j].w); *(u32x2*)(HH + (size_t)row * D + lo4 + 256 * j) = w; } }
        }
        if (layer < DEPTH) {
            float ss = 0.f;
#pragma unroll
            for (int j = 0; j < 4; ++j) ss += (v[j].x * v[j].x + v[j].y * v[j].y) + (v[j].z * v[j].z + v[j].w * v[j].w);
            const float rstd = 1.0f / sqrtf(wave_sum(ss) * (1.0f / D) + NORM_EPS);
#pragma unroll
            for (int j = 0; j < 4; ++j) { const f32x4 u = (v[j] * rstd) * gnv[j] * (scv[j] + 1.0f) + shv[j]; u32x2 w; w.x = pkh(u.x, u.y); w.y = pkh(u.z, u.w);
                *(u32x2*)(U + (size_t)row * D + lo4 + 256 * j) = w; }
        }
    }
#undef PN_HIN
#undef PN_LOAD_INV
#undef PN_SELECT
#undef PN_DMA
}
__device__ __forceinline__ void phase_pn(const Ctx& C, int layer) { if (layer == 0) phase_pn_t<true>(C, 0); else phase_pn_t<false>(C, layer); }
__device__ __forceinline__ void phase_pf(const Ctx& C, int layer) {
    int lane = C.lane, wave = C.wave; asm volatile("" : "+v"(lane));
    const int nrows = layer == DEPTH - 1 ? RL : R;
    const int ngroups = nrows >> 4;
    const int g0 = (int)(((long)C.bid * ngroups) / C.G), g1 = (int)(((long)(C.bid + 1) * ngroups) / C.G);
    LAS float* part = (LAS float*)C.lds;
    const float* MOD = (const float*)(C.ws + WS_MOD);
    const f16* HH = (const f16*)(C.ws + WS_HH);
    float* AFFL = (float*)(C.ws + WS_AFFL); float* AFFC = (float*)(C.ws + WS_AFFC);
    unsigned* INVw = (unsigned*)(C.ws + WS_INV);
    unsigned char* U8 = C.ws + WS_U;
    int* ROWIDX = (int*)(C.ws + WS_ROWIDX);
    { const int gw = C.bid * 8 + wave; if (gw < 64) { const int i = gw * 64 + lane; ROWIDX[(i >> 8) * EROWS + 4096 + (i & 255)] = 0; } }
    const float* Wr = C.in[IN_ROUTER] + (size_t)layer * 1024 * 16;
    const int q = lane >> 4, e = lane & 15, kb = 128 * wave + 8 * q;
    __syncthreads();
    f16x8 Bf[4]; unsigned gsh[4][4], shh[4][4]; float s2 = 0.f; int cur_bb = -1;
#pragma unroll
    for (int j = 0; j < 4; ++j) { Bf[j] = (f16x8){0, 0, 0, 0, 0, 0, 0, 0};
#pragma unroll
        for (int i = 0; i < 4; ++i) { gsh[j][i] = 0u; shh[j][i] = 0u; } }
    u32x4 xn[4];
    if (g0 < g1) {
#pragma unroll
        for (int j = 0; j < 4; ++j) xn[j] = *(const u32x4*)(HH + (size_t)(16 * g0 + e) * D + kb + 32 * j); }
    for (int g = g0; g < g1; ++g) {
        const int row0 = 16 * g; const bool isc = row0 >= RL; const int bb = isc ? 4 : (row0 >> 13);
        LAS float* pw = part + ((g & 1) * 8) * 288;
        if (bb != cur_bb) { cur_bb = bb;
            const float* gn = C.in[IN_NFFN] + layer * 1024; const float* sh = MOD + (size_t)(layer * 5 + bb) * 6144 + 3 * 1024; const float* sc = sh + 1024;
            float s2p = 0.f;
#pragma unroll
            for (int j = 0; j < 4; ++j) { const int k0 = kb + 32 * j;
                const f32x4 ga = *(const f32x4*)(gn + k0), gb = *(const f32x4*)(gn + k0 + 4), sa = *(const f32x4*)(sc + k0), sb2 = *(const f32x4*)(sc + k0 + 4), ha = *(const f32x4*)(sh + k0), hb = *(const f32x4*)(sh + k0 + 4);
                float gs[8], hv[8];
#pragma unroll
                for (int i = 0; i < 4; ++i) { gs[i] = ga[i] * (sa[i] + 1.0f); gs[4 + i] = gb[i] * (sb2[i] + 1.0f); hv[i] = ha[i]; hv[4 + i] = hb[i]; }
                f16x8 bfr;
#pragma unroll
                for (int i = 0; i < 8; ++i) { const float wv = Wr[(size_t)(k0 + i) * 16 + e]; bfr[i] = (f16)(gs[i] * wv); s2p += hv[i] * wv; }
                Bf[j] = bfr;
#pragma unroll
                for (int i = 0; i < 4; ++i) { gsh[j][i] = pkh(gs[2 * i], gs[2 * i + 1]); shh[j][i] = pkh(hv[2 * i], hv[2 * i + 1]); } }
            s2p += swz_xor<16>(s2p); s2 = sum_xor32(s2p); }
        f16x8 xa[4];
#pragma unroll
        for (int j = 0; j < 4; ++j) xa[j] = __builtin_bit_cast(f16x8, xn[j]);
        { const int gn2 = min(g + 1, g1 - 1);
#pragma unroll
          for (int j = 0; j < 4; ++j) xn[j] = *(const u32x4*)(HH + (size_t)(16 * gn2 + e) * D + kb + 32 * j); }
        f32x4 acc = (f32x4){0.f, 0.f, 0.f, 0.f}; float ss = 0.f;
#pragma unroll
        for (int j = 0; j < 4; ++j) { acc = __builtin_amdgcn_mfma_f32_16x16x32_f16(xa[j], Bf[j], acc, 0, 0, 0);
#pragma unroll
            for (int i = 0; i < 8; ++i) { const float xv = (float)xa[j][i]; ss += xv * xv; } }
        ss += swz_xor<16>(ss); ss = sum_xor32(ss);
        LAS float* mine = pw + wave * 288;
#pragma unroll
        for (int i = 0; i < 4; ++i) mine[(4 * q + i) * 16 + e] = acc[i];
        if (lane < 16) { mine[256 + lane] = ss; mine[272 + lane] = s2; }
        __syncthreads();
        float sst = 0.f;
#pragma unroll
        for (int w2 = 0; w2 < 8; ++w2) sst += pw[w2 * 288 + 256 + e];
        const float rstd = 1.0f / sqrtf(sst * (1.0f / D) + NORM_EPS);
        unsigned char* up = U8 + (size_t)(row0 + e) * D + kb;
#pragma unroll
        for (int j = 0; j < 4; ++j) { float u[8];
#pragma unroll
            for (int i = 0; i < 4; ++i) { const f32x2 gsv = h2f_(gsh[j][i]), shv = h2f_(shh[j][i]);
                u[2 * i] = ((float)xa[j][2 * i] * rstd) * gsv[0] + shv[0]; u[2 * i + 1] = ((float)xa[j][2 * i + 1] * rstd) * gsv[1] + shv[1]; }
            u32x2 o; o.x = pk8(u[0], u[1], u[2], u[3]); o.y = pk8(u[4], u[5], u[6], u[7]);
            *(u32x2*)(up + 32 * j) = o; }
        { const int r = 2 * wave + ((lane >> 4) & 1);
          float lgt = 0.f, sr = 0.f, s2t = 0.f;
#pragma unroll
          for (int w2 = 0; w2 < 8; ++w2) { lgt += pw[w2 * 288 + r * 16 + e]; sr += pw[w2 * 288 + 256 + r]; s2t += pw[w2 * 288 + 272 + e]; }
          lgt = lgt * (1.0f / sqrtf(sr * (1.0f / D) + NORM_EPS)) + s2t;
          float mx = lgt; mx = fmaxf(mx, swz_xor<1>(mx)); mx = fmaxf(mx, swz_xor<2>(mx)); mx = fmaxf(mx, swz_xor<4>(mx)); mx = fmaxf(mx, swz_xor<8>(mx));
          const float pe = expf(lgt - mx);
          float sum = pe; sum += swz_xor<1>(sum); sum += swz_xor<2>(sum); sum += swz_xor<4>(sum); sum += swz_xor<8>(sum);
          const float aff = pe / sum;
          const int row = row0 + r, rc = row - RL;
          float* dst = isc ? AFFC + (size_t)((rc >> 8) * 16 + e) * NCX + (rc & 255) : AFFL + (size_t)((row >> 13) * 16 + e) * T + (row & 8191);
          if (lane < 32) *dst = aff;
          if (lane < 16) INVw[(size_t)(row0 + 2 * wave) * 8 + lane] = 0u; }
    }
}

template <int EPT>
__device__ __forceinline__ void topk_unit(const Ctx& C, const float* vals, int nact  , int K, int e, int rowbase, int slotbase) {
    LAS unsigned* hist = (LAS unsigned*)C.lds;
    LAS unsigned* res = hist + 256;
    LAS unsigned* wtot = hist + 264;
    const int tid = C.tid, lane = C.lane; const bool active = tid < nact;
    unsigned key[EPT];
    if (EPT == 16) {
#pragma unroll
        for (int j = 0; j < 4; ++j) { const u32x4 w = active ? *(const u32x4*)(vals + tid * 16 + 4 * j) : (u32x4){0u, 0u, 0u, 0u}; key[4 * j] = w.x; key[4 * j + 1] = w.y; key[4 * j + 2] = w.z; key[4 * j + 3] = w.w; }
    } else {
#pragma unroll
        for (int j = 0; j < EPT; ++j) key[j] = active ? __float_as_uint(vals[tid * EPT + j]) : 0u;
    }
    unsigned prefix = 0u, mask = 0u; int remaining = K;
    for (int pass = 0; pass < 4; ++pass) {
        const int shift = 24 - 8 * pass;
        if (tid < 256) hist[tid] = 0u;
        __syncthreads();
        if (active) {
#pragma unroll
            for (int j = 0; j < EPT; ++j) if ((key[j] & mask) == prefix) __hip_atomic_fetch_add(&hist[(key[j] >> shift) & 255u], 1u, __ATOMIC_RELAXED, __HIP_MEMORY_SCOPE_WORKGROUP);
        }
        __syncthreads();
        if (C.wave == 0) {
            const unsigned c0 = hist[4 * lane], c1 = hist[4 * lane + 1], c2 = hist[4 * lane + 2], c3 = hist[4 * lane + 3];
            const unsigned tot = c0 + c1 + c2 + c3; unsigned suf = tot;
#pragma unroll
            for (int o = 1; o < 64; o <<= 1) { const unsigned t = (unsigned)__builtin_amdgcn_ds_bpermute(((lane + o) & 63) << 2, (int)suf); if (lane + o < 64) suf += t; }
            const unsigned above = suf - tot;
            if ((int)above < remaining && remaining <= (int)suf) {
                unsigned a = above; int d = -1; unsigned nr = 0;
                const unsigned cs[4] = {c0, c1, c2, c3};
#pragma unroll
                for (int bq = 3; bq >= 0; --bq) { if (d < 0) { if ((int)(a + cs[bq]) >= remaining) { d = 4 * lane + bq; nr = (unsigned)remaining - a; } else a += cs[bq]; } }
                res[0] = (unsigned)d; res[1] = nr;
            }
        }
        __syncthreads();
        const unsigned d = res[0]; remaining = (int)res[1];
        prefix |= d << shift; mask |= 0xFFu << shift;
    }
    const unsigned Tk = prefix; const int need_eq = remaining;
    unsigned gt = 0, eq = 0;
    if (active) {
#pragma unroll
        for (int j = 0; j < EPT; ++j) { gt += key[j] > Tk; eq += key[j] == Tk; }
    }
    const unsigned packed = gt | (eq << 16);
    unsigned incl = packed;
#pragma unroll
    for (int o = 1; o < 64; o <<= 1) { const unsigned t = (unsigned)__builtin_amdgcn_ds_bpermute(((lane - o) & 63) << 2, (int)incl); if (lane >= o) incl += t; }
    if (lane == 63) wtot[C.wave] = incl;
    __syncthreads();
    unsigned pre = 0;
    for (int w = 0; w < C.wave; ++w) pre += wtot[w];
    const unsigned excl = pre + incl - packed;
    unsigned gtb = excl & 0xffffu, eqb = excl >> 16;
    const unsigned total_gt = (unsigned)(K - need_eq);
    int* ROWIDX = (int*)(C.ws + WS_ROWIDX); unsigned short* INV = (unsigned short*)(C.ws + WS_INV);
    if (active) {
#pragma unroll
        for (int j = 0; j < EPT; ++j) {
            int slot = -1;
            if (key[j] > Tk) { slot = (int)gtb; ++gtb; }
            else if (key[j] == Tk) { if ((int)eqb < need_eq) slot = (int)(total_gt + eqb); ++eqb; }
            if (slot >= 0) { const int idx = tid * EPT + j; ROWIDX[e * EROWS + slotbase + slot] = rowbase + idx; INV[(size_t)(rowbase + idx) * 16 + e] = (unsigned short)(slotbase + slot + 1); }
        }
    }
    __syncthreads();
}
__device__ __forceinline__ void phase_topk(const Ctx& C, int layer) {
    const int nunits = layer == DEPTH - 1 ? 64 : 128;
    for (int u = C.bid; u < nunits; u += C.G) {
        if (u < 64) { const int b = u >> 4, e = u & 15; topk_unit<16>(C, (const float*)(C.ws + WS_AFFL) + (size_t)(b * 16 + e) * T, 512, CAPL, e, b * T, b * CAPL); }
        else { const int v = u - 64, b = v >> 4, e = v & 15; topk_unit<1>(C, (const float*)(C.ws + WS_AFFC) + (size_t)(b * 16 + e) * NCX, 256, CAPC, e, RL + b * NCX, NB * CAPL + b * CAPC); }
    }
}
constexpr int CV_ITEMS = NE * 1536;
constexpr int CV_IPB0 = 48, CV_IPB1 = 24, CV_IPB2 = 24;
__device__ __forceinline__ int cv_n0(int layer, int G) { return (G == 256 && layer >= 1) ? 192 * CV_IPB0 : 0; }
__device__ __forceinline__ int cv_idle1(int layer) { const int nwg = (R / 256) * ((layer % 3) == 0 ? 6 : 12); return 256 - nwg % 256; }
__device__ __forceinline__ int cv_n1(int layer, int G) { return G == 256 ? cv_idle1(layer) * CV_IPB1 : 0; }
__device__ __forceinline__ int cv_n2(int layer, int G) { return (G == 256 && layer < DEPTH - 1) ? 240 * CV_IPB2 : 0; }
__device__ __forceinline__ void convert_items(const Ctx& C, int layer, int first, int count  ) {
    LAS float* scr = (LAS float*)(C.lds + C.wave * 16640); const int lane = C.lane;
    unsigned char* WEGU = C.ws + ((layer & 1) ? WS_WEGU2 : WS_WEGU); unsigned char* WED = C.ws + ((layer & 1) ? WS_WED2 : WS_WED);
    const int end = min(first + count, CV_ITEMS);
    for (int it = first + C.wave; it < end; it += 8) {
        const int e = it / 1536, r = it % 1536, kind = r >> 9, q = r & 511;
        if (kind < 2) { const int kb = q >> 5, nb = q & 31, n0 = 64 * nb; const float* W = C.in[kind == 0 ? IN_WGATE : IN_WUP] + ((size_t)layer * NE + e) * 1024 * 2048;
            transpose_item8(W, 1024, 2048, WEGU + (size_t)e * 4096 * 1024, 64 * kb, n0, (n0 >> 7) * 256 + (n0 & 127) + kind * 128, scr, lane); }
        else { const int kb = q >> 4, nb = q & 15; const float* W = C.in[IN_WDOWN] + ((size_t)layer * NE + e) * 2048 * 1024;
            transpose_item8(W, 2048, 1024, WED + (size_t)e * 1024 * 2048, 64 * kb, 64 * nb, 64 * nb, scr, lane); }
    }
}
constexpr int CV_TOPK_EQ = 24;
__device__ __forceinline__ void phase_topk_convert(const Ctx& C, int layer) {
    const int ntk = min(layer == DEPTH - 1 ? 64 : 128, C.G);
    phase_topk(C, layer);
    __syncthreads();
    const int done = cv_n0(layer, C.G) + cv_n1(layer, C.G) + cv_n2(layer, C.G);
    const int rem = CV_ITEMS - done; if (rem <= 0) return;
    const int share = (rem + CV_TOPK_EQ * ntk + C.G - 1) / C.G, small = max(share - CV_TOPK_EQ, 0);
    const int first = C.bid < ntk ? C.bid * small : ntk * small + (C.bid - ntk) * share, cnt = C.bid < ntk ? small : share;
    if (first < rem) convert_items(C, layer, done + first, min(cnt, rem - first));
}

struct AttnSt { f32x4 o[4][4]; float m[4]; float l[4]; };
__device__ __forceinline__ f16x4 tr_read(const LAS char* p) { return __builtin_bit_cast(f16x4, __builtin_amdgcn_ds_read_tr16_b64_v4i16((LAS v4i16*)p)); }
template <int QLO, int QHI, int MODE>
__device__ __forceinline__ void attn_block32(AttnSt& st, const f16x8 (&q)[4][2], const f16x8 (&kf)[2][2], const LAS char* vb, int lane, int p0, int p1, const LAS float* bias) {
    const int h = lane >> 4, li = lane & 15;
    f16x8 vf[4];
    const LAS char* va = vb + (4 * h + (li >> 2)) * 160 + (li & 3) * 8;
#pragma unroll
    for (int dt = 0; dt < 4; ++dt) { const f16x4 a = tr_read(va + dt * 32), b = tr_read(va + 16 * 160 + dt * 32); vf[dt] = (f16x8){a[0], a[1], a[2], a[3], b[0], b[1], b[2], b[3]}; }
    f32x4 sa[4][2];
#pragma unroll
    for (int qt = QLO; qt < QHI; ++qt)
#pragma unroll
        for (int kt = 0; kt < 2; ++kt) { f32x4 z = (f32x4){0.f, 0.f, 0.f, 0.f};
            z = __builtin_amdgcn_mfma_f32_16x16x32_f16(kf[kt][0], q[qt][0], z, 0, 0, 0); sa[qt][kt] = __builtin_amdgcn_mfma_f32_16x16x32_f16(kf[kt][1], q[qt][1], z, 0, 0, 0); }
#pragma unroll
    for (int qp = QLO; qp < QHI; qp += 2) {
        f16x8 pf[2];
#pragma unroll
        for (int u = 0; u < 2; ++u) { const int qt = qp + u; if (qt >= QHI) continue;
            float s[8] = {sa[qt][0][0], sa[qt][0][1], sa[qt][0][2], sa[qt][0][3], sa[qt][1][0], sa[qt][1][1], sa[qt][1][2], sa[qt][1][3]};
            if (MODE == 1) {
                if (p1 < (1 << 20)) {
#pragma unroll
                    for (int i = 0; i < 8; ++i) { const int dlt = p0 + 16 * (i >> 2) + 4 * h + (i & 3) - (16 * qt + li); s[i] = (abs(dlt) <= p1) ? s[i] : -INFINITY; }
                }
            }
            if (MODE == 2) {
                const int qc = 16 * qt + li; const int cs = min(max(qc - 8, 0), 48);
#pragma unroll
                for (int i = 0; i < 8; ++i) { const int kc = p0 + 16 * (i >> 2) + 4 * h + (i & 3); const bool ok = (unsigned)(kc - cs) < 16u; const int bi = min(max(p1 + kc - qc + 15, 0), 464);
                    s[i] += bias[bi]; s[i] = ok ? s[i] : -INFINITY; }
            }
            float mx = fmaxf(fmaxf(fmaxf(s[0], s[1]), fmaxf(s[2], s[3])), fmaxf(fmaxf(s[4], s[5]), fmaxf(s[6], s[7])));
            mx = fmaxf(mx, swz_xor<16>(mx)); mx = max_xor32(mx);
            if (__builtin_amdgcn_ballot_w64(mx > st.m[qt] + 8.0f) != 0ull) {
                const float mnew = fmaxf(st.m[qt], mx); const float alpha = __builtin_amdgcn_exp2f(st.m[qt] - mnew);
                st.l[qt] *= alpha; st.m[qt] = mnew;
#pragma unroll
                for (int dt = 0; dt < 4; ++dt) st.o[dt][qt] = st.o[dt][qt] * alpha;
            }
            const float mcur = st.m[qt];
            float rs = 0.f;
#pragma unroll
            for (int i = 0; i < 8; ++i) { s[i] = __builtin_amdgcn_exp2f(s[i] - mcur); rs += s[i]; }
            st.l[qt] += rs;
            pf[u] = (f16x8){(f16)s[0], (f16)s[1], (f16)s[2], (f16)s[3], (f16)s[4], (f16)s[5], (f16)s[6], (f16)s[7]};
        }
#pragma unroll
        for (int u = 0; u < 2; ++u) { const int qt = qp + u; if (qt >= QHI) continue;
#pragma unroll
            for (int dt = 0; dt < 4; ++dt) st.o[dt][qt] = __builtin_amdgcn_mfma_f32_16x16x32_f16(vf[dt], pf[u], st.o[dt][qt], 0, 0, 0); }
        __builtin_amdgcn_sched_barrier(0);
    }
}
__device__ __forceinline__ void attn_init(AttnSt& st, float m0, float l0) {
#pragma unroll
    for (int qt = 0; qt < 4; ++qt) { st.m[qt] = m0; st.l[qt] = l0;
#pragma unroll
        for (int dt = 0; dt < 4; ++dt) st.o[dt][qt] = (f32x4){0.f, 0.f, 0.f, 0.f}; }
}
__device__ __forceinline__ void attn_store(AttnSt& st, f16* O, size_t row0, int col0, int lane) {
    const int h = lane >> 4, li = lane & 15;
#pragma unroll
    for (int qt = 0; qt < 4; ++qt) { float l = st.l[qt]; l += swz_xor<16>(l); l = sum_xor32(l); const float inv = 1.0f / l;
        f16* rp = O + row0 * D + col0;
        const unsigned lo2 = (unsigned)(li * D + 4 * h) + (unsigned)(16 * qt * D);
#pragma unroll
        for (int dt = 0; dt < 4; ++dt) { const f32x4 v = st.o[dt][qt] * inv; u32x2 w; w.x = pkh(v[0], v[1]); w.y = pkh(v[2], v[3]); *(u32x2*)(rp + (lo2 + (unsigned)(16 * dt))) = w; } }
}
__device__ __forceinline__ void load_q(f16x8 (&q)[4][2], const f16* Q  , int lane) {
    const unsigned loff = (unsigned)((lane & 15) * 64 + 8 * (lane >> 4));
#pragma unroll
    for (int qt = 0; qt < 4; ++qt)
#pragma unroll
        for (int ks = 0; ks < 2; ++ks) q[qt][ks] = *(const f16x8*)(Q + (loff + (unsigned)(qt * 1024 + ks * 32)));
}

constexpr size_t AT_QR = 0, AT_QP = 64 * MiB, AT_KR = 128 * MiB, AT_VV = 144 * MiB, AT_QC = 160 * MiB, AT_KC = 162 * MiB, AT_VC = 163 * MiB;
constexpr size_t CT_Q = 0, CT_K = 64 * MiB, CT_V = 128 * MiB, CT_QC = 192 * MiB, CT_KC = 194 * MiB, CT_VC = 196 * MiB;
template <int KIND  > struct EpiQKV {
    static constexpr bool PERM = false, SWAP = false; static constexpr int BPERM = 2;
    unsigned char* AT; const float* qg; const float* kg; const float* rope; bool need_ctx;
    __device__ __forceinline__ void operator()(const f32x4 (&acc)[2][2][4][2], const pg8::Unit& u, int wr, int wc, int fr_, int fq_) const {
        int fr = fr_, fq = fq_; asm volatile("" : "+v"(fr), "+v"(fq));
        const bool isc = u.pm >= 128; const int b = isc ? (u.pm - 128) : (u.pm >> 5); const int t0 = isc ? 0 : (u.pm & 31) * 256; const int len = isc ? NCX : T;
        int role, head, nh;
        if (KIND == 0) { role = u.pn < 4 ? 0 : (u.pn == 4 ? 1 : 2); head = (u.pn < 4 ? 4 * u.pn : 0) + wc; nh = role == 0 ? 16 : 4; }
        else { role = u.pn >> 2; head = 4 * (u.pn & 3) + wc; nh = 16; }
        if (role == 0 && isc && !need_ctx) return;
        size_t off0, off1 = 0;
        if (KIND == 0) { if (role == 0) { off0 = isc ? AT_QC : AT_QP; off1 = AT_QR; } else if (role == 1) off0 = isc ? AT_KC : AT_KR; else off0 = isc ? AT_VC : AT_VV; }
        else { if (role == 0) off0 = isc ? CT_QC : CT_Q; else if (role == 1) off0 = isc ? CT_KC : CT_K; else off0 = isc ? CT_VC : CT_V; }
        f16* dst0 = (f16*)(AT + off0) + (size_t)(b * nh + head) * len * 64; f16* dst1 = (f16*)(AT + off1) + (size_t)(b * nh + head) * len * 64;
        const float* gp = role == 0 ? qg : kg;
        f32x4 gv[2][2];
#pragma unroll
        for (int bj = 0; bj < 2; ++bj)
#pragma unroll
            for (int n = 0; n < 2; ++n) gv[bj][n] = *(const f32x4*)(gp + 32 * bj + 16 * n + 4 * fq);
        const float osc = role == 0 ? QSCALE : 1.0f;
        const bool rot = (KIND == 0) && !isc && role < 2;
#pragma unroll
        for (int ai = 0; ai < 2; ++ai)
#pragma unroll
            for (int m = 0; m < 4; ++m) {
                const int t = t0 + ai * 128 + wr * 64 + m * 16 + fr;
                f32x4 y[2][2];
#pragma unroll
                for (int bj = 0; bj < 2; ++bj)
#pragma unroll
                    for (int n = 0; n < 2; ++n) y[bj][n] = acc[ai][bj][m][n];
                if (role < 2) {
                    float ss = 0.f;
#pragma unroll
                    for (int bj = 0; bj < 2; ++bj)
#pragma unroll
                        for (int n = 0; n < 2; ++n) ss += (y[bj][n].x * y[bj][n].x + y[bj][n].y * y[bj][n].y) + (y[bj][n].z * y[bj][n].z + y[bj][n].w * y[bj][n].w);
                    ss += swz_xor<16>(ss); ss = sum_xor32(ss);
                    const float r = 1.0f / sqrtf(ss * (1.0f / 64.0f) + NORM_EPS);
#pragma unroll
                    for (int bj = 0; bj < 2; ++bj)
#pragma unroll
                        for (int n = 0; n < 2; ++n) y[bj][n] = y[bj][n] * r * gv[bj][n];
                }
                f16* p0 = dst0 + (size_t)t * 64 + 4 * fq;
                if (!(KIND == 0 && role == 1 && !isc)) {
#pragma unroll
                    for (int bj = 0; bj < 2; ++bj)
#pragma unroll
                        for (int n = 0; n < 2; ++n) { const f32x4 v = y[bj][n] * osc; u32x2 w; w.x = pkh(v.x, v.y); w.y = pkh(v.z, v.w); *(u32x2*)(p0 + 32 * bj + 16 * n) = w; }
                }
                if (rot) {
                    f16* p1 = (role == 0 ? dst1 : dst0) + (size_t)t * 64 + 4 * fq;
#pragma unroll
                    for (int bj = 0; bj < 2; ++bj) { const int pos = bj == 0 ? (t >> 6) : (t & 63);
                        const f32x4 cs = *(const f32x4*)(rope + pos * 16 + 4 * fq), sn = *(const f32x4*)(rope + 2048 + pos * 16 + 4 * fq);
                        const f32x4 r0 = (y[bj][0] * cs - y[bj][1] * sn) * osc, r1 = (y[bj][1] * cs + y[bj][0] * sn) * osc;
                        u32x2 w0, w1; w0.x = pkh(r0.x, r0.y); w0.y = pkh(r0.z, r0.w); w1.x = pkh(r1.x, r1.y); w1.y = pkh(r1.z, r1.w);
                        *(u32x2*)(p1 + 32 * bj) = w0; *(u32x2*)(p1 + 32 * bj + 16) = w1; }
                }
            }
    }
};
__device__ __forceinline__ void head_norm8(const float (&x)[8], const float* g, float (&y)[8]) {
    float ss = 0.f;
#pragma unroll
    for (int i = 0; i < 8; ++i) ss += x[i] * x[i];
    ss += swz_xor<1>(ss); ss += swz_xor<2>(ss); ss += swz_xor<4>(ss);
    const float r = 1.0f / sqrtf(ss * (1.0f / 64.0f) + NORM_EPS);
#pragma unroll
    for (int i = 0; i < 8; ++i) y[i] = x[i] * r * g[i];
}
__device__ __forceinline__ u32x4 pack8(const float (&y)[8], float sc) { u32x4 w; w.x = pkh(y[0] * sc, y[1] * sc); w.y = pkh(y[2] * sc, y[3] * sc); w.z = pkh(y[4] * sc, y[5] * sc); w.w = pkh(y[6] * sc, y[7] * sc); return w; }
__device__ __forceinline__ void phase_prep_a(const Ctx& C, int j  , bool need_ctx) {
    const int gw = C.bid * 8 + C.wave, NGW = C.G * 8, lane = C.lane;
    const f16* P = (const f16*)(C.ws + WS_P); unsigned char* AT = C.ws + WS_ATT;
    const float* rope = (const float*)(C.ws + WS_ROPE);
    const int d0 = 8 * (lane & 7), sub = lane & 7;
    float qg[8], kg[8];
#pragma unroll
    for (int i = 0; i < 8; ++i) { qg[i] = C.in[IN_A_QG][j * 64 + d0 + i]; kg[i] = C.in[IN_A_KG][j * 64 + d0 + i]; }
    for (int row = gw; row < R; row += NGW) {
        const bool isc = row >= RL; const int rc = row - RL; const int b = isc ? (rc >> 8) : (row >> 13); const int t = isc ? (rc & 255) : (row & 8191); const int len = isc ? NCX : T;
        const f16* pr = P + (size_t)row * 1536;
        const int pos = (sub < 4) ? (t >> 6) : (t & 63); const int f0 = 8 * (sub & 1);
        float cs[8], sn[8];
#pragma unroll
        for (int i = 0; i < 8; ++i) { cs[i] = rope[pos * 16 + f0 + i]; sn[i] = rope[2048 + pos * 16 + f0 + i]; }
        const bool is_x1 = !(sub & 2);
#pragma unroll
        for (int jj = 0; jj < 3; ++jj) {
            float x[8], y[8]; unpack8(*(const u32x4*)(pr + 512 * jj + 8 * lane), x);
            const bool isv = (jj == 2) && (lane >= 32);
            head_norm8(x, jj < 2 ? qg : kg, y);
            float ro[8];
#pragma unroll
            for (int i = 0; i < 8; ++i) { const float py = swz_xor<2>(y[i]); ro[i] = is_x1 ? y[i] * cs[i] - py * sn[i] : y[i] * cs[i] + py * sn[i]; }
            if (jj < 2) {
                const int hq = 8 * jj + (lane >> 3);
                if (!isc) { const size_t o = ((size_t)(b * 16 + hq) * T + t) * 64 + d0; *(u32x4*)((f16*)(AT + AT_QP) + o) = pack8(y, QSCALE); *(u32x4*)((f16*)(AT + AT_QR) + o) = pack8(ro, QSCALE); }
                else if (need_ctx) { const size_t o = ((size_t)(b * 16 + hq) * NCX + t) * 64 + d0; *(u32x4*)((f16*)(AT + AT_QC) + o) = pack8(y, QSCALE); }
            } else {
                const int hk = (lane & 31) >> 3; const size_t o = ((size_t)(b * 4 + hk) * len + t) * 64 + d0;
                f16* dst = (f16*)(AT + (isv ? (isc ? AT_VC : AT_VV) : (isc ? AT_KC : AT_KR))) + o;
                *(u32x4*)dst = isv ? pack8(x, 1.0f) : (isc ? pack8(y, 1.0f) : pack8(ro, 1.0f));
            }
        }
    }
}
__device__ __forceinline__ void phase_prep_c(const Ctx& C, bool need_ctx) {
    const int gw = C.bid * 8 + C.wave, NGW = C.G * 8, lane = C.lane;
    const f16* P = (const f16*)(C.ws + WS_P); unsigned char* AT = C.ws + WS_ATT;
    const int d0 = 8 * (lane & 7);
    float qg[8], kg[8];
#pragma unroll
    for (int i = 0; i < 8; ++i) { qg[i] = C.in[IN_C_QG][d0 + i]; kg[i] = C.in[IN_C_KG][d0 + i]; }
    for (int row = gw; row < R; row += NGW) {
        const bool isc = row >= RL; const int rc = row - RL; const int b = isc ? (rc >> 8) : (row >> 13); const int t = isc ? (rc & 255) : (row & 8191); const int len = isc ? NCX : T;
        const f16* pr = P + (size_t)row * 3072;
#pragma unroll
        for (int jj = 0; jj < 6; ++jj) {
            float x[8], y[8]; unpack8(*(const u32x4*)(pr + 512 * jj + 8 * lane), x);
            head_norm8(x, jj < 2 ? qg : kg, y);
            const int hh = 8 * (jj & 1) + (lane >> 3); const size_t o = ((size_t)(b * 16 + hh) * len + t) * 64 + d0;
            if (jj < 2) { if (!isc) *(u32x4*)((f16*)(AT + CT_Q) + o) = pack8(y, QSCALE); else if (need_ctx) *(u32x4*)((f16*)(AT + CT_QC) + o) = pack8(y, QSCALE); }
            else if (jj < 4) *(u32x4*)((f16*)(AT + (isc ? CT_KC : CT_K)) + o) = pack8(y, 1.0f);
            else *(u32x4*)((f16*)(AT + (isc ? CT_VC : CT_V)) + o) = pack8(x, 1.0f);
        }
    }
}

__device__ __forceinline__ void phase_attn_a(const Ctx& C, int j, bool need_ctx) {
    const int lane = C.lane, tid = C.tid, wave = C.wave;
    unsigned char* AT = C.ws + WS_ATT; f16* O = (f16*)(C.ws + WS_O);
    const int nctx = need_ctx ? 32 : 0, nunits = nctx + 1024;
    const int g = wave >> 1, half = wave & 1;
    const int srow = tid >> 3, sch = tid & 7;
    for (int u = C.bid; u < nunits; u += C.G) {
        const bool cu = u < nctx;
        int b, hk, i;
        if (cu) { b = u >> 3; hk = (u >> 1) & 3; i = u & 1; } else { const int v = u - nctx; b = v >> 8; i = (v >> 2) & 63; hk = v & 3; }
        const int hq = hk * 4 + g;
        const int q0 = i * 128 + half * 64;
        const f16* KRb = (const f16*)(AT + AT_KR) + (size_t)(b * 4 + hk) * T * 64; const f16* VVb = (const f16*)(AT + AT_VV) + (size_t)(b * 4 + hk) * T * 64;
        const f16* KCb = (const f16*)(AT + AT_KC) + (size_t)(b * 4 + hk) * NCX * 64; const f16* VCb = (const f16*)(AT + AT_VC) + (size_t)(b * 4 + hk) * NCX * 64;
        const f16* QRw = cu ? (const f16*)(AT + AT_QC) + ((size_t)(b * 16 + hq) * NCX + q0) * 64 : (const f16*)(AT + AT_QR) + ((size_t)(b * 16 + hq) * T + q0) * 64;
        const f16* QPw = cu ? QRw : (const f16*)(AT + AT_QP) + ((size_t)(b * 16 + hq) * T + q0) * 64;
        f16x8 q[4][2];
        load_q(q, QRw, lane);
        AttnSt st; attn_init(st, C.in[IN_A_SINK][j * 16 + hq] * LOG2E, (lane < 16) ? 1.0f : 0.0f);
        const int c_lo = cu ? 0 : (i == 0 ? 2 : 0), c_hi = cu ? 0 : (i == 63 ? 4 : 6), nl = c_hi - c_lo, nch = nl + 4;
        const unsigned soff = (unsigned)(srow * 64 + 8 * sch);
        u32x4 kreg, vreg;
        { const bool loc = 0 < nl; const int kp0 = (i - 1) * 128 + 64 * c_lo;
          const f16* ks = loc ? KRb + (size_t)kp0 * 64 : KCb; const f16* vs = loc ? VVb + (size_t)kp0 * 64 : VCb;
          kreg = *(const u32x4*)(ks + soff); vreg = *(const u32x4*)(vs + soff); }
#define ATTN_A_CHUNK { \
            LAS char* kb = (LAS char*)C.lds + (k & 1) * 20480; LAS char* vbuf = kb + 10240; \
            *(LAS u32x4*)(kb + srow * 160 + sch * 16) = kreg; *(LAS u32x4*)(vbuf + srow * 160 + sch * 16) = vreg; \
            __syncthreads(); \
            { const int k1 = min(k + 1, nch - 1); const bool loc1 = k1 < nl; const int kp1 = (i - 1) * 128 + 64 * (c_lo + k1); const int cc = k1 - nl;        \
                const f16* ks = loc1 ? KRb + (size_t)kp1 * 64 : KCb + (size_t)(64 * cc) * 64; const f16* vs = loc1 ? VVb + (size_t)kp1 * 64 : VCb + (size_t)(64 * cc) * 64; \
                kreg = *(const u32x4*)(ks + soff); vreg = *(const u32x4*)(vs + soff); } \
            const bool loc = k < nl; const int kp0 = (i - 1) * 128 + 64 * (c_lo + k); \
            _Pragma("unroll 1") for (int blk = 0; blk < 2; ++blk) { \
                const LAS char* kblk = kb + blk * 32 * 160; const LAS char* vblk = vbuf + blk * 32 * 160; \
                const int kb0 = kp0 + 32 * blk; \
                if (loc && (kb0 + 31 < q0 - 128 || kb0 > q0 + 63 + 128)) continue; \
                f16x8 kf[2][2]; \
                _Pragma("unroll") for (int kt = 0; kt < 2; ++kt) _Pragma("unroll") for (int ks = 0; ks < 2; ++ks) kf[kt][ks] = *(const LAS f16x8*)(kblk + (16 * kt + (lane & 15)) * 160 + (lane >> 4) * 16 + ks * 64); \
                const bool edge = loc && !(kb0 >= q0 + 63 - 128 && kb0 + 31 <= q0 + 128); \
                attn_block32<0, 4, 1>(st, q, kf, vblk, lane, loc ? kb0 - q0 : 0, edge ? 128 : (1 << 24), nullptr); } }
        int k = 0;
#pragma unroll 1
        for (; k < nl; ++k) ATTN_A_CHUNK
        if (!cu) { load_q(q, QPw, lane); __builtin_amdgcn_sched_barrier(0); }
#pragma unroll 1
        for (; k < nch; ++k) ATTN_A_CHUNK
#undef ATTN_A_CHUNK
        const size_t orow = cu ? (size_t)RL + b * NCX + q0 : (size_t)b * T + q0;
        attn_store(st, O, orow, hq * 64, lane);
        __syncthreads();
    }
}

__device__ __forceinline__ void load_kf(f16x8 (&kf)[2][2], const f16* Kp  , int lane) {
#pragma unroll
    for (int kt = 0; kt < 2; ++kt)
#pragma unroll
        for (int ks = 0; ks < 2; ++ks) kf[kt][ks] = *(const f16x8*)(Kp + ((unsigned)((lane & 15) * 64 + 8 * (lane >> 4)) + (unsigned)(kt * 1024 + ks * 32)));
}
__device__ __forceinline__ void load_vrows(u32x4 (&vr)[4], const f16* Vp, int lane) {
#pragma unroll
    for (int jj = 0; jj < 4; ++jj) vr[jj] = *(const u32x4*)(Vp + ((unsigned)((lane >> 3) * 64 + 8 * (lane & 7)) + (unsigned)(jj * 512)));
}
__device__ __forceinline__ void store_vrows(const u32x4 (&vr)[4], LAS char* vb, int lane) {
#pragma unroll
    for (int jj = 0; jj < 4; ++jj) *(LAS u32x4*)(vb + ((lane >> 3) + 8 * jj) * 160 + (lane & 7) * 16) = vr[jj];
}
__device__ __forceinline__ void phase_attn_c(const Ctx& C, bool need_ctx) {
    const int lane = C.lane, gw = C.bid * 8 + C.wave, NGW = C.G * 8;
    unsigned char* AT = C.ws + WS_ATT; f16* O = (f16*)(C.ws + WS_O);
    LAS char* vbase = (LAS char*)C.lds + C.wave * 10240;
    LAS float* bias = (LAS float*)(C.lds + 81920 + C.wave * 2048);
    const int nlat = NB * 16 * 128, nunits = nlat + (need_ctx ? NB * 16 * 4 : 0);
    for (int u = gw; u < nunits; u += NGW) {
        const bool cu = u >= nlat;
        int b, hh, r;
        if (cu) { const int v = u - nlat; b = v >> 6; hh = (v >> 2) & 15; r = v & 3; } else { b = u >> 11; hh = (u >> 7) & 15; r = u & 127; }
        const f16* Kc = (const f16*)(AT + CT_KC) + (size_t)(b * 16 + hh) * NCX * 64; const f16* Vc = (const f16*)(AT + CT_VC) + (size_t)(b * 16 + hh) * NCX * 64;
        const f16* Kl = (const f16*)(AT + CT_K) + (size_t)(b * 16 + hh) * T * 64; const f16* Vl = (const f16*)(AT + CT_V) + (size_t)(b * 16 + hh) * T * 64;
        f16x8 q[4][2];
        if (cu) load_q(q, (const f16*)(AT + CT_QC) + ((size_t)(b * 16 + hh) * NCX + 64 * r) * 64, lane);
        else load_q(q, (const f16*)(AT + CT_Q) + ((size_t)(b * 16 + hh) * T + 64 * r) * 64, lane);
        if (!cu) { const float* rp = C.in[IN_C_RPB] + hh * 465; for (int i2 = lane; i2 < 465; i2 += 64) bias[i2] = rp[i2] * LOG2E; }
        AttnSt st; attn_init(st, -INFINITY, 0.0f);
        const int r0 = min(max(r - 4, 0), 120);
        const int nblk = cu ? 8 : 24;
        f16x8 kf[2][2], kn[2][2]; u32x4 vr[4];
        load_kf(kf, Kc, lane); load_vrows(vr, Vc, lane); store_vrows(vr, vbase, lane);
#define ATTN_C_STEP(CALL) { \
            const int n1 = n + 1; const bool more = n1 < nblk; \
            const f16* kp = Kc; const f16* vp = Vc; \
            if (more) { if (n1 < 8) { kp = Kc + (size_t)32 * n1 * 64; vp = Vc + (size_t)32 * n1 * 64; } else { const size_t tok = (size_t)(r0 + ((n1 - 8) >> 1)) * 64 + 32 * ((n1 - 8) & 1); kp = Kl + tok * 64; vp = Vl + tok * 64; } } \
            load_kf(kn, kp, lane); load_vrows(vr, vp, lane); \
            const LAS char* vb = vbase + (n & 1) * 5120; \
            CALL; \
            if (more) { store_vrows(vr, vbase + (n1 & 1) * 5120, lane); } \
            _Pragma("unroll") for (int a = 0; a < 2; ++a) _Pragma("unroll") for (int c2 = 0; c2 < 2; ++c2) kf[a][c2] = kn[a][c2]; }
#pragma unroll 1
        for (int n = 0; n < 8; ++n) ATTN_C_STEP((attn_block32<0, 4, 0>(st, q, kf, vb, lane, 0, 0, nullptr)))
#pragma unroll 1
        for (int n = 8; n < nblk; ++n) ATTN_C_STEP((attn_block32<0, 4, 2>(st, q, kf, vb, lane, 32 * ((n - 8) & 1), (r0 + ((n - 8) >> 1) - r + 7) * 31, bias)))
#undef ATTN_C_STEP
        const size_t orow = cu ? (size_t)RL + b * NCX + 64 * r : (size_t)b * T + 64 * r;
        attn_store(st, O, orow, hh * 64, lane);
    }
}

constexpr int FN = 16384;
__host__ __device__ constexpr int brev_c(int k, int bits) { int r = 0; for (int i = 0; i < bits; ++i) if (k & (1 << i)) r |= 1 << (bits - 1 - i); return r; }
__device__ __forceinline__ int swz(int i) { return i ^ ((i >> 4) & 7) ^ (((i >> 7) & 1) << 4) ^ ((((i >> 7) ^ (i >> 8)) & 1) << 3); }
__device__ __forceinline__ f32x2 cmul(f32x2 x, f32x2 w) { f32x2 t, r;
    asm("v_pk_mul_f32 %0, %1, %2 op_sel_hi:[0,1]" : "=v"(t) : "v"(x), "v"(w));
    asm("v_pk_fma_f32 %0, %1, %2, %3 op_sel:[1,1,0] op_sel_hi:[1,0,1] neg_lo:[0,1,0]" : "=v"(r) : "v"(x), "v"(w), "v"(t));
    return r; }
template <bool NR, bool NI> __device__ __forceinline__ f32x2 cmulk(f32x2 x, f32x2 K) { f32x2 t, r;
    if (!NR && !NI) { asm("v_pk_mul_f32 %0, %1, %2 op_sel_hi:[0,1]" : "=v"(t) : "v"(x), "s"(K));
                      asm("v_pk_fma_f32 %0, %1, %2, %3 op_sel:[1,1,0] op_sel_hi:[1,0,1] neg_lo:[0,1,0]" : "=v"(r) : "v"(x), "s"(K), "v"(t)); }
    if (!NR && NI)  { asm("v_pk_mul_f32 %0, %1, %2 op_sel_hi:[0,1] neg_hi:[0,1]" : "=v"(t) : "v"(x), "s"(K));
                      asm("v_pk_fma_f32 %0, %1, %2, %3 op_sel:[1,1,0] op_sel_hi:[1,0,1]" : "=v"(r) : "v"(x), "s"(K), "v"(t)); }
    if (NR && !NI)  { asm("v_pk_mul_f32 %0, %1, %2 op_sel_hi:[0,1] neg_lo:[0,1]" : "=v"(t) : "v"(x), "s"(K));
                      asm("v_pk_fma_f32 %0, %1, %2, %3 op_sel:[1,1,0] op_sel_hi:[1,0,1] neg_lo:[0,1,0] neg_hi:[0,1,0]" : "=v"(r) : "v"(x), "s"(K), "v"(t)); }
    if (NR && NI)   { asm("v_pk_mul_f32 %0, %1, %2 op_sel_hi:[0,1] neg_lo:[0,1] neg_hi:[0,1]" : "=v"(t) : "v"(x), "s"(K));
                      asm("v_pk_fma_f32 %0, %1, %2, %3 op_sel:[1,1,0] op_sel_hi:[1,0,1] neg_hi:[0,1,0]" : "=v"(r) : "v"(x), "s"(K), "v"(t)); }
    return r; }
__device__ __forceinline__ f32x2 dif_sub_rot(f32x2 a, f32x2 b) { f32x2 r; asm("v_pk_add_f32 %0, %1, %2 op_sel:[1,1] op_sel_hi:[0,0] neg_lo:[0,1] neg_hi:[1,0]" : "=v"(r) : "v"(a), "v"(b)); return r; }
__device__ __forceinline__ f32x2 add_irot(f32x2 a, f32x2 b) { f32x2 r; asm("v_pk_add_f32 %0, %1, %2 op_sel:[0,1] op_sel_hi:[1,0] neg_lo:[0,1]" : "=v"(r) : "v"(a), "v"(b)); return r; }
__device__ __forceinline__ f32x2 sub_irot(f32x2 a, f32x2 b) { f32x2 r; asm("v_pk_add_f32 %0, %1, %2 op_sel:[0,1] op_sel_hi:[1,0] neg_hi:[0,1]" : "=v"(r) : "v"(a), "v"(b)); return r; }
__device__ __forceinline__ f32x2 rot_mi(f32x2 a) { f32x2 r; asm("v_pk_add_f32 %0, %1, 0 op_sel:[1,0] op_sel_hi:[0,0] neg_hi:[1,0]" : "=v"(r) : "v"(a)); return r; }
template <bool INV> __device__ __forceinline__ f32x2 tw16(f32x2 x, int r16, f32x2 K1, f32x2 K2, f32x2 K3) {
    const f32x2 K = (r16 == 1 || r16 == 7) ? K1 : (r16 == 2 || r16 == 6) ? K2 : K3;
    return r16 > 4 ? cmulk<true, !INV>(x, K) : cmulk<false, !INV>(x, K);
}
template <int RR, int LGM, bool INVERSE, bool ZHI = false, bool HALFOUT = false>
__device__ __forceinline__ void fft_pass(LAS f32x2* cx, int tid) {
    constexpr int NP = 1 << RR, mlast = 1 << LGM;
    static_assert((LGM == 10 || LGM == 6 || LGM == 2) ? RR == 4 : (LGM == 0 && RR == 2), "pass shapes with a closed-form swizzled address");
    const f32x2 K1 = (f32x2){0.92387953251128674f, 0.38268343236508977f}, K2 = (f32x2){0.70710678118654752f, 0.70710678118654752f}, K3 = (f32x2){0.38268343236508977f, 0.92387953251128674f};
#pragma unroll 1
    for (int it = tid; it < (FN >> RR); it += 512) {
        const int lo = it & (mlast - 1), hi = it >> LGM;
        int pb;
        if (LGM == 10) pb = swz(lo);
        else if (LGM == 6) pb = (hi << 10) + (lo ^ ((lo >> 4) & 3));
        else if (LGM == 2) pb = (hi << 6) + lo + (((hi & 1) | ((((hi >> 1) ^ (hi >> 2)) & 1) << 1) | (((hi >> 1) & 1) << 2)) << 2);
        else pb = swz(4 * ((it & ~48) | ((it & 16) << 1) | ((it & 32) >> 1)));
#define FFT_CK6(k) ((((k) & 1) << 2) | (((((k) >> 1) ^ ((k) >> 2)) & 1) << 3) | ((((k) >> 1) & 1) << 4))
#define FFT_ADDR(k) (LGM == 10 ? pb + ((k) << 10) : LGM == 6 ? (pb ^ FFT_CK6(k)) + ((k) << 6) : LGM == 2 ? (pb ^ (((k) << 2) | (((k) >> 2) & 3))) : (pb ^ (k)))
        f32x2 x[NP];
#pragma unroll
        for (int k = 0; k < NP; ++k) { if (ZHI && k >= NP / 2) x[k] = (f32x2){0.f, 0.f}; else x[k] = cx[FFT_ADDR(k)]; }
        f32x2 w[NP];
        if (LGM > 0) {
            const float fr = (float)lo * (1.0f / (float)(NP * mlast));
            float cs = __builtin_amdgcn_cosf(fr), sn = __builtin_amdgcn_sinf(INVERSE ? fr : -fr);
            asm volatile("s_nop 1" : "+v"(cs), "+v"(sn));
            w[1] = (f32x2){cs, sn};
#pragma unroll
            for (int r = 2; r < NP; ++r) w[r] = (r & 1) == 0 ? cmul(w[r >> 1], w[r >> 1]) : cmul(w[r - 1], w[1]);
        }
        if (INVERSE && LGM > 0) {
#pragma unroll
            for (int k = 1; k < NP; ++k) x[k] = cmul(x[k], w[brev_c(k, RR)]);
        }
        if (!INVERSE) {
#pragma unroll
            for (int hs = NP >> 1; hs >= 1; hs >>= 1) {
#pragma unroll
                for (int k0 = 0; k0 < NP; ++k0) { if (k0 & hs) continue; const int k1 = k0 + hs;
                    const int r16 = (k0 & (hs - 1)) * (8 / hs);
                    const f32x2 a = x[k0], b = x[k1];
                    if (ZHI && hs == NP / 2) {
                        if (r16 == 0) x[k1] = a; else if (r16 == 4) x[k1] = rot_mi(a); else x[k1] = tw16<false>(a, r16, K1, K2, K3);
                    } else {
                        x[k0] = a + b;
                        if (r16 == 0) x[k1] = a - b; else if (r16 == 4) x[k1] = dif_sub_rot(a, b); else x[k1] = tw16<false>(a - b, r16, K1, K2, K3);
                    } }
            }
        } else {
#pragma unroll
            for (int hs = 1; hs < NP; hs <<= 1) {
#pragma unroll
                for (int k0 = 0; k0 < NP; ++k0) { if (k0 & hs) continue; const int k1 = k0 + hs;
                    const int r16 = (k0 & (hs - 1)) * (8 / hs);
                    const f32x2 a = x[k0], b = x[k1];
                    if (r16 == 4) { x[k0] = add_irot(a, b); x[k1] = sub_irot(a, b); }
                    else { const f32x2 bt = r16 == 0 ? b : tw16<true>(b, r16, K1, K2, K3); x[k0] = a + bt; x[k1] = a - bt; } }
            }
        }
        if (!INVERSE && LGM > 0) {
#pragma unroll
            for (int k = 1; k < NP; ++k) x[k] = cmul(x[k], w[brev_c(k, RR)]);
        }
#pragma unroll
        for (int k = 0; k < NP; ++k) { if (HALFOUT && k >= NP / 2) continue; cx[FFT_ADDR(k)] = x[k]; }
#undef FFT_ADDR
#undef FFT_CK6
    }
}
__device__ __forceinline__ int fft_mid_item(int tid, int jj) {
    const int lp = (tid & 15) | ((tid & 16) << 1) | ((tid & 32) >> 1);
    return (((tid >> 6) + 8 * (jj >> 2)) << 8) + ((jj & 3) << 6) + lp;
}
__device__ __forceinline__ void fft_kf_load(const u32x4* kf  , int tid, u32x4 (&kq)[8]) {
#pragma unroll
    for (int jj = 0; jj < 8; ++jj) kq[jj] = kf[fft_mid_item(tid, jj)];
}
__device__ __forceinline__ f32x2 h2f(unsigned v) { const f16x2 h = __builtin_bit_cast(f16x2, v); return (f32x2){(float)h[0], (float)h[1]}; }
__device__ __forceinline__ void fft_mid_mul(LAS f32x2* cx, const u32x4 (&kq)[8], int tid) {
#pragma unroll
    for (int jj = 0; jj < 8; ++jj) { const int it = fft_mid_item(tid, jj);
        const int pb = swz(4 * it);
        const f32x2 x0 = cx[pb], x1 = cx[pb ^ 1], x2 = cx[pb ^ 2], x3 = cx[pb ^ 3];
        const f32x2 a0 = x0 + x2, b0 = x0 - x2, a1 = x1 + x3, b1 = dif_sub_rot(x1, x3);
        f32x2 y0 = a0 + a1, y1 = a0 - a1, y2 = b0 + b1, y3 = b0 - b1;
        y0 = cmul(y0, h2f(kq[jj][0])); y1 = cmul(y1, h2f(kq[jj][1])); y2 = cmul(y2, h2f(kq[jj][2])); y3 = cmul(y3, h2f(kq[jj][3]));
        const f32x2 z0 = y0 + y1, z1 = y0 - y1, z2 = y2 + y3, z3 = y2 - y3;
        cx[pb] = z0 + z2; cx[pb ^ 1] = add_irot(z1, z3); cx[pb ^ 2] = z0 - z2; cx[pb ^ 3] = sub_irot(z1, z3);
    }
}
__device__ __forceinline__ void fft_forward(LAS f32x2* cx, int tid) {
    fft_pass<4, 10, false>(cx, tid); __syncthreads(); fft_pass<4, 6, false>(cx, tid); fft_pass<4, 2, false>(cx, tid); __syncthreads();
    fft_pass<2, 0, false>(cx, tid); __syncthreads();
}
__device__ __forceinline__ void fft_conv(LAS f32x2* cx, const u32x4* kf, int tid) {
    fft_pass<4, 10, false, true>(cx, tid); __syncthreads();
    u32x4 kq[8]; fft_kf_load(kf, tid, kq);
    fft_pass<4, 6, false>(cx, tid); fft_pass<4, 2, false>(cx, tid);
    fft_mid_mul(cx, kq, tid);
    fft_pass<4, 2, true>(cx, tid); fft_pass<4, 6, true>(cx, tid); __syncthreads();
    fft_pass<4, 10, true, false, true>(cx, tid); __syncthreads();
}
__device__ __forceinline__ float block_sum(const Ctx& C, float v, LAS float* scr  ) {
    v = wave_sum(v);
    __syncthreads();
    if (C.lane == 0) scr[C.wave] = v;
    __syncthreads();
    float s = 0.f;
#pragma unroll
    for (int w = 0; w < 8; ++w) s += scr[w];
    return s;
}
__device__ __forceinline__ float hy_delta(int c) {
    const float mind = -4.605170185988091f / 1.5f, maxd = -4.605170185988091f / 0.3f;
    return fabsf(mind + (float)c * ((maxd - mind) / 1023.0f));
}
__device__ __forceinline__ void phase_filter_spectra(const Ctx& C) {
    LAS f32x2* cx = (LAS f32x2*)C.lds;
    LAS float* w3c = (LAS float*)(C.lds + MISC_OFF + 256);
    LAS float* red = (LAS float*)(C.lds + MISC_OFF + 256 + 1024);
    const f16* FT = (const f16*)(C.ws + WS_FTL);
    unsigned* KF = (unsigned*)(C.ws + WS_BIG);
    for (int c = C.bid; c < 1024; c += C.G) {
        int tid = C.tid; asm volatile("" : "+v"(tid));
        __syncthreads();
        const float dl = hy_delta(c);
        float ss0 = 0.f, ss1 = 0.f;
        const int skw = ((C.bid * 37) & 127) * 64;
        const f16* f0 = FT + (size_t)c * T; const f16* f1 = f0 + (size_t)1024 * T; const f16* f2 = f0 + (size_t)2048 * T; const f16* f3 = f0 + (size_t)3072 * T;
#pragma unroll 4
        for (int jj = 0; jj < 8; ++jj) {
            const int t2 = 2 * ((jj * 512 + tid + (skw >> 1)) & 4095);
            const f16x2 h0 = __builtin_bit_cast(f16x2, *(const unsigned*)(f0 + t2)), h1 = __builtin_bit_cast(f16x2, *(const unsigned*)(f1 + t2)),
                        h2 = __builtin_bit_cast(f16x2, *(const unsigned*)(f2 + t2)), h3 = __builtin_bit_cast(f16x2, *(const unsigned*)(f3 + t2));
#pragma unroll
            for (int q = 0; q < 2; ++q) { const int t = t2 + q;
                const float dec = expf(-((float)t / 8191.0f) * dl);
                const f32x4 a = (f32x4){(float)h0[q], (float)h1[q], (float)h2[q], (float)h3[q]} * dec;
                cx[swz(t)] = (f32x2){a[0], a[2]};
                if (t >= 1) { cx[swz(FN - t)] = (f32x2){a[1], a[3]}; ss0 += a[1] * a[1]; ss1 += a[3] * a[3]; }
                else cx[swz(8192)] = (f32x2){0.f, 0.f};
                ss0 += a[0] * a[0]; ss1 += a[2] * a[2]; }
        }
        const float n0 = 1.0f / sqrtf(block_sum(C, ss0, red) + NORM_EPS);
        const float n1 = 1.0f / sqrtf(block_sum(C, ss1, red) + NORM_EPS);
        __syncthreads();
        fft_forward(cx, tid);
        for (int jj = 0; jj < 32; ++jj) {
            const int p = (jj * 512 + tid + 4 * skw) & (FN - 1); const int f = (int)(__brev((unsigned)p) >> 18); const int p2 = (int)(__brev((unsigned)((FN - f) & (FN - 1))) >> 18);
            const f32x2 va = cx[swz(p)], vb = cx[swz(p2)]; const float ar = va[0], ai = va[1], br = vb[0], bi = -vb[1];
            KF[((size_t)0 * 1024 + c) * FN + p] = pkh(0.5f * (ar + br) * n0, 0.5f * (ai + bi) * n0);
            KF[((size_t)1 * 1024 + c) * FN + p] = pkh(0.5f * (ai - bi) * n1, -0.5f * (ar - br) * n1);
        }
    }
}
__device__ __forceinline__ float short_conv(const f16* col, int t, int len, float w0, float w1, float w2, float bs) {
    const float lm = (float)col[max(t - 1, 0)], p0 = (float)col[t], lp = (float)col[min(t + 1, len - 1)];
    const float pm = t > 0 ? lm : 0.f, pp = t + 1 < len ? lp : 0.f;
    return pm * w0 + p0 * w1 + pp * w2 + bs;
}
__device__ __forceinline__ void short_conv8(const f16* col, int t0, float w0, float w1, float w2, float bs, float (&o)[8]) {
    const u32x4 m = *(const u32x4*)(col + t0);
    const float lm = (float)col[max(t0 - 1, 0)], rp = (float)col[min(t0 + 8, T - 1)];
    float x[8]; unpack8(m, x);
    const float left = t0 > 0 ? lm : 0.f, right = t0 + 8 < T ? rp : 0.f;
#pragma unroll
    for (int i = 0; i < 8; ++i) { const float pv = i ? x[i > 0 ? i - 1 : 0] : left, nx = i < 7 ? x[i < 7 ? i + 1 : 7] : right; o[i] = pv * w0 + x[i] * w1 + nx * w2 + bs; }
}
struct Raw8 { u32x4 ma, mb; f16 la, ra, lb, rb; };
__device__ __forceinline__ Raw8 sc_load(const f16* cola, const f16* colb, int t0) {
    Raw8 r; r.ma = *(const u32x4*)(cola + t0); r.mb = *(const u32x4*)(colb + t0);
    r.la = cola[max(t0 - 1, 0)]; r.ra = cola[min(t0 + 8, T - 1)]; r.lb = colb[max(t0 - 1, 0)]; r.rb = colb[min(t0 + 8, T - 1)];
    return r;
}
__device__ __forceinline__ void sc_compute(const Raw8& r, int t0, float w0, float w1, float w2, float bs, f32x2 (&o)[8]) {
    float xa[8], xb[8]; unpack8(r.ma, xa); unpack8(r.mb, xb);
    f32x2 x[8];
#pragma unroll
    for (int i = 0; i < 8; ++i) x[i] = (f32x2){xa[i], xb[i]};
    const f32x2 left = t0 > 0 ? (f32x2){(float)r.la, (float)r.lb} : (f32x2){0.f, 0.f}, right = t0 + 8 < T ? (f32x2){(float)r.ra, (float)r.rb} : (f32x2){0.f, 0.f};
#pragma unroll
    for (int i = 0; i < 8; ++i) { const f32x2 pv = i ? x[i > 0 ? i - 1 : 0] : left, nx = i < 7 ? x[i < 7 ? i + 1 : 7] : right; o[i] = pv * w0 + x[i] * w1 + nx * w2 + bs; }
}
__device__ __forceinline__ void phase_hyena_conv(const Ctx& C, bool need_ctx) {
    LAS f32x2* cx = (LAS f32x2*)C.lds;
    const f16* PT = (const f16*)(C.ws + WS_P); const f16* PTC = PT + (size_t)NB * 3072 * T;
    f16* ZT = (f16*)(C.ws + WS_ZT); f16* ZTC = ZT + (size_t)NB * 1024 * T;
    const u32x4* KF = (const u32x4*)(C.ws + WS_BIG);
    const float* sw = C.in[IN_B_SW]; const float* sb = C.in[IN_B_SB]; const float* fb = C.in[IN_B_BIAS];
    const int nbig = 2048, nunits = nbig + (need_ctx ? 1024 : 0);
    for (int u = C.bid; u < nunits; u += C.G) {
        int tid = C.tid; asm volatile("" : "+v"(tid));
        __syncthreads();
        if (u < nbig) {
            const int c = u >> 1, bp = u & 1;
            float w[3][3], bsv[3];
#pragma unroll
            for (int s = 0; s < 3; ++s) { bsv[s] = sb[s * 1024 + c];
#pragma unroll
                for (int k = 0; k < 3; ++k) w[s][k] = sw[k * 3072 + s * 1024 + c]; }
            const float bias0 = fb[c], bias1 = fb[1024 + c];
            const f16* colv[2]; const f16* colx1[2]; const f16* colx2[2];
#pragma unroll
            for (int bi = 0; bi < 2; ++bi) { const int b = 2 * bp + bi; colv[bi] = PT + ((size_t)b * 3072 + c) * T; colx1[bi] = PT + ((size_t)b * 3072 + 1024 + c) * T; colx2[bi] = PT + ((size_t)b * 3072 + 2048 + c) * T; }
            const int skq = ((C.bid * 37) & 31) << 5;
            const float invn = 1.0f / (float)FN;
            int t0s[2], pbs[2];
#pragma unroll
            for (int jj = 0; jj < 2; ++jj) { t0s[jj] = 8 * ((jj * 512 + tid + skq) & 1023); pbs[jj] = swz(t0s[jj]); }
            Raw8 rv[2], rx1[2], rx2[2];
#pragma unroll
            for (int jj = 0; jj < 2; ++jj) rv[jj] = sc_load(colv[0], colv[1], t0s[jj]);
#pragma unroll
            for (int jj = 0; jj < 2; ++jj) rx1[jj] = sc_load(colx1[0], colx1[1], t0s[jj]);
            unsigned vh[2][8], z1h[2][8];
#pragma unroll
            for (int jj = 0; jj < 2; ++jj) { f32x2 v[8]; sc_compute(rv[jj], t0s[jj], w[0][0], w[0][1], w[0][2], bsv[0], v);
#pragma unroll
                for (int i = 0; i < 8; ++i) { cx[pbs[jj] ^ i] = v[i]; vh[jj][i] = pkh(v[i][0], v[i][1]); } }
            __syncthreads();
            fft_conv(cx, KF + ((size_t)0 * 1024 + c) * (FN / 4), tid);
#pragma unroll
            for (int jj = 0; jj < 2; ++jj) rx2[jj] = sc_load(colx2[0], colx2[1], t0s[jj]);
#pragma unroll
            for (int jj = 0; jj < 2; ++jj) { f32x2 x1[8]; sc_compute(rx1[jj], t0s[jj], w[1][0], w[1][1], w[1][2], bsv[1], x1);
#pragma unroll
                for (int i = 0; i < 8; ++i) { const f32x2 z1 = x1[i] * (cx[pbs[jj] ^ i] * invn + bias0 * h2f(vh[jj][i])); cx[pbs[jj] ^ i] = z1; z1h[jj][i] = pkh(z1[0], z1[1]); } }
            __syncthreads();
            fft_conv(cx, KF + ((size_t)1 * 1024 + c) * (FN / 4), tid);
            f16* za = ZT + ((size_t)(2 * bp) * 1024 + c) * T; f16* zb = ZT + ((size_t)(2 * bp + 1) * 1024 + c) * T;
#pragma unroll
            for (int jj = 0; jj < 2; ++jj) { f32x2 x2[8]; sc_compute(rx2[jj], t0s[jj], w[2][0], w[2][1], w[2][2], bsv[2], x2);
                float oa[8], ob[8];
#pragma unroll
                for (int i = 0; i < 8; ++i) { const f32x2 o = x2[i] * (cx[pbs[jj] ^ i] * invn + bias1 * h2f(z1h[jj][i])) * ZSCALE; oa[i] = o[0]; ob[i] = o[1]; }
                *(u32x4*)(za + t0s[jj]) = pack8(oa, 1.0f); *(u32x4*)(zb + t0s[jj]) = pack8(ob, 1.0f); }
        } else {
            const int c = u - nbig;
            LAS float* w3c = (LAS float*)C.lds;
            LAS float* kk = w3c + 256;
            LAS float* zz = kk + 1088;
            LAS float* red = zz + 1024;
            const float* FTC = (const float*)(C.ws + WS_FTC);
            float ss0 = 0.f, ss1 = 0.f; f32x4 a = (f32x4){0.f, 0.f, 0.f, 0.f};
            if (tid < 256) { const int t = tid;
                a = (f32x4){FTC[(size_t)c * NCX + t], FTC[(size_t)(1024 + c) * NCX + t], FTC[(size_t)(2048 + c) * NCX + t], FTC[(size_t)(3072 + c) * NCX + t]};
                a = a * expf(-((float)t / 255.0f) * hy_delta(c));
                ss0 = a[0] * a[0] + (t >= 1 ? a[1] * a[1] : 0.f); ss1 = a[2] * a[2] + (t >= 1 ? a[3] * a[3] : 0.f); }
            const float n0 = 1.0f / sqrtf(block_sum(C, ss0, red) + NORM_EPS);
            const float n1 = 1.0f / sqrtf(block_sum(C, ss1, red) + NORM_EPS);
            __syncthreads();
#define KKI(i) ((i) + ((i) >> 5))
            if (tid < 256) { const int t = tid; kk[KKI(255 + t)] = a[0] * n0; kk[544 + KKI(255 + t)] = a[2] * n1; if (t >= 1) { kk[KKI(255 - t)] = a[1] * n0; kk[544 + KKI(255 - t)] = a[3] * n1; } }
            float w[3][3], bsv[3];
#pragma unroll
            for (int s = 0; s < 3; ++s) { bsv[s] = sb[s * 1024 + c];
#pragma unroll
                for (int k = 0; k < 3; ++k) w[s][k] = sw[k * 3072 + s * 1024 + c]; }
            const int cb = (tid >> 6) & 3, t0 = (tid & 63) * 4; const bool act = tid < 256;
            float vv[4], x1v[4], x2v[4], z1[4];
#pragma unroll
            for (int i = 0; i < 4; ++i) { const int t = t0 + i;
                vv[i] = short_conv(PTC + ((size_t)cb * 3072 + c) * NCX, t, NCX, w[0][0], w[0][1], w[0][2], bsv[0]);
                x1v[i] = short_conv(PTC + ((size_t)cb * 3072 + 1024 + c) * NCX, t, NCX, w[1][0], w[1][1], w[1][2], bsv[1]);
                x2v[i] = short_conv(PTC + ((size_t)cb * 3072 + 2048 + c) * NCX, t, NCX, w[2][0], w[2][1], w[2][2], bsv[2]);
                if (act) zz[cb * 256 + t] = vv[i]; }
            __syncthreads();
#define CTX_CONV4(y, kbase) { float w0_ = kk[(kbase) + KKI(255 + t0)], w1_ = kk[(kbase) + KKI(256 + t0)], w2_ = kk[(kbase) + KKI(257 + t0)], w3_ = kk[(kbase) + KKI(258 + t0)]; \
                y[0] = 0.f; y[1] = 0.f; y[2] = 0.f; y[3] = 0.f; \
                _Pragma("unroll 8") for (int s_ = 0; s_ < 256; ++s_) { const float zv_ = zz[cb * 256 + s_]; const float nw_ = kk[(kbase) + KKI(max(254 + t0 - s_, 0))]; \
                    y[0] += zv_ * w0_; y[1] += zv_ * w1_; y[2] += zv_ * w2_; y[3] += zv_ * w3_; w3_ = w2_; w2_ = w1_; w1_ = w0_; w0_ = nw_; } }
            float y[4];
            if (act) { CTX_CONV4(y, 0)
#pragma unroll
                for (int i = 0; i < 4; ++i) z1[i] = x1v[i] * (y[i] + fb[c] * vv[i]); }
            __syncthreads();
            if (act) {
#pragma unroll
                for (int i = 0; i < 4; ++i) zz[cb * 256 + t0 + i] = z1[i]; }
            __syncthreads();
            if (act) { CTX_CONV4(y, 544)
                float o4[4];
#pragma unroll
                for (int i = 0; i < 4; ++i) o4[i] = x2v[i] * (y[i] + fb[1024 + c] * z1[i]) * ZSCALE;
                u32x2 wv; wv.x = pkh(o4[0], o4[1]); wv.y = pkh(o4[2], o4[3]);
                *(u32x2*)(ZTC + ((size_t)cb * 1024 + c) * NCX + t0) = wv; }
#undef CTX_CONV4
#undef KKI
        }
    }
}
__device__ __forceinline__ void phase_hyena_transpose(const Ctx& C, bool need_ctx) {
    const int gw = C.bid * 8 + C.wave, NGW = C.G * 8, lane = C.lane;
    LAS f16* tile = (LAS f16*)(C.lds + C.wave * 8448);
    const f16* ZT = (const f16*)(C.ws + WS_ZT); const f16* ZTC = ZT + (size_t)NB * 1024 * T; f16* O = (f16*)(C.ws + WS_O);
    const int nl = NB * 16 * 128, ntiles = nl + (need_ctx ? NB * 16 * 4 : 0);
    for (int it = gw; it < ntiles; it += NGW) {
        const bool isc = it >= nl; const int v = isc ? it - nl : it; const int ntt = isc ? 4 : 128, len = isc ? NCX : T;
        const int b = v / (16 * ntt), cb = (v / ntt) & 15, tb = v % ntt;
        const f16* src = (isc ? ZTC : ZT) + ((size_t)b * 1024 + cb * 64) * len + tb * 64;
#pragma unroll 8
        for (int cc = 0; cc < 64; ++cc) tile[cc * 66 + lane] = src[(size_t)cc * len + lane];
        asm volatile("s_waitcnt lgkmcnt(0)" ::: "memory");
        f16* dst = O + ((size_t)(isc ? RL + b * NCX : b * T) + tb * 64) * D + cb * 64;
#pragma unroll 8
        for (int tt = 0; tt < 64; ++tt) dst[(size_t)tt * D + lane] = tile[lane * 66 + tt];
        asm volatile("s_waitcnt lgkmcnt(0)" ::: "memory");
    }
}

constexpr int PH_PROLOGUE = 1, PH_PER_LAYER_MAX = 11;
__host__ __device__ constexpr int layer_phases(int kind) { return kind == 1 ? 10 : 8; }
__host__ __device__ constexpr int total_phases() { int n = PH_PROLOGUE; for (int i = 0; i < DEPTH; ++i) n += layer_phases(i % 3); return n + 1; }

__global__ void __launch_bounds__(512, 2) mega(Args args) {
    extern __shared__ __attribute__((aligned(16))) unsigned char lds_raw[];
    Ctx C0;
    C0.lds = (LAS unsigned char*)lds_raw; C0.tid = threadIdx.x; C0.lane = C0.tid & 63; C0.wave = __builtin_amdgcn_readfirstlane(C0.tid >> 6); C0.G = gridDim.x; C0.bid = blockIdx.x;
    C0.in = args.in; C0.out = args.out; C0.ws = args.ws;
    volatile LAS unsigned* MISC = (volatile LAS unsigned*)(C0.lds + MISC_OFF);
    if (C0.tid < 64) MISC[C0.tid] = 0u;
    __syncthreads();
    const int lo = args.ph_lo, hi = args.ph_hi;
    XcdBarrier bar; bar.bar = (unsigned*)(C0.ws + WS_CTL); bar.x = 0; bar.st = MISC + 8;
    if (hi - lo > 1) bar = xcd_barrier_post((unsigned*)(C0.ws + WS_CTL), MISC + 8);
    int pid = 0;
#ifndef PROBE_MASK
#define PROBE_MASK 0
#endif
#ifndef PROBE_KINDS
#define PROBE_KINDS 7
#endif
#define PHASE_BEGIN_G(grp) if (lo <= pid && pid < hi) { for (int rep_ = 0; rep_ < 1 + ((((PROBE_MASK) >> (grp)) & 1) && (((PROBE_KINDS) >> pkind) & 1) ? 1 : 0); ++rep_) { Ctx C = C0; asm volatile("" : "+v"(C.tid)); C.lane = C.tid & 63; C.wave = __builtin_amdgcn_readfirstlane(C.tid >> 6); \
        { unsigned long long wsl = (unsigned long long)C.ws; asm volatile("" : "+s"(wsl)); C.ws = (unsigned char*)wsl; }
#define PHASE_END   } if (pid + 1 < hi) xcd_barrier(bar); } ++pid;

    int pkind = 0;
    PHASE_BEGIN_G(0) phase_prologue(C); PHASE_END

    for (int layer = 0; layer < DEPTH; ++layer) {
        const int kind = layer % 3, j = layer / 3; const bool last = layer == DEPTH - 1; const bool need_ctx = !last;
        pkind = kind;
        PHASE_BEGIN_G(1) phase_pn(C, layer); PHASE_END
        PHASE_BEGIN_G(2)
            if (kind == 1) { pg8::Gemm g{(const f16*)(C.ws + WS_U), (const f16*)(C.ws + WS_WB_IN), 1024, nullptr}; pg8::StaticOrder S; S.init(R, 3072, C.G, C.bid);
                pg8::EpiTransposeF16 E{(f16*)(C.ws + WS_P), (f16*)(C.ws + WS_P) + (size_t)NB * 3072 * T}; pg8::gemm_phase(C.lds, C.tid, g, S, E); }
            else if (kind == 0) { pg8::Gemm g{(const f16*)(C.ws + WS_U), (const f16*)(C.ws + WS_WA_IN) + (size_t)j * 1536 * 1024, 1024, nullptr}; pg8::StaticOrder S; S.init(R, 1536, C.G, C.bid);
                EpiQKV<0> E{C.ws + WS_ATT, C.in[IN_A_QG] + j * 64, C.in[IN_A_KG] + j * 64, (const float*)(C.ws + WS_ROPE), need_ctx}; pg8::gemm_phase(C.lds, C.tid, g, S, E); }
            else { pg8::Gemm g{(const f16*)(C.ws + WS_U), (const f16*)(C.ws + WS_WC_IN), 1024, nullptr}; pg8::StaticOrder S; S.init(R, 3072, C.G, C.bid);
                EpiQKV<2> E{C.ws + WS_ATT, C.in[IN_C_QG], C.in[IN_C_KG], (const float*)(C.ws + WS_ROPE), need_ctx}; pg8::gemm_phase(C.lds, C.tid, g, S, E); }
            if (cv_n1(layer, C.G)) { const int rank = C.bid - (256 - cv_idle1(layer));
                if (rank >= 0) {
                    if (kind == 1) {
                        int kf = 256; asm volatile("" : "+s"(kf));
                        pg8::Gemm g{(const f16*)(C.ws + WS_H2A), (const f16*)(C.ws + WS_W3T), kf, nullptr}; pg8::StaticOrder S; S.init(T + NCX, 4096, cv_idle1(layer), rank);
                        pg8::EpiFilterT E{(f16*)(C.ws + WS_FTL), (float*)(C.ws + WS_FTC)}; pg8::gemm_phase(C.lds, C.tid, g, S, E); }
                    convert_items(C, layer, cv_n0(layer, C.G) + rank * CV_IPB1, CV_IPB1); } }
            else if (kind == 1) { int kf = 256; asm volatile("" : "+s"(kf));
                pg8::Gemm g{(const f16*)(C.ws + WS_H2A), (const f16*)(C.ws + WS_W3T), kf, nullptr}; pg8::StaticOrder S; S.init(T + NCX, 4096, C.G, C.bid);
                pg8::EpiFilterT E{(f16*)(C.ws + WS_FTL), (float*)(C.ws + WS_FTC)}; pg8::gemm_phase(C.lds, C.tid, g, S, E); }
        PHASE_END
        if (kind == 1) { PHASE_BEGIN_G(3) phase_filter_spectra(C); PHASE_END }
        PHASE_BEGIN_G(4)
            if (kind == 0) phase_attn_a(C, j, need_ctx); else if (kind == 1) phase_hyena_conv(C, need_ctx); else phase_attn_c(C, need_ctx);
        PHASE_END
        if (kind == 1) { PHASE_BEGIN_G(5) phase_hyena_transpose(C, need_ctx); PHASE_END }
        PHASE_BEGIN_G(6)
            { const f16* W = kind == 0 ? (const f16*)(C.ws + WS_WA_OUT) + (size_t)j * 1024 * 1024 : (kind == 1 ? (const f16*)(C.ws + WS_WB_OUT) : (const f16*)(C.ws + WS_WC_OUT));
              pg8::Gemm g{(const f16*)(C.ws + WS_O), W, 1024, nullptr}; pg8::StaticOrder S; S.init(need_ctx ? R : RL, 1024, C.G, C.bid);
              pg8::EpiResidual E{C.in[IN_X], C.in[IN_CTX], (f16*)(C.ws + WS_HH), layer == 0,
                                 (const float*)(C.ws + WS_MOD) + (size_t)layer * 5 * 6144 + 2 * 1024, kind == 1 ? ZUNSCALE : 1.0f};
              pg8::gemm_phase(C.lds, C.tid, g, S, E);
              if (cv_n2(layer, C.G) && C.bid >= 16) convert_items(C, layer, cv_n0(layer, C.G) + cv_n1(layer, C.G) + (C.bid - 16) * CV_IPB2, CV_IPB2); }
        PHASE_END
        PHASE_BEGIN_G(7) phase_pf(C, layer); PHASE_END
        PHASE_BEGIN_G(8) phase_topk_convert(C, layer); PHASE_END
        PHASE_BEGIN_G(10)
            { int kq = 512  ; asm volatile("" : "+s"(kq));
              pg8::Gemm g{(const f16*)(C.ws + WS_U), (const f16*)(C.ws + ((layer & 1) ? WS_WEGU2 : WS_WEGU)), kq, (const int*)(C.ws + WS_ROWIDX)}; pg8::GroupedOrder S; S.init(last ? 16 : 17, 16, C.G, C.bid); pg8::EpiSwiGLU E{C.ws + WS_BIG};
              pg8::gemm_phase<pg8::EpiSwiGLU, pg8::GroupedOrder, true, true>(C.lds, C.tid, g, S, E); }
        PHASE_END
        PHASE_BEGIN_G(11)
            { int kq = 1024  ; asm volatile("" : "+s"(kq));
              pg8::Gemm g{(const f16*)(C.ws + WS_BIG), (const f16*)(C.ws + ((layer & 1) ? WS_WED2 : WS_WED)), kq, nullptr}; pg8::GroupedOrder S; S.init(last ? 16 : 17, 4, C.G, C.bid); pg8::EpiStoreF8 E{C.ws + WS_ATT, 1024, YE_SCALE};
              pg8::gemm_phase<pg8::EpiStoreF8, pg8::GroupedOrder, false, true>(C.lds, C.tid, g, S, E);
              if (cv_n0(layer + 1, C.G) && layer + 1 < DEPTH && (C.bid >> 3) >= 8) convert_items(C, layer + 1, (((C.bid & 7) * 24) + ((C.bid >> 3) - 8)) * CV_IPB0, CV_IPB0); }
        PHASE_END
    }
    PHASE_BEGIN_G(1) phase_pn(C, DEPTH); PHASE_END
}

extern "C" void kernel_launch(void* const* d_in, const int* in_sizes, int n_in, void* d_out, int out_size, void* d_ws, size_t ws_size, hipStream_t stream) {
    static int grid = 0;
    if (grid == 0) {
        if (n_in != 34 || out_size != RL * D || ws_size < WS_END) { fprintf(stderr, "kernel_launch: unexpected problem (n_in %d, out %d, ws %zu < %zu)\n", n_in, out_size, ws_size, (size_t)WS_END); grid = -1; return; }
        int dev = 0, cus = 0;
        if (hipGetDevice(&dev) != hipSuccess || hipDeviceGetAttribute(&cus, hipDeviceAttributeMultiprocessorCount, dev) != hipSuccess) { grid = -1; return; }
        if (hipFuncSetAttribute((const void*)mega, hipFuncAttributeMaxDynamicSharedMemorySize, LDS_BYTES) != hipSuccess) { fprintf(stderr, "kernel_launch: hipFuncSetAttribute failed\n"); grid = -1; return; }
        int per_cu = 0;
        (void)hipOccupancyMaxActiveBlocksPerMultiprocessor(&per_cu, (const void*)mega, 512, LDS_BYTES);
        (void)hipGetLastError();
        grid = cus;
    }
    if (grid < 0) return;
    (void)hipMemsetAsync((char*)d_ws + WS_CTL, 0, CTL_ZERO_BYTES, stream);
    Args a{};
    for (int i = 0; i < 34; ++i) a.in[i] = (const float*)d_in[i];
    a.out = (float*)d_out; a.ws = (unsigned char*)d_ws;
    const int NPH = total_phases();
#if ONE_LAUNCH
    a.ph_lo = 0; a.ph_hi = NPH;
    hipLaunchKernelGGL(mega, dim3(grid), dim3(512), LDS_BYTES, stream, a);
#else
    for (int p = 0; p < NPH; ++p) { a.ph_lo = p; a.ph_hi = p + 1; hipLaunchKernelGGL(mega, dim3(grid), dim3(512), LDS_BYTES, stream, a); }
#endif
}
```

```cpp
#include <hip/hip_runtime.h>
#include <cstdio>
#include <cstdint>

#ifndef ONE_LAUNCH
#define ONE_LAUNCH 1
#endif

#define LAS __attribute__((address_space(3)))
#define GAS __attribute__((address_space(1)))
typedef _Float16 f16;
typedef _Float16 f16x8 __attribute__((ext_vector_type(8)));
typedef _Float16 f16x4 __attribute__((ext_vector_type(4)));
typedef _Float16 f16x2 __attribute__((ext_vector_type(2)));
typedef short v4i16 __attribute__((ext_vector_type(4)));
typedef float f32x4 __attribute__((ext_vector_type(4)));
typedef float f32x2 __attribute__((ext_vector_type(2)));
typedef unsigned u32x4 __attribute__((ext_vector_type(4)));
typedef unsigned u32x2 __attribute__((ext_vector_type(2)));
typedef int v4i32 __attribute__((ext_vector_type(4)));
typedef int v8i32 __attribute__((ext_vector_type(8)));

constexpr int D = 1024, NB = 4, T = 8192, NCX = 256, DEPTH = 4;
constexpr int RL = NB * T, RC = NB * NCX, R = RL + RC;
constexpr int NE = 16, CAPL = 1024, CAPC = 32, FF = 2048, EROWS = 4352, ETILES = 17;
constexpr float NORM_EPS = 1e-6f;
constexpr float LOG2E = 1.4426950408889634f;
constexpr float QSCALE = 0.125f * LOG2E;
constexpr float ZSCALE = 1.0f / 64.0f, ZUNSCALE = 64.0f;

constexpr size_t MiB = 1u << 20;
constexpr size_t WS_CTL = 0, CTL_ZERO_BYTES = 64 * 1024;
constexpr size_t WS_MOD = 1 * MiB;
constexpr size_t WS_ROPE = WS_MOD + 512 * 1024;
constexpr size_t WS_H2L = 2 * MiB;
constexpr size_t WS_H2C = 4 * MiB;
constexpr size_t WS_HC = 5 * MiB;
constexpr size_t WS_AFFL = 9 * MiB;
constexpr size_t WS_AFFC = 11 * MiB;
constexpr size_t WS_INV = 12 * MiB;
constexpr size_t WS_ROWIDX = 14 * MiB;
constexpr size_t WS_WA_IN = 16 * MiB;
constexpr size_t WS_WA_OUT = 22 * MiB;
constexpr size_t WS_WB_IN = 26 * MiB;
constexpr size_t WS_WB_OUT = 32 * MiB;
constexpr size_t WS_WC_IN = 34 * MiB;
constexpr size_t WS_WC_OUT = 40 * MiB;
constexpr size_t WS_WEGU = 42 * MiB;
constexpr size_t WS_WED = 170 * MiB;
constexpr size_t WS_U = 234 * MiB;
constexpr size_t WS_P = 300 * MiB;
constexpr size_t WS_O = 498 * MiB;
constexpr size_t WS_ZT = 564 * MiB;
constexpr size_t WS_ATT = 630 * MiB;
constexpr size_t WS_BIG = 830 * MiB;
constexpr size_t WS_H2A = 1102 * MiB;
constexpr size_t WS_W3T = 1107 * MiB;
constexpr size_t WS_FTC = 1110 * MiB;
constexpr size_t WS_WEGU2 = 1114 * MiB;
constexpr size_t WS_WED2 = 1242 * MiB;
constexpr size_t WS_HH = 1306 * MiB;
constexpr size_t WS_END = 1372 * MiB;
constexpr size_t WS_FTL = WS_O;

constexpr int LDS_BYTES = 147456;
constexpr int MISC_OFF = 143360;

__device__ __forceinline__ unsigned pkh(float a, float b) { f16x2 v = {(f16)a, (f16)b}; return __builtin_bit_cast(unsigned, v); }
__device__ __forceinline__ f32x2 h2f_(unsigned v) { const f16x2 h = __builtin_bit_cast(f16x2, v); return (f32x2){(float)h[0], (float)h[1]}; }
template <int M> __device__ __forceinline__ float swz_xor(float v) { return __builtin_bit_cast(float, __builtin_amdgcn_ds_swizzle(__builtin_bit_cast(int, v), 0x1f | (M << 10))); }
__device__ __forceinline__ void swap32(float v, float& a, float& b) { a = v; b = v; asm volatile("v_nop\n\tv_nop\n\tv_permlane32_swap_b32 %0, %1" : "+v"(a), "+v"(b)); }
__device__ __forceinline__ float sum_xor32(float v) { float a, b; swap32(v, a, b); return a + b; }
__device__ __forceinline__ float max_xor32(float v) { float a, b; swap32(v, a, b); return fmaxf(a, b); }
__device__ __forceinline__ float wave_sum(float v) {
    v += swz_xor<1>(v); v += swz_xor<2>(v); v += swz_xor<4>(v); v += swz_xor<8>(v); v += swz_xor<16>(v);
    return sum_xor32(v);
}
__device__ __forceinline__ void unpack8(const u32x4 w, float (&f)[8]) {
    const f16x8 h = __builtin_bit_cast(f16x8, w);
#pragma unroll
    for (int i = 0; i < 8; ++i) f[i] = (float)h[i];
}

constexpr float YE_SCALE = 16.0f;
constexpr float W8_SCALE = 64.0f; constexpr int W8_SCALE_E8M0 = 127 - 6, A8_SCALE_E8M0 = 127;
__device__ __forceinline__ float clamp8(float x) { return fminf(fmaxf(x, -448.0f), 448.0f); }
__device__ __forceinline__ unsigned pk8nc(float a, float b, float c, float d) { int w = 0; w = __builtin_amdgcn_cvt_pk_fp8_f32(a, b, w, false); w = __builtin_amdgcn_cvt_pk_fp8_f32(c, d, w, true); return (unsigned)w; }
__device__ __forceinline__ unsigned pk8(float a, float b, float c, float d) { int w = 0; w = __builtin_amdgcn_cvt_pk_fp8_f32(clamp8(a), clamp8(b), w, false); w = __builtin_amdgcn_cvt_pk_fp8_f32(clamp8(c), clamp8(d), w, true); return (unsigned)w; }
#define XB_TMO      128
#define XB_XCNT(j)  (256  + 64 * (j))
#define XB_XSUB(j)  (1280 + 64 * (j))
#define XB_XGEN(j)  (2304 + 64 * (j))
#define XB_TOP      3328
#define XB_TOPGEN   3392
#define XCD_BAR_WORDS 3456
#define XB_SPIN_CAP (1u << 18)
__device__ __forceinline__ unsigned xb_ld(unsigned* p)              { return __hip_atomic_load(p, __ATOMIC_RELAXED, __HIP_MEMORY_SCOPE_AGENT); }
__device__ __forceinline__ unsigned xb_add(unsigned* p, unsigned v) { return __hip_atomic_fetch_add(p, v, __ATOMIC_RELAXED, __HIP_MEMORY_SCOPE_AGENT); }
__device__ __forceinline__ unsigned xb_xcc_id() { return (unsigned)__builtin_amdgcn_s_getreg((3 << 11) | 20) & 0xFu; }
#define XB_SPIN(cond, bar) do { unsigned _sp = 0; while (cond) { __builtin_amdgcn_s_sleep(1); \
    if ((++_sp & 255u) == 0u) { if (xb_ld(&(bar)[XB_TMO])) break; if (_sp > XB_SPIN_CAP) { atomicAdd(&(bar)[XB_TMO], 1u); break; } } } } while (0)
struct XcdBarrier { unsigned* bar; unsigned x; volatile LAS unsigned* st; };
__device__ __forceinline__ XcdBarrier xcd_barrier_post(unsigned* bar, volatile LAS unsigned* st) {
    XcdBarrier b; b.bar = bar; b.x = xb_xcc_id(); b.st = st;
    if (threadIdx.x == 0) (void)xb_add(&bar[XB_XCNT(b.x)], 1u);
    return b;
}
__device__ __forceinline__ void xcd_barrier_complete(unsigned* bar, unsigned x, unsigned& nloc, unsigned& nx) {
    const unsigned G = gridDim.x * gridDim.y * gridDim.z;
    unsigned sum, cnt, mine, sp = 0u;
    for (;;) {
        sum = 0u; cnt = 0u; mine = 0u;
#pragma unroll
        for (unsigned j = 0; j < 16; ++j) { const unsigned c = xb_ld(&bar[XB_XCNT(j)]); sum += c; cnt += (c > 0u) ? 1u : 0u; mine = (j == x) ? c : mine; }
        if (sum == G) break;
        __builtin_amdgcn_s_sleep(1);
        if ((++sp & 255u) == 0u) { if (xb_ld(&bar[XB_TMO])) break; if (sp > XB_SPIN_CAP) { atomicAdd(&bar[XB_TMO], 1u); break; } }
    }
    nloc = mine > 0u ? mine : 1u; nx = cnt > 0u ? cnt : 1u;
}
__device__ __forceinline__ void xcd_barrier(const XcdBarrier& b) {
    asm volatile("s_waitcnt vmcnt(0)" ::: "memory");
    __syncthreads();
    if (threadIdx.x == 0) {
        unsigned* bar = b.bar;
        __builtin_amdgcn_s_waitcnt(0);
        unsigned nloc = b.st[0], nx = b.st[1];
        if (nloc == 0u) { xcd_barrier_complete(bar, b.x, nloc, nx); b.st[0] = nloc; b.st[1] = nx; }
        const unsigned old = xb_add(&bar[XB_XSUB(b.x)], 1u);
        const unsigned gen = old / nloc;
        if (old + 1u == (gen + 1u) * nloc) {
            __builtin_amdgcn_fence(__ATOMIC_RELEASE, "agent");
            asm volatile("s_waitcnt vmcnt(0)" ::: "memory");
            const unsigned og = xb_add(&bar[XB_TOP], 1u);
            const unsigned tg = og / nx;
            if (og + 1u == (tg + 1u) * nx) xb_add(&bar[XB_TOPGEN], 1u);
            else XB_SPIN(xb_ld(&bar[XB_TOPGEN]) == tg, bar);
            __builtin_amdgcn_fence(__ATOMIC_ACQUIRE, "agent");
            xb_add(&bar[XB_XGEN(b.x)], 1u);
            asm volatile("s_waitcnt vmcnt(0)" ::: "memory");
        } else {
            XB_SPIN(xb_ld(&bar[XB_XGEN(b.x)]) == gen, bar);
            __builtin_amdgcn_fence(__ATOMIC_ACQUIRE, "agent");
            asm volatile("s_waitcnt vmcnt(0)" ::: "memory");
        }
    }
    __syncthreads();
}

namespace pg8 {
constexpr int BM = 256, BK = 64, HALF = 128, HTB = HALF * BK * 2, STAGE_BYTES = 8 * HTB, NXCD = 8, WGM = 8;
__host__ __device__ __forceinline__ int lds_byte(int r, int c) { const int st = (r >> 4) * 2 + (c >> 5), rr = r & 15, cc = c & 31, ob = rr * 64 + cc * 2; return st * 1024 + (ob ^ (((ob >> 9) & 1) << 5)); }
__host__ __device__ __forceinline__ void stage_rc(int b, int& Rr, int& C) { const int st = b / 1024, sb = b % 1024, swz = sb ^ (((sb >> 9) & 1) << 5); Rr = (st >> 1) * 16 + swz / 64; C = (st & 1) * 32 + (swz % 64) / 2; }
__host__ __device__ __forceinline__ int perm32(int rho) { const int n = rho >> 4, i = rho & 15; return 8 * (i >> 2) + 4 * n + (i & 3); }

struct Unit { int pm, pn, pb; };
struct Gemm { const f16* A; const f16* Bt; int K; const int* ridx; };

struct StaticOrder {
    int nM, nN, nwg, G, c;
    __device__ void init(int M, int N, int G_, int c_) { nM = M / BM; nN = N / BM; nwg = nM * nN; G = G_; c = c_; }
    __device__ bool next(int i, Unit& u) const {
        const long L = (long)i * G + c; if (L >= nwg) return false;
        int wgid = (int)L; { const int q = nwg / NXCD, r = nwg % NXCD, xcd = wgid % NXCD, off = wgid / NXCD; wgid = (xcd < r ? xcd * (q + 1) : r * (q + 1) + (xcd - r) * q) + off; }
        const int nig = WGM * nN, gid = wgid / nig, fm = gid * WGM, gsz = (nM - fm) < WGM ? (nM - fm) : WGM;
        u.pm = fm + ((wgid % nig) % gsz); u.pn = (wgid % nig) / gsz; u.pb = u.pn; return true;
    }
};
struct GroupedOrder {
    int nMe, nN, G, c;
    __device__ void init(int nMe_, int nN_, int G_, int c_) { nMe = nMe_; nN = nN_; G = G_; c = c_; }
    __device__ bool next(int i, Unit& u) const {
        const int per = nMe * nN; int e, r;
        if ((G & 7) == 0) { const int x = c & 7, j = c >> 3, w = i * (G >> 3) + j; if (w >= 2 * per) return false; e = 2 * x + w / per; r = w % per; }
        else { const long L = (long)i * G + c; if (L >= (long)NE * per) return false; e = (int)(L / per); r = (int)(L % per); }
        const int nig = WGM * nN, gid = r / nig, fm = gid * WGM, gsz = (nMe - fm) < WGM ? (nMe - fm) : WGM;
        u.pm = e * ETILES + fm + ((r % nig) % gsz); u.pn = (r % nig) / gsz; u.pb = e * nN + u.pn; return true;
    }
};

struct EpiStoreF16 {
    static constexpr bool PERM = true, SWAP = false; static constexpr int BPERM = 0;
    f16* O; int ldc;
    __device__ __forceinline__ void operator()(const f32x4 (&acc)[2][2][4][2], const Unit& u, int wr, int wc, int fr_, int fq_) const {
        int fr = fr_, fq = fq_; asm volatile("" : "+v"(fr), "+v"(fq));
        const int row0 = u.pm * BM + wr * 64 + fr, col0 = u.pn * BM + wc * 32 + 8 * fq;
#pragma unroll
        for (int ai = 0; ai < 2; ++ai)
#pragma unroll
            for (int m = 0; m < 4; ++m) { f16* rowp = O + (size_t)(row0 + ai * HALF + m * 16) * ldc + col0;
#pragma unroll
                for (int bj = 0; bj < 2; ++bj) { const f32x4 v0 = acc[ai][bj][m][0], v1 = acc[ai][bj][m][1];
                    u32x4 w; w.x = pkh(v0[0], v0[1]); w.y = pkh(v0[2], v0[3]); w.z = pkh(v1[0], v1[1]); w.w = pkh(v1[2], v1[3]);
                    *(u32x4*)(rowp + bj * HALF) = w; } }
    }
};
struct EpiStoreF8 {
    static constexpr bool PERM = true, SWAP = false; static constexpr int BPERM = 0;
    unsigned char* O; int ldc; float sc;
    __device__ __forceinline__ void operator()(const f32x4 (&acc)[2][2][4][2], const Unit& u, int wr, int wc, int fr_, int fq_) const {
        int fr = fr_, fq = fq_; asm volatile("" : "+v"(fr), "+v"(fq));
        const int row0 = u.pm * BM + wr * 64 + fr, col0 = u.pn * BM + wc * 32 + 8 * fq;
#pragma unroll
        for (int ai = 0; ai < 2; ++ai)
#pragma unroll
            for (int m = 0; m < 4; ++m) { unsigned char* rowp = O + (size_t)(row0 + ai * HALF + m * 16) * ldc + col0;
#pragma unroll
                for (int bj = 0; bj < 2; ++bj) { const f32x4 v0 = acc[ai][bj][m][0] * sc, v1 = acc[ai][bj][m][1] * sc;
                    u32x2 w; w.x = pk8(v0[0], v0[1], v0[2], v0[3]); w.y = pk8(v1[0], v1[1], v1[2], v1[3]);
                    *(u32x2*)(rowp + bj * HALF) = w; } }
    }
};
__device__ __forceinline__ float silu_mul(float g, float u) { return g * __builtin_amdgcn_rcpf(1.0f + __builtin_amdgcn_exp2f(-g * LOG2E)) * u; }
struct EpiSwiGLU {
    static constexpr bool PERM = true, SWAP = false; static constexpr int BPERM = 0;
    unsigned char* O;
    __device__ __forceinline__ void operator()(const f32x4 (&acc)[2][2][4][2], const Unit& u, int wr, int wc, int fr_, int fq_) const {
        int fr = fr_, fq = fq_; asm volatile("" : "+v"(fr), "+v"(fq));
        const int row0 = u.pm * BM + wr * 64 + fr, col0 = u.pn * HALF + wc * 32 + 8 * fq;
#pragma unroll
        for (int ai = 0; ai < 2; ++ai)
#pragma unroll
            for (int m = 0; m < 4; ++m) { unsigned char* rowp = O + (size_t)(row0 + ai * HALF + m * 16) * FF + col0;
                const f32x4 g0 = acc[ai][0][m][0], g1 = acc[ai][0][m][1], u0 = acc[ai][1][m][0], u1 = acc[ai][1][m][1];
                u32x2 w; w.x = pk8(silu_mul(g0[0], u0[0]), silu_mul(g0[1], u0[1]), silu_mul(g0[2], u0[2]), silu_mul(g0[3], u0[3]));
                w.y = pk8(silu_mul(g1[0], u1[0]), silu_mul(g1[1], u1[1]), silu_mul(g1[2], u1[2]), silu_mul(g1[3], u1[3]));
                *(u32x2*)rowp = w; }
    }
};
struct EpiResidual {
    static constexpr bool PERM = false, SWAP = false; static constexpr int BPERM = 0;
    const float* x_l; const float* x_c; f16* HH; bool first; const float* gate; float scale;
    __device__ __forceinline__ void operator()(const f32x4 (&acc)[2][2][4][2], const Unit& u, int wr, int wc, int fr, int fq) const {
        const bool isc = u.pm >= 128; const int bb = isc ? 4 : (u.pm >> 5);
        const float* hin = isc ? x_c + (size_t)(u.pm - 128) * BM * D : x_l + (size_t)u.pm * BM * D;
        f16* hh = HH + (size_t)u.pm * BM * D;
        const int row0 = wr * 64 + fr, col0 = u.pn * BM + wc * 32 + 4 * fq;
        f32x4 gv[2][2];
#pragma unroll
        for (int bj = 0; bj < 2; ++bj)
#pragma unroll
            for (int n = 0; n < 2; ++n) gv[bj][n] = *(const f32x4*)(gate + bb * 6144 + col0 + bj * HALF + n * 16) * scale;
#pragma unroll
        for (int ai = 0; ai < 2; ++ai)
#pragma unroll
            for (int m = 0; m < 4; ++m) { const size_t off = (size_t)(row0 + ai * HALF + m * 16) * D + col0;
#pragma unroll
                for (int bj = 0; bj < 2; ++bj)
#pragma unroll
                    for (int n = 0; n < 2; ++n) { f32x4 hv;
                        if (first) hv = *(const f32x4*)(hin + off + bj * HALF + n * 16);
                        else { const f16x4 t = *(const f16x4*)(hh + off + bj * HALF + n * 16); hv = (f32x4){(float)t[0], (float)t[1], (float)t[2], (float)t[3]}; }
                        const f32x4 o = hv + gv[bj][n] * acc[ai][bj][m][n]; u32x2 w; w.x = pkh(o.x, o.y); w.y = pkh(o.z, o.w);
                        *(u32x2*)(hh + off + bj * HALF + n * 16) = w; } }
    }
};
struct EpiTransposeF16 {
    static constexpr bool PERM = false, SWAP = true; static constexpr int BPERM = 0;
    f16* PT; f16* PTC;
    __device__ __forceinline__ void operator()(const f32x4 (&acc)[2][2][4][2], const Unit& u, int wr, int wc, int fr, int fq) const {
        const bool isc = u.pm >= 128;
        const int b = isc ? (u.pm - 128) : (u.pm >> 5); const int t0 = isc ? 0 : (u.pm & 31) * BM; const int len = isc ? NCX : T;
        f16* base = (isc ? PTC : PT) + (size_t)b * 3072 * len;
        const int col0 = u.pn * BM + wc * 32 + fr, tt0 = t0 + wr * 64 + 4 * fq;
#pragma unroll
        for (int bj = 0; bj < 2; ++bj)
#pragma unroll
            for (int n = 0; n < 2; ++n) { f16* cp = base + (size_t)(col0 + bj * HALF + n * 16) * len + tt0;
#pragma unroll
                for (int ai = 0; ai < 2; ++ai)
#pragma unroll
                    for (int m = 0; m < 4; ++m) { const f32x4 v = acc[ai][bj][m][n]; u32x2 w; w.x = pkh(v[0], v[1]); w.y = pkh(v[2], v[3]); *(u32x2*)(cp + ai * HALF + m * 16) = w; } }
    }
};

struct EpiFilterT {
    static constexpr bool PERM = false, SWAP = true; static constexpr int BPERM = 0;
    f16* FTL; float* FTC;
    __device__ __forceinline__ void operator()(const f32x4 (&acc)[2][2][4][2], const Unit& u, int wr, int wc, int fr, int fq) const {
        const bool isc = u.pm >= 32;
        const int col0 = u.pn * BM + wc * 32 + fr, tt0 = (isc ? 0 : u.pm * BM) + wr * 64 + 4 * fq;
#pragma unroll
        for (int bj = 0; bj < 2; ++bj)
#pragma unroll
            for (int n = 0; n < 2; ++n) {
                if (isc) { float* cp = FTC + (size_t)(col0 + bj * HALF + n * 16) * NCX + tt0;
#pragma unroll
                    for (int ai = 0; ai < 2; ++ai)
#pragma unroll
                        for (int m = 0; m < 4; ++m) *(f32x4*)(cp + ai * HALF + m * 16) = acc[ai][bj][m][n]; }
                else { f16* cp = FTL + (size_t)(col0 + bj * HALF + n * 16) * T + tt0;
#pragma unroll
                    for (int ai = 0; ai < 2; ++ai)
#pragma unroll
                        for (int m = 0; m < 4; ++m) { const f32x4 v = acc[ai][bj][m][n]; u32x2 w; w.x = pkh(v[0], v[1]); w.y = pkh(v[2], v[3]); *(u32x2*)(cp + ai * HALF + m * 16) = w; } } }
    }
};
template <class Epi, class Sched, bool GATHER = false, bool FP8 = false>
__device__ __forceinline__ void gemm_phase(LAS unsigned char* lds, const int tid, const Gemm g, const Sched& S, const Epi& E) {
    const int wid = __builtin_amdgcn_readfirstlane(tid >> 6), lane = tid & 63, wr = wid >> 2, wc = wid & 3, fr = lane & 15, fq = lane >> 4;
    const int K = g.K, nt = K / BK;
    unsigned voffA[2], voffB[2]; int rowA[2]; unsigned colA[2];
#pragma unroll
    for (int i = 0; i < 2; ++i) { int Rr, C; stage_rc(tid * 16 + i * 8192, Rr, C); const int Rb = Epi::PERM ? ((Rr & ~31) + perm32(Rr & 31)) : Rr;
        voffA[i] = (unsigned)(Rr * K + C) * 2u; voffB[i] = (unsigned)(Rb * K + C) * 2u; rowA[i] = Rr; colA[i] = (unsigned)C * 2u; }
    unsigned voffB2[2][2];
#pragma unroll
    for (int h_ = 0; h_ < 2; ++h_)
#pragma unroll
        for (int i_ = 0; i_ < 2; ++i_) voffB2[h_][i_] = (unsigned)((64 * (rowA[i_] >> 5) + 32 * h_ + (rowA[i_] & 31)) * K) * 2u + colA[i_];
#define PG8_STAGE_B(bufoff, bbase, h) do { if constexpr (Epi::BPERM == 2) PG8_STAGE(bufoff, bbase, voffB2[h]); else PG8_STAGE(bufoff, (bbase) + (h) * hstep, voffB); } while (0)
    unsigned gcur[2][2], gnxt[2][2];
#define PG8_LOADG(dst, u) do { _Pragma("unroll") for (int h_ = 0; h_ < 2; ++h_) _Pragma("unroll") for (int i_ = 0; i_ < 2; ++i_) \
        dst[h_][i_] = (unsigned)g.ridx[(u).pm * BM + h_ * HALF + rowA[i_]] * (unsigned)(K * 2) + colA[i_]; } while (0)
#define PG8_STAGE_A(bufoff, kb, h, nx) do { if constexpr (GATHER) { unsigned o_[2]; o_[0] = (nx) ? gnxt[h][0] : gcur[h][0]; o_[1] = (nx) ? gnxt[h][1] : gcur[h][1]; PG8_STAGE(bufoff, (const char*)g.A + (kb), o_); } \
        else PG8_STAGE(bufoff, ((nx) ? nA : cA) + (kb) + (h) * hstep, voffA); } while (0)
    const size_t kstep = (size_t)(BK * 2);
    const size_t hstep = (size_t)HALF * K * 2;
    const size_t tstep = 2 * hstep;
    const unsigned ldsw = (unsigned)wid * 1024u;
    const int aoff = lds_byte(wr * 64 + fr, fq * 8), boff = lds_byte(wc * 32 + fr, fq * 8);
#define PG8_SA(b, h) (((b) * 2 + (h)) * HTB)
#define PG8_SB(b, h) ((4 + (b) * 2 + (h)) * HTB)
#define PG8_STAGE(bufoff, gbase, voff) do { _Pragma("unroll") for (int _i = 0; _i < 2; ++_i) \
        __builtin_amdgcn_global_load_lds((const unsigned*)((const char*)(gbase) + (voff)[_i]), (LAS unsigned*)(lds + (bufoff) + ldsw + _i * 8192), 16, 0, 0); } while (0)
#define PG8_LDA(dst, b, h) do { _Pragma("unroll") for (int m = 0; m < 4; ++m) _Pragma("unroll") for (int k = 0; k < 2; ++k) dst[m][k] = *(const LAS f16x8*)(lds + PG8_SA(b, h) + aoff + m * 2048 + k * 1024); } while (0)
#define PG8_LDB(dst, b, h) do { _Pragma("unroll") for (int n = 0; n < 2; ++n) _Pragma("unroll") for (int k = 0; k < 2; ++k) dst[n][k] = *(const LAS f16x8*)(lds + PG8_SB(b, h) + boff + n * 2048 + k * 1024); } while (0)
#define PG8_CAT(x0, x1) __builtin_shufflevector(__builtin_bit_cast(v4i32, x0), __builtin_bit_cast(v4i32, x1), 0, 1, 2, 3, 4, 5, 6, 7)
#define PG8_MMA(ai, bj, At, Bt) do { __builtin_amdgcn_s_setprio(1); \
        if constexpr (FP8) { _Pragma("unroll") for (int m = 0; m < 4; ++m) _Pragma("unroll") for (int n = 0; n < 2; ++n) \
            { const v8i32 b8_ = PG8_CAT(Bt[n][0], Bt[n][1]), a8_ = PG8_CAT(At[m][0], At[m][1]); \
              asm("v_mfma_scale_f32_16x16x128_f8f6f4 %0, %1, %2, %0, %3, %4 op_sel_hi:[0,0,0]" : "+v"(acc[ai][bj][m][n]) : "v"(b8_), "v"(a8_), "v"(sc8w), "v"(sc8a)); } } \
        else { _Pragma("unroll") for (int m = 0; m < 4; ++m) _Pragma("unroll") for (int n = 0; n < 2; ++n) _Pragma("unroll") for (int k = 0; k < 2; ++k) \
        acc[ai][bj][m][n] = Epi::SWAP ? __builtin_amdgcn_mfma_f32_16x16x32_f16(At[m][k], Bt[n][k], acc[ai][bj][m][n], 0, 0, 0) \
                                      : __builtin_amdgcn_mfma_f32_16x16x32_f16(Bt[n][k], At[m][k], acc[ai][bj][m][n], 0, 0, 0); } __builtin_amdgcn_s_setprio(0); } while (0)
#define PG8_WAIT_V(n) asm volatile("s_waitcnt vmcnt(" #n ")" ::: "memory")
#define PG8_WAIT_L(n) asm volatile("s_waitcnt lgkmcnt(" #n ")" ::: "memory")
#define PG8_BAR __builtin_amdgcn_s_barrier()
#define PG8_SCHED __builtin_amdgcn_sched_barrier(0)
    Unit cur, nxt; int ui = 0;
    if (!S.next(0, cur)) return;
    const int sc8w = W8_SCALE_E8M0, sc8a = A8_SCALE_E8M0;
    f32x4 acc[2][2][4][2];
#pragma unroll
    for (int a = 0; a < 2; ++a)
#pragma unroll
        for (int b = 0; b < 2; ++b)
#pragma unroll
            for (int m = 0; m < 4; ++m)
#pragma unroll
                for (int n = 0; n < 2; ++n) acc[a][b][m][n] = (f32x4){0.f, 0.f, 0.f, 0.f};
    f16x8 At[4][2], B0[2][2], B1[2][2];
    const char* cA = (const char*)g.A + (size_t)cur.pm * tstep; const char* cB = (const char*)g.Bt + (size_t)cur.pb * tstep; const char* nA = cA;
    if constexpr (GATHER) { PG8_LOADG(gcur, cur); PG8_LOADG(gnxt, cur); }
    PG8_STAGE_B(PG8_SB(0, 0), cB, 0); PG8_STAGE_B(PG8_SB(0, 1), cB, 1); PG8_STAGE_A(PG8_SA(0, 0), 0, 0, false); PG8_STAGE_A(PG8_SA(0, 1), 0, 1, false);
    if (wr == 1) PG8_BAR;
    PG8_WAIT_V(2); PG8_BAR;
    PG8_STAGE_B(PG8_SB(1, 0), cB + kstep, 0); PG8_STAGE_A(PG8_SA(1, 0), kstep, 0, false); PG8_STAGE_B(PG8_SB(1, 1), cB + kstep, 1);
    PG8_WAIT_V(6); PG8_BAR;
    for (;;) {
        const bool has_next = S.next(ui + 1, nxt);
        nA = has_next ? (const char*)g.A + (size_t)nxt.pm * tstep : cA; const char* nB = has_next ? (const char*)g.Bt + (size_t)nxt.pb * tstep : cB;
        if constexpr (GATHER) { const Unit lu = has_next ? nxt : cur; PG8_LOADG(gnxt, lu); }
        for (int t = 0; t < nt; t += 2) {
            const bool last = (t == nt - 2);
            const size_t k1 = (size_t)(t + 1) * kstep, k2 = last ? 0 : (size_t)(t + 2) * kstep, k3 = k2 + kstep;
            const char* b2 = last ? nB : cB + (size_t)(t + 2) * kstep; const char* b3 = b2 + kstep;
            PG8_LDB(B0, 0, 0); PG8_LDB(B1, 0, 1); PG8_SCHED; PG8_LDA(At, 0, 0); PG8_STAGE_A(PG8_SA(1, 1), k1, 1, false);
            PG8_WAIT_V(8); PG8_WAIT_L(0); PG8_BAR; PG8_MMA(0, 0, At, B0); PG8_MMA(0, 1, At, B1); PG8_BAR; PG8_SCHED;
            PG8_LDA(At, 0, 1); PG8_STAGE_B(PG8_SB(0, 0), b2, 0); PG8_STAGE_B(PG8_SB(0, 1), b2, 1); PG8_STAGE_A(PG8_SA(0, 0), k2, 0, last);
            PG8_WAIT_V(8); PG8_WAIT_L(0); PG8_BAR; PG8_MMA(1, 0, At, B0); PG8_MMA(1, 1, At, B1); PG8_BAR; PG8_SCHED;
            PG8_LDB(B0, 1, 0); PG8_LDB(B1, 1, 1); PG8_SCHED; PG8_LDA(At, 1, 0); PG8_STAGE_A(PG8_SA(0, 1), k2, 1, last);
            PG8_WAIT_V(8); PG8_WAIT_L(0); PG8_BAR; PG8_MMA(0, 0, At, B0); PG8_MMA(0, 1, At, B1); PG8_BAR; PG8_SCHED;
            PG8_LDA(At, 1, 1); PG8_STAGE_B(PG8_SB(1, 0), b3, 0); PG8_STAGE_B(PG8_SB(1, 1), b3, 1); PG8_STAGE_A(PG8_SA(1, 0), k3, 0, last);
            PG8_WAIT_V(8); PG8_WAIT_L(0); PG8_BAR; PG8_MMA(1, 0, At, B0); PG8_MMA(1, 1, At, B1); PG8_BAR; PG8_SCHED;
        }
        if (wr == 0) PG8_BAR;
        if constexpr (FP8) asm volatile("s_nop 15\n\ts_nop 15" ::: "memory");
        E(acc, cur, wr, wc, fr, fq);
        if (!has_next) break;
#pragma unroll
        for (int a = 0; a < 2; ++a)
#pragma unroll
            for (int b = 0; b < 2; ++b)
#pragma unroll
                for (int m = 0; m < 4; ++m)
#pragma unroll
                    for (int n = 0; n < 2; ++n) acc[a][b][m][n] = (f32x4){0.f, 0.f, 0.f, 0.f};
        cur = nxt; cA = nA; cB = nB; ++ui;
        if constexpr (GATHER) {
#pragma unroll
            for (int h_ = 0; h_ < 2; ++h_)
#pragma unroll
                for (int i_ = 0; i_ < 2; ++i_) gcur[h_][i_] = gnxt[h_][i_]; }
        if (wr == 1) PG8_BAR;
    }
    PG8_WAIT_V(0);
    PG8_BAR;
#undef PG8_SA
#undef PG8_SB
#undef PG8_STAGE
#undef PG8_STAGE_A
#undef PG8_STAGE_B
#undef PG8_LOADG
#undef PG8_LDA
#undef PG8_LDB
#undef PG8_MMA
#undef PG8_CAT
#undef PG8_WAIT_V
#undef PG8_WAIT_L
#undef PG8_BAR
#undef PG8_SCHED
}
}

struct Args { const float* in[34]; float* out; unsigned char* ws; int ph_lo, ph_hi; };
struct Ctx {
    LAS unsigned char* lds; int tid, lane, wave, G, bid;
    const float* const* in; float* out; unsigned char* ws;
};
#define IN_X 0
#define IN_C 1
#define IN_CTX 2
#define IN_CCTX 3
#define IN_ADA_W 4
#define IN_ADA_B 5
#define IN_NMIX 6
#define IN_NFFN 7
#define IN_ROUTER 8
#define IN_WGATE 9
#define IN_WUP 10
#define IN_WDOWN 11
#define IN_A_WIN 12
#define IN_A_WOUT 13
#define IN_A_QG 14
#define IN_A_KG 15
#define IN_A_SINK 16
#define IN_B_WIN 17
#define IN_B_SW 18
#define IN_B_SB 19
#define IN_B_W1 20
#define IN_B_B1 21
#define IN_B_F1 22
#define IN_B_W2 23
#define IN_B_B2 24
#define IN_B_F2 25
#define IN_B_W3 26
#define IN_B_BIAS 27
#define IN_B_WOUT 28
#define IN_C_WIN 29
#define IN_C_WOUT 30
#define IN_C_QG 31
#define IN_C_KG 32
#define IN_C_RPB 33

__device__ __forceinline__ void transpose_item(const float* W, int K, int N, f16* WT, int k0, int n0, int dst_row0, LAS float* scr, int lane) {
    float v[64];
    const float* src = W + (size_t)k0 * N + n0 + lane;
#pragma unroll
    for (int kk = 0; kk < 64; ++kk) v[kk] = __builtin_nontemporal_load(src + (size_t)kk * N);
#pragma unroll
    for (int kk = 0; kk < 64; ++kk) scr[kk * 65 + lane] = v[kk];
    asm volatile("s_waitcnt lgkmcnt(0)" ::: "memory");
    const int c = lane & 7, ns = lane >> 3;
#pragma unroll
    for (int j = 0; j < 8; ++j) { const int n = ns + 8 * j; const LAS float* sp = scr + (8 * c) * 65 + n;
        u32x4 o; o.x = pkh(sp[0 * 65], sp[1 * 65]); o.y = pkh(sp[2 * 65], sp[3 * 65]); o.z = pkh(sp[4 * 65], sp[5 * 65]); o.w = pkh(sp[6 * 65], sp[7 * 65]);
        *(u32x4*)(WT + (size_t)(dst_row0 + n) * K + k0 + 8 * c) = o; }
    asm volatile("s_waitcnt lgkmcnt(0)" ::: "memory");
}
__device__ __forceinline__ void transpose_item8(const float* W, int K, int N, unsigned char* WT, int k0, int n0, int dst_row0, LAS float* scr, int lane) {
    f32x4 v[16];
    const float* src = W + (size_t)(k0 + (lane >> 4)) * N + n0 + 4 * (lane & 15);
#pragma unroll
    for (int pq = 0; pq < 16; ++pq) v[pq] = __builtin_nontemporal_load((const f32x4*)(src + (size_t)(4 * pq) * N));
#pragma unroll
    for (int pq = 0; pq < 16; ++pq) { LAS float* sp = scr + (4 * pq + (lane >> 4)) * 65 + 4 * (lane & 15); const f32x4 t = v[pq] * W8_SCALE; sp[0] = t[0]; sp[1] = t[1]; sp[2] = t[2]; sp[3] = t[3]; }
    asm volatile("s_waitcnt lgkmcnt(0)" ::: "memory");
    const int c = lane & 7, ns = lane >> 3;
#pragma unroll
    for (int j = 0; j < 8; ++j) { const int n = ns + 8 * j; const LAS float* sp = scr + (8 * c) * 65 + n;
        u32x2 o; o.x = pk8(sp[0 * 65], sp[1 * 65], sp[2 * 65], sp[3 * 65]); o.y = pk8(sp[4 * 65], sp[5 * 65], sp[6 * 65], sp[7 * 65]);
        *(u32x2*)(WT + (size_t)(dst_row0 + n) * K + k0 + 8 * c) = o; }
    asm volatile("s_waitcnt lgkmcnt(0)" ::: "memory");
}
__device__ __forceinline__ void transpose_matrix_items(const Ctx& C, const float* W, int K, int N, f16* WT, int& base, int gw, int NGW) {
    const int nblk = N / 64, nit = (K / 64) * nblk;
    LAS float* scr = (LAS float*)(C.lds + C.wave * 16640);
    int first = (gw - base % NGW + NGW) % NGW;
    for (int it = first; it < nit; it += NGW) { const int kb = it / nblk, nb = it % nblk; transpose_item(W, K, N, WT, 64 * kb, 64 * nb, 64 * nb, scr, C.lane); }
    base += nit;
}

__device__ __forceinline__ float silu_f(float x) { return x / (1.0f + expf(-x)); }

__device__ __forceinline__ void prologue_mod(const Ctx& C) {
    LAS float* sc = (LAS float*)C.lds;
    LAS float* red = (LAS float*)(C.lds + 32768);
    if (C.bid >= 96) return;
    for (int i = C.tid; i < 5 * 1024; i += 512) { const int bb = i >> 10, k = i & 1023; const float v = bb < 4 ? C.in[IN_C][bb * 1024 + k] : C.in[IN_CCTX][k]; sc[i] = silu_f(v); }
    __syncthreads();
    for (int u = C.bid; u < 96; u += C.G) {
        const int layer = u / 24, cg = u % 24; const float* W = C.in[IN_ADA_W] + (size_t)layer * 1024 * 6144 + cg * 256 + 4 * C.lane;
        f32x4 acc[5];
#pragma unroll
        for (int bb = 0; bb < 5; ++bb) acc[bb] = (f32x4){0.f, 0.f, 0.f, 0.f};
        const int kb = C.wave * 128;
#pragma unroll 4
        for (int k = 0; k < 128; ++k) { const f32x4 w = __builtin_nontemporal_load((const f32x4*)(W + (size_t)(kb + k) * 6144));
#pragma unroll
            for (int bb = 0; bb < 5; ++bb) acc[bb] += w * sc[bb * 1024 + kb + k]; }
#pragma unroll
        for (int bb = 0; bb < 5; ++bb) *(LAS f32x4*)(red + (C.wave * 5 + bb) * 256 + 4 * C.lane) = acc[bb];
        __syncthreads();
        for (int i = C.tid; i < 5 * 256; i += 512) { const int bb = i >> 8, cc = i & 255; float s = C.in[IN_ADA_B][layer * 6144 + cg * 256 + cc];
#pragma unroll
            for (int w = 0; w < 8; ++w) s += red[(w * 5 + bb) * 256 + cc];
            ((float*)(C.ws + WS_MOD))[(size_t)(layer * 5 + bb) * 6144 + cg * 256 + cc] = s; }
        __syncthreads();
    }
}
__device__ __forceinline__ void prologue_tables(const Ctx& C, int gw, int NGW) {
    float* rope = (float*)(C.ws + WS_ROPE);
    for (int i = gw * 64 + C.lane; i < 128 * 16; i += NGW * 64) { const int pos = i >> 4, f = i & 15;
        const float inv = 1.0f / powf(10000.0f, (float)(2 * f) / 32.0f); const float ang = (float)pos * inv;
        rope[i] = cosf(ang); rope[2048 + i] = sinf(ang); }
    LAS float* zb = (LAS float*)(C.lds + 133120 + C.wave * 512);
    const float* w1 = C.in[IN_B_W1]; const float* b1 = C.in[IN_B_B1]; const float* f1 = C.in[IN_B_F1];
    const float* w2 = C.in[IN_B_W2]; const float* b2 = C.in[IN_B_B2]; const float* f2 = C.in[IN_B_F2];
    f16* H2A = (f16*)(C.ws + WS_H2A);
    for (int p = gw; p < T + NCX; p += NGW) {
        const bool isc = p >= T; const int t = isc ? p - T : p; const int n = isc ? NCX : T;
        float z = 0.f;
        if (C.lane == 0) z = (float)t / (float)(n - 1);
        else if (C.lane < 33) { const int k = (C.lane - 1) & 15; const float f = 1e-4f + (float)k * ((15.0f - 1e-4f) / 15.0f); const float w = (6.283185307179586f * (float)t) / (float)n;
            z = C.lane < 17 ? cosf(f * w) : -sinf(f * w); }
        zb[C.lane] = z;
        asm volatile("s_waitcnt lgkmcnt(0)" ::: "memory");
        float a = b1[C.lane];
        for (int k = 0; k < 33; ++k) a += zb[k] * w1[k * 64 + C.lane];
        const float h1 = sinf(f1[C.lane] * a);
        zb[64 + C.lane] = h1;
        asm volatile("s_waitcnt lgkmcnt(0)" ::: "memory");
        float a2 = b2[C.lane];
        for (int k = 0; k < 64; ++k) a2 += zb[64 + k] * w2[k * 64 + C.lane];
        const float h2 = sinf(f2[C.lane] * a2);
        f16* dst = H2A + (size_t)p * 256;
        dst[C.lane] = (f16)h2;
        if (C.lane < 48) *(u32x2*)(dst + 64 + 4 * C.lane) = (u32x2){0u, 0u};
        asm volatile("s_waitcnt lgkmcnt(0)" ::: "memory");
    }
    { f16* W3T = (f16*)(C.ws + WS_W3T);
      for (int r = gw; r < 4096; r += NGW) { if (C.lane < 48) *(u32x2*)(W3T + (size_t)r * 256 + 64 + 4 * C.lane) = (u32x2){0u, 0u}; } }
}
__device__ __forceinline__ void phase_prologue(const Ctx& C) {
    prologue_mod(C);
    __syncthreads();
    const int gw = C.bid * 8 + C.wave, NGW = C.G * 8;
    int base = 0;
    for (int j = 0; j < 2; ++j) transpose_matrix_items(C, C.in[IN_A_WIN] + (size_t)j * 1024 * 1536, 1024, 1536, (f16*)(C.ws + WS_WA_IN) + (size_t)j * 1536 * 1024, base, gw, NGW);
    for (int j = 0; j < 2; ++j) transpose_matrix_items(C, C.in[IN_A_WOUT] + (size_t)j * 1024 * 1024, 1024, 1024, (f16*)(C.ws + WS_WA_OUT) + (size_t)j * 1024 * 1024, base, gw, NGW);
    transpose_matrix_items(C, C.in[IN_B_WIN], 1024, 3072, (f16*)(C.ws + WS_WB_IN), base, gw, NGW);
    transpose_matrix_items(C, C.in[IN_B_WOUT], 1024, 1024, (f16*)(C.ws + WS_WB_OUT), base, gw, NGW);
    transpose_matrix_items(C, C.in[IN_C_WIN], 1024, 3072, (f16*)(C.ws + WS_WC_IN), base, gw, NGW);
    transpose_matrix_items(C, C.in[IN_C_WOUT], 1024, 1024, (f16*)(C.ws + WS_WC_OUT), base, gw, NGW);
    { LAS float* scr = (LAS float*)(C.lds + C.wave * 16640);
      const int first = (gw - base % NGW + NGW) % NGW;
      for (int it = first; it < 64; it += NGW) transpose_item(C.in[IN_B_W3], 256, 4096, (f16*)(C.ws + WS_W3T), 0, 64 * it, 64 * it, scr, C.lane);
      base += 64; }
    prologue_tables(C, gw, NGW);
}

struct PnSel { const unsigned char* yp[4]; float g[4]; unsigned mask; int cnt; };
template <bool FIRST  > __device__ __forceinline__ void phase_pn_t(const Ctx& C, int layer) {
    const int lane = C.lane;
    const int nrows = layer == DEPTH ? RL : R;
    const float* MOD = (const float*)(C.ws + WS_MOD);
    f16* HH = (f16*)(C.ws + WS_HH);
    const unsigned char* YE = C.ws + WS_ATT;
    const unsigned short* INV = (const unsigned short*)(C.ws + WS_INV);
    const float* AFFL = (const float*)(C.ws + WS_AFFL); const float* AFFC = (const float*)(C.ws + WS_AFFC);
    f16* U = (f16*)(C.ws + WS_U);
    const bool comb = !FIRST;
    const int rpb = (nrows + C.G - 1) / C.G;
    const int rb0 = min(C.bid * rpb, nrows), rb1 = min(rb0 + rpb, nrows), cnt = rb1 - rb0;
    const int r0 = rb0 + (C.wave * cnt) / 8, r1 = rb0 + ((C.wave + 1) * cnt) / 8;
    if (r0 >= r1) return;
    const unsigned lo4 = 4u * (unsigned)lane;
#define PN_HIN(row) ((row) >= RL ? C.in[IN_CTX] + (size_t)((row) - RL) * D : C.in[IN_X] + (size_t)(row) * D)
#define PN_LOAD_INV(dst, row) { const u32x4 a_ = *(const u32x4*)(INV + (size_t)(row) * 16), b_ = *(const u32x4*)(INV + (size_t)(row) * 16 + 8); \
        dst[0] = a_.x; dst[1] = a_.y; dst[2] = a_.z; dst[3] = a_.w; dst[4] = b_.x; dst[5] = b_.y; dst[6] = b_.z; dst[7] = b_.w; }
#define PN_SELECT(sel, iwv, row) { unsigned iw_[8]; _Pragma("unroll") for (int i_ = 0; i_ < 8; ++i_) iw_[i_] = __builtin_amdgcn_readfirstlane(iwv[i_]); \
        unsigned m_ = 0; _Pragma("unroll") for (int e_ = 0; e_ < 16; ++e_) m_ |= (((iw_[e_ >> 1] >> ((e_ & 1) * 16)) & 0xffffu) != 0u ? 1u : 0u) << e_; \
        sel.mask = m_; sel.cnt = __builtin_popcount(m_); const bool isc_ = (row) >= RL; const int rc_ = (row) - RL; const int b_ = isc_ ? (rc_ >> 8) : ((row) >> 13); \
        _Pragma("unroll") for (int k_ = 0; k_ < 4; ++k_) { const bool has_ = m_ != 0u; const int e_ = has_ ? __builtin_ctz(m_) : 0; m_ &= m_ - 1u; \
            unsigned w_ = iw_[0]; _Pragma("unroll") for (int i_ = 1; i_ < 8; ++i_) w_ = ((e_ >> 1) == i_) ? iw_[i_] : w_; \
            const unsigned s_ = has_ ? ((w_ >> ((e_ & 1) * 16)) & 0xffffu) : 1u; \
            sel.yp[k_] = YE + ((size_t)e_ * EROWS + (s_ - 1u)) * D; \
            const float gv_ = isc_ ? AFFC[(size_t)(b_ * 16 + e_) * NCX + (rc_ & 255)] : AFFL[(size_t)(b_ * 16 + e_) * T + ((row) & 8191)]; sel.g[k_] = gv_;   } }
    LAS unsigned char* ybuf = C.lds + C.wave * 16384;
#define PN_DMA(sel, buf) { _Pragma("unroll") for (int k_ = 0; k_ < 4; ++k_) { if (k_ < sel.cnt) { \
            __builtin_amdgcn_global_load_lds((const unsigned*)(sel.yp[k_] + 16 * lane), (LAS unsigned*)(ybuf + (buf) * 8192 + k_ * 2048), 16, 0, 2  ); } } }
    unsigned iw1[8], iw2[8];
    f32x4 vc[4], vn[4];
    u32x2 hc[4], hn[4];
    PnSel sc, sn;
#pragma unroll
    for (int i = 0; i < 8; ++i) { iw1[i] = 0u; iw2[i] = 0u; }
    sc.mask = 0u; sn.mask = 0u; sc.cnt = 0; sn.cnt = 0;
#pragma unroll
    for (int k = 0; k < 4; ++k) { sc.yp[k] = YE; sc.g[k] = 0.f; sn.yp[k] = YE; sn.g[k] = 0.f; }
    if (comb) { unsigned iw0[8]; PN_LOAD_INV(iw0, r0); PN_SELECT(sn, iw0, r0);
        PN_DMA(sn, (r0 & 1));
        PN_LOAD_INV(iw2, min(r0 + 1, r1 - 1)); }
#pragma unroll
    for (int j = 0; j < 4; ++j) { vc[j] = (f32x4){0.f, 0.f, 0.f, 0.f}; vn[j] = vc[j]; hc[j] = (u32x2){0u, 0u}; hn[j] = hc[j]; }
    if (FIRST) { const float* hp = PN_HIN(r0);
#pragma unroll
      for (int j = 0; j < 4; ++j) vn[j] = __builtin_nontemporal_load((const f32x4*)(hp + lo4 + 256 * j)); }
    else {
#pragma unroll
      for (int j = 0; j < 4; ++j) hn[j] = *(const u32x2*)(HH + (size_t)r0 * D + lo4 + 256 * j); }
    int cur_bb = -1; f32x4 g2v[4], gnv[4], shv[4], scv[4];
#pragma unroll
    for (int j = 0; j < 4; ++j) { g2v[j] = (f32x4){0.f, 0.f, 0.f, 0.f}; gnv[j] = g2v[j]; shv[j] = g2v[j]; scv[j] = g2v[j]; }
    for (int row = r0; row < r1; ++row) {
        const bool more = row + 1 < r1;
        const bool isc = row >= RL; const int rc = row - RL; const int b = isc ? (rc >> 8) : (row >> 13); const int bb = isc ? 4 : b;
        if (bb != cur_bb) { cur_bb = bb;
#pragma unroll
            for (int j = 0; j < 4; ++j) { if (comb) g2v[j] = *(const f32x4*)(MOD + (size_t)((layer - 1) * 5 + bb) * 6144 + 5 * 1024 + lo4 + 256 * j) * (1.0f / YE_SCALE);
                if (layer < DEPTH) { gnv[j] = *(const f32x4*)(C.in[IN_NMIX] + layer * 1024 + lo4 + 256 * j); shv[j] = *(const f32x4*)(MOD + (size_t)(layer * 5 + bb) * 6144 + lo4 + 256 * j); scv[j] = *(const f32x4*)(MOD + (size_t)(layer * 5 + bb) * 6144 + 1024 + lo4 + 256 * j); } } }
        asm volatile("s_waitcnt vmcnt(0)" ::: "memory");
        {
#pragma unroll
            for (int j = 0; j < 4; ++j) { vc[j] = vn[j]; hc[j] = hn[j]; }
            if (comb) {
#pragma unroll
                for (int k = 0; k < 4; ++k) { sc.yp[k] = sn.yp[k]; sc.g[k] = sn.g[k]; }
                sc.mask = sn.mask; sc.cnt = sn.cnt;
#pragma unroll
                for (int i = 0; i < 8; ++i) iw1[i] = iw2[i];
            }
        }
        f32x4 v[4];
#pragma unroll
        for (int j = 0; j < 4; ++j) { if (FIRST) v[j] = vc[j]; else { const f16x4 t = __builtin_bit_cast(f16x4, hc[j]); v[j] = (f32x4){(float)t[0], (float)t[1], (float)t[2], (float)t[3]}; } }
        f32x4 acc[4];
#pragma unroll
        for (int j = 0; j < 4; ++j) acc[j] = (f32x4){0.f, 0.f, 0.f, 0.f};
        if (comb) {
#pragma unroll
            for (int k = 0; k < 4; ++k) { if (k < sc.cnt) {
#pragma unroll
                for (int j = 0; j < 4; ++j) { const int y = *(const LAS int*)(ybuf + (row & 1) * 8192 + k * 2048 + 4 * lane + 256 * j);
                    const f32x2 ya = __builtin_amdgcn_cvt_pk_f32_fp8(y, false), yb = __builtin_amdgcn_cvt_pk_f32_fp8(y, true); acc[j] += (f32x4){ya[0], ya[1], yb[0], yb[1]} * sc.g[k]; } } }
            unsigned rest = sc.mask; rest &= rest - 1u; rest &= rest - 1u; rest &= rest - 1u; rest &= rest - 1u;
            while (rest) { const int e = __builtin_ctz(rest); rest &= rest - 1u;
                const unsigned s = __builtin_amdgcn_readfirstlane((unsigned)INV[(size_t)row * 16 + e]);
                const float g = isc ? AFFC[(size_t)(b * 16 + e) * NCX + (rc & 255)] : AFFL[(size_t)(b * 16 + e) * T + (row & 8191)];
                const unsigned char* ye = YE + ((size_t)e * EROWS + (s - 1u)) * D + lo4;
#pragma unroll
                for (int j = 0; j < 4; ++j) { const int y = *(const int*)(ye + 256 * j); const f32x2 ya = __builtin_amdgcn_cvt_pk_f32_fp8(y, false), yb = __builtin_amdgcn_cvt_pk_f32_fp8(y, true); acc[j] += (f32x4){ya[0], ya[1], yb[0], yb[1]} * g; } }
            asm volatile("s_waitcnt lgkmcnt(0)" ::: "memory");
        }
        { const int rn = min(row + 1, r1 - 1);
            if (comb) { PN_SELECT(sn, iw1, rn);
                PN_LOAD_INV(iw2, min(row + 2, r1 - 1));
                if (more) PN_DMA(sn, (rn & 1)); }
            if (FIRST) { const float* hp = PN_HIN(rn);
#pragma unroll
                for (int j = 0; j < 4; ++j) vn[j] = __builtin_nontemporal_load((const f32x4*)(hp + lo4 + 256 * j)); }
            else {
#pragma unroll
                for (int j = 0; j < 4; ++j) hn[j] = *(const u32x2*)(HH + (size_t)rn * D + lo4 + 256 * j); }
        }
        if (comb) {
#pragma unroll
            for (int j = 0; j < 4; ++j) { v[j] += g2v[j] * acc[j];
                if (layer == DEPTH) *(f32x4*)(C.out + (size_t)row * D + lo4 + 256 * j) = v[j];
                else { u32x2 w; w.x = pkh(v[j].x, v[j].y); w.y = pkh(v[j].z, v[j].w); *(u32x2*)(HH + (size_t)row * D + lo4 + 256 * j) = w; } }
        }
        if (layer < DEPTH) {
            float ss = 0.f;
#pragma unroll
            for (int j = 0; j < 4; ++j) ss += (v[j].x * v[j].x + v[j].y * v[j].y) + (v[j].z * v[j].z + v[j].w * v[j].w);
            const float rstd = 1.0f / sqrtf(wave_sum(ss) * (1.0f / D) + NORM_EPS);
#pragma unroll
            for (int j = 0; j < 4; ++j) { const f32x4 u = (v[j] * rstd) * gnv[j] * (scv[j] + 1.0f) + shv[j]; u32x2 w; w.x = pkh(u.x, u.y); w.y = pkh(u.z, u.w);
                *(u32x2*)(U + (size_t)row * D + lo4 + 256 * j) = w; }
        }
    }
#undef PN_HIN
#undef PN_LOAD_INV
#undef PN_SELECT
#undef PN_DMA
}
__device__ __forceinline__ void phase_pn(const Ctx& C, int layer) { if (layer == 0) phase_pn_t<true>(C, 0); else phase_pn_t<false>(C, layer); }
__device__ __forceinline__ void phase_pf(const Ctx& C, int layer) {
    int lane = C.lane, wave = C.wave; asm volatile("" : "+v"(lane));
    const int nrows = layer == DEPTH - 1 ? RL : R;
    const int ngroups = nrows >> 4;
    const int g0 = (int)(((long)C.bid * ngroups) / C.G), g1 = (int)(((long)(C.bid + 1) * ngroups) / C.G);
    LAS float* part = (LAS float*)C.lds;
    const float* MOD = (const float*)(C.ws + WS_MOD);
    const f16* HH = (const f16*)(C.ws + WS_HH);
    float* AFFL = (float*)(C.ws + WS_AFFL); float* AFFC = (float*)(C.ws + WS_AFFC);
    unsigned* INVw = (unsigned*)(C.ws + WS_INV);
    unsigned char* U8 = C.ws + WS_U;
    int* ROWIDX = (int*)(C.ws + WS_ROWIDX);
    { const int gw = C.bid * 8 + wave; if (gw < 64) { const int i = gw * 64 + lane; ROWIDX[(i >> 8) * EROWS + 4096 + (i & 255)] = 0; } }
    const float* Wr = C.in[IN_ROUTER] + (size_t)layer * 1024 * 16;
    const int q = lane >> 4, e = lane & 15, kb = 128 * wave + 8 * q;
    __syncthreads();
    f16x8 Bf[4]; unsigned gsh[4][4], shh[4][4]; float s2 = 0.f; int cur_bb = -1;
#pragma unroll
    for (int j = 0; j < 4; ++j) { Bf[j] = (f16x8){0, 0, 0, 0, 0, 0, 0, 0};
#pragma unroll
        for (int i = 0; i < 4; ++i) { gsh[j][i] = 0u; shh[j][i] = 0u; } }
    u32x4 xn[4];
    if (g0 < g1) {
#pragma unroll
        for (int j = 0; j < 4; ++j) xn[j] = *(const u32x4*)(HH + (size_t)(16 * g0 + e) * D + kb + 32 * j); }
    for (int g = g0; g < g1; ++g) {
        const int row0 = 16 * g; const bool isc = row0 >= RL; const int bb = isc ? 4 : (row0 >> 13);
        LAS float* pw = part + ((g & 1) * 8) * 288;
        if (bb != cur_bb) { cur_bb = bb;
            const float* gn = C.in[IN_NFFN] + layer * 1024; const float* sh = MOD + (size_t)(layer * 5 + bb) * 6144 + 3 * 1024; const float* sc = sh + 1024;
            float s2p = 0.f;
#pragma unroll
            for (int j = 0; j < 4; ++j) { const int k0 = kb + 32 * j;
                const f32x4 ga = *(const f32x4*)(gn + k0), gb = *(const f32x4*)(gn + k0 + 4), sa = *(const f32x4*)(sc + k0), sb2 = *(const f32x4*)(sc + k0 + 4), ha = *(const f32x4*)(sh + k0), hb = *(const f32x4*)(sh + k0 + 4);
                float gs[8], hv[8];
#pragma unroll
                for (int i = 0; i < 4; ++i) { gs[i] = ga[i] * (sa[i] + 1.0f); gs[4 + i] = gb[i] * (sb2[i] + 1.0f); hv[i] = ha[i]; hv[4 + i] = hb[i]; }
                f16x8 bfr;
#pragma unroll
                for (int i = 0; i < 8; ++i) { const float wv = Wr[(size_t)(k0 + i) * 16 + e]; bfr[i] = (f16)(gs[i] * wv); s2p += hv[i] * wv; }
                Bf[j] = bfr;
#pragma unroll
                for (int i = 0; i < 4; ++i) { gsh[j][i] = pkh(gs[2 * i], gs[2 * i + 1]); shh[j][i] = pkh(hv[2 * i], hv[2 * i + 1]); } }
            s2p += swz_xor<16>(s2p); s2 = sum_xor32(s2p); }
        f16x8 xa[4];
#pragma unroll
        for (int j = 0; j < 4; ++j) xa[j] = __builtin_bit_cast(f16x8, xn[j]);
        { const int gn2 = min(g + 1, g1 - 1);
#pragma unroll
          for (int j = 0; j < 4; ++j) xn[j] = *(const u32x4*)(HH + (size_t)(16 * gn2 + e) * D + kb + 32 * j); }
        f32x4 acc = (f32x4){0.f, 0.f, 0.f, 0.f}; float ss = 0.f;
#pragma unroll
        for (int j = 0; j < 4; ++j) { acc = __builtin_amdgcn_mfma_f32_16x16x32_f16(xa[j], Bf[j], acc, 0, 0, 0);
#pragma unroll
            for (int i = 0; i < 8; ++i) { const float xv = (float)xa[j][i]; ss += xv * xv; } }
        ss += swz_xor<16>(ss); ss = sum_xor32(ss);
        LAS float* mine = pw + wave * 288;
#pragma unroll
        for (int i = 0; i < 4; ++i) mine[(4 * q + i) * 16 + e] = acc[i];
        if (lane < 16) { mine[256 + lane] = ss; mine[272 + lane] = s2; }
        __syncthreads();
        float sst = 0.f;
#pragma unroll
        for (int w2 = 0; w2 < 8; ++w2) sst += pw[w2 * 288 + 256 + e];
        const float rstd = 1.0f / sqrtf(sst * (1.0f / D) + NORM_EPS);
        unsigned char* up = U8 + (size_t)(row0 + e) * D + kb;
#pragma unroll
        for (int j = 0; j < 4; ++j) { float u[8];
#pragma unroll
            for (int i = 0; i < 4; ++i) { const f32x2 gsv = h2f_(gsh[j][i]), shv = h2f_(shh[j][i]);
                u[2 * i] = ((float)xa[j][2 * i] * rstd) * gsv[0] + shv[0]; u[2 * i + 1] = ((float)xa[j][2 * i + 1] * rstd) * gsv[1] + shv[1]; }
            u32x2 o; o.x = pk8(u[0], u[1], u[2], u[3]); o.y = pk8(u[4], u[5], u[6], u[7]);
            *(u32x2*)(up + 32 * j) = o; }
        { const int r = 2 * wave + ((lane >> 4) & 1);
          float lgt = 0.f, sr = 0.f, s2t = 0.f;
#pragma unroll
          for (int w2 = 0; w2 < 8; ++w2) { lgt += pw[w2 * 288 + r * 16 + e]; sr += pw[w2 * 288 + 256 + r]; s2t += pw[w2 * 288 + 272 + e]; }
          lgt = lgt * (1.0f / sqrtf(sr * (1.0f / D) + NORM_EPS)) + s2t;
          float mx = lgt; mx = fmaxf(mx, swz_xor<1>(mx)); mx = fmaxf(mx, swz_xor<2>(mx)); mx = fmaxf(mx, swz_xor<4>(mx)); mx = fmaxf(mx, swz_xor<8>(mx));
          const float pe = expf(lgt - mx);
          float sum = pe; sum += swz_xor<1>(sum); sum += swz_xor<2>(sum); sum += swz_xor<4>(sum); sum += swz_xor<8>(sum);
          const float aff = pe / sum;
          const int row = row0 + r, rc = row - RL;
          float* dst = isc ? AFFC + (size_t)((rc >> 8) * 16 + e) * NCX + (rc & 255) : AFFL + (size_t)((row >> 13) * 16 + e) * T + (row & 8191);
          if (lane < 32) *dst = aff;
          if (lane < 16) INVw[(size_t)(row0 + 2 * wave) * 8 + lane] = 0u; }
    }
}

template <int EPT>
__device__ __forceinline__ void topk_unit(const Ctx& C, const float* vals, int nact  , int K, int e, int rowbase, int slotbase) {
    LAS unsigned* hist = (LAS unsigned*)C.lds;
    LAS unsigned* res = hist + 256;
    LAS unsigned* wtot = hist + 264;
    const int tid = C.tid, lane = C.lane; const bool active = tid < nact;
    unsigned key[EPT];
    if (EPT == 16) {
#pragma unroll
        for (int j = 0; j < 4; ++j) { const u32x4 w = active ? *(const u32x4*)(vals + tid * 16 + 4 * j) : (u32x4){0u, 0u, 0u, 0u}; key[4 * j] = w.x; key[4 * j + 1] = w.y; key[4 * j + 2] = w.z; key[4 * j + 3] = w.w; }
    } else {
#pragma unroll
        for (int j = 0; j < EPT; ++j) key[j] = active ? __float_as_uint(vals[tid * EPT + j]) : 0u;
    }
    unsigned prefix = 0u, mask = 0u; int remaining = K;
    for (int pass = 0; pass < 4; ++pass) {
        const int shift = 24 - 8 * pass;
        if (tid < 256) hist[tid] = 0u;
        __syncthreads();
        if (active) {
#pragma unroll
            for (int j = 0; j < EPT; ++j) if ((key[j] & mask) == prefix) __hip_atomic_fetch_add(&hist[(key[j] >> shift) & 255u], 1u, __ATOMIC_RELAXED, __HIP_MEMORY_SCOPE_WORKGROUP);
        }
        __syncthreads();
        if (C.wave == 0) {
            const unsigned c0 = hist[4 * lane], c1 = hist[4 * lane + 1], c2 = hist[4 * lane + 2], c3 = hist[4 * lane + 3];
            const unsigned tot = c0 + c1 + c2 + c3; unsigned suf = tot;
#pragma unroll
            for (int o = 1; o < 64; o <<= 1) { const unsigned t = (unsigned)__builtin_amdgcn_ds_bpermute(((lane + o) & 63) << 2, (int)suf); if (lane + o < 64) suf += t; }
            const unsigned above = suf - tot;
            if ((int)above < remaining && remaining <= (int)suf) {
                unsigned a = above; int d = -1; unsigned nr = 0;
                const unsigned cs[4] = {c0, c1, c2, c3};
#pragma unroll
                for (int bq = 3; bq >= 0; --bq) { if (d < 0) { if ((int)(a + cs[bq]) >= remaining) { d = 4 * lane + bq; nr = (unsigned)remaining - a; } else a += cs[bq]; } }
                res[0] = (unsigned)d; res[1] = nr;
            }
        }
        __syncthreads();
        const unsigned d = res[0]; remaining = (int)res[1];
        prefix |= d << shift; mask |= 0xFFu << shift;
    }
    const unsigned Tk = prefix; const int need_eq = remaining;
    unsigned gt = 0, eq = 0;
    if (active) {
#pragma unroll
        for (int j = 0; j < EPT; ++j) { gt += key[j] > Tk; eq += key[j] == Tk; }
    }
    const unsigned packed = gt | (eq << 16);
    unsigned incl = packed;
#pragma unroll
    for (int o = 1; o < 64; o <<= 1) { const unsigned t = (unsigned)__builtin_amdgcn_ds_bpermute(((lane - o) & 63) << 2, (int)incl); if (lane >= o) incl += t; }
    if (lane == 63) wtot[C.wave] = incl;
    __syncthreads();
    unsigned pre = 0;
    for (int w = 0; w < C.wave; ++w) pre += wtot[w];
    const unsigned excl = pre + incl - packed;
    unsigned gtb = excl & 0xffffu, eqb = excl >> 16;
    const unsigned total_gt = (unsigned)(K - need_eq);
    int* ROWIDX = (int*)(C.ws + WS_ROWIDX); unsigned short* INV = (unsigned short*)(C.ws + WS_INV);
    if (active) {
#pragma unroll
        for (int j = 0; j < EPT; ++j) {
            int slot = -1;
            if (key[j] > Tk) { slot = (int)gtb; ++gtb; }
            else if (key[j] == Tk) { if ((int)eqb < need_eq) slot = (int)(total_gt + eqb); ++eqb; }
            if (slot >= 0) { const int idx = tid * EPT + j; ROWIDX[e * EROWS + slotbase + slot] = rowbase + idx; INV[(size_t)(rowbase + idx) * 16 + e] = (unsigned short)(slotbase + slot + 1); }
        }
    }
    __syncthreads();
}
__device__ __forceinline__ void phase_topk(const Ctx& C, int layer) {
    const int nunits = layer == DEPTH - 1 ? 64 : 128;
    for (int u = C.bid; u < nunits; u += C.G) {
        if (u < 64) { const int b = u >> 4, e = u & 15; topk_unit<16>(C, (const float*)(C.ws + WS_AFFL) + (size_t)(b * 16 + e) * T, 512, CAPL, e, b * T, b * CAPL); }
        else { const int v = u - 64, b = v >> 4, e = v & 15; topk_unit<1>(C, (const float*)(C.ws + WS_AFFC) + (size_t)(b * 16 + e) * NCX, 256, CAPC, e, RL + b * NCX, NB * CAPL + b * CAPC); }
    }
}
constexpr int CV_ITEMS = NE * 1536;
constexpr int CV_IPB0 = 48, CV_IPB1 = 24, CV_IPB2 = 24;
__device__ __forceinline__ int cv_n0(int layer, int G) { return (G == 256 && layer >= 1) ? 192 * CV_IPB0 : 0; }
__device__ __forceinline__ int cv_idle1(int layer) { const int nwg = (R / 256) * ((layer % 3) == 0 ? 6 : 12); return 256 - nwg % 256; }
__device__ __forceinline__ int cv_n1(int layer, int G) { return G == 256 ? cv_idle1(layer) * CV_IPB1 : 0; }
__device__ __forceinline__ int cv_n2(int layer, int G) { return (G == 256 && layer < DEPTH - 1) ? 240 * CV_IPB2 : 0; }
__device__ __forceinline__ void convert_items(const Ctx& C, int layer, int first, int count  ) {
    LAS float* scr = (LAS float*)(C.lds + C.wave * 16640); const int lane = C.lane;
    unsigned char* WEGU = C.ws + ((layer & 1) ? WS_WEGU2 : WS_WEGU); unsigned char* WED = C.ws + ((layer & 1) ? WS_WED2 : WS_WED);
    const int end = min(first + count, CV_ITEMS);
    for (int it = first + C.wave; it < end; it += 8) {
        const int e = it / 1536, r = it % 1536, kind = r >> 9, q = r & 511;
        if (kind < 2) { const int kb = q >> 5, nb = q & 31, n0 = 64 * nb; const float* W = C.in[kind == 0 ? IN_WGATE : IN_WUP] + ((size_t)layer * NE + e) * 1024 * 2048;
            transpose_item8(W, 1024, 2048, WEGU + (size_t)e * 4096 * 1024, 64 * kb, n0, (n0 >> 7) * 256 + (n0 & 127) + kind * 128, scr, lane); }
        else { const int kb = q >> 4, nb = q & 15; const float* W = C.in[IN_WDOWN] + ((size_t)layer * NE + e) * 2048 * 1024;
            transpose_item8(W, 2048, 1024, WED + (size_t)e * 1024 * 2048, 64 * kb, 64 * nb, 64 * nb, scr, lane); }
    }
}
constexpr int CV_TOPK_EQ = 16;
__device__ __forceinline__ void phase_topk_convert(const Ctx& C, int layer) {
    const int ntk = min(layer == DEPTH - 1 ? 64 : 128, C.G);
    phase_topk(C, layer);
    __syncthreads();
    const int done = cv_n0(layer, C.G) + cv_n1(layer, C.G) + cv_n2(layer, C.G);
    const int rem = CV_ITEMS - done; if (rem <= 0) return;
    const int share = (rem + CV_TOPK_EQ * ntk + C.G - 1) / C.G, small = max(share - CV_TOPK_EQ, 0);
    const int first = C.bid < ntk ? C.bid * small : ntk * small + (C.bid - ntk) * share, cnt = C.bid < ntk ? small : share;
    if (first < rem) convert_items(C, layer, done + first, min(cnt, rem - first));
}

struct AttnSt { f32x4 o[4][4]; float m[4]; float l[4]; };
__device__ __forceinline__ f16x4 tr_read(const LAS char* p) { return __builtin_bit_cast(f16x4, __builtin_amdgcn_ds_read_tr16_b64_v4i16((LAS v4i16*)p)); }
template <int QLO, int QHI, int MODE>
__device__ __forceinline__ void attn_block32(AttnSt& st, const f16x8 (&q)[4][2], const f16x8 (&kf)[2][2], const LAS char* vb, int lane, int p0, int p1, const LAS float* bias) {
    const int h = lane >> 4, li = lane & 15;
    f16x8 vf[4];
    const LAS char* va = vb + (4 * h + (li >> 2)) * 160 + (li & 3) * 8;
#pragma unroll
    for (int dt = 0; dt < 4; ++dt) { const f16x4 a = tr_read(va + dt * 32), b = tr_read(va + 16 * 160 + dt * 32); vf[dt] = (f16x8){a[0], a[1], a[2], a[3], b[0], b[1], b[2], b[3]}; }
    f32x4 sa[4][2];
#pragma unroll
    for (int qt = QLO; qt < QHI; ++qt)
#pragma unroll
        for (int kt = 0; kt < 2; ++kt) { const float nm = (MODE == 1) ? -st.m[qt] : 0.0f; f32x4 z = (f32x4){nm, nm, nm, nm};
            z = __builtin_amdgcn_mfma_f32_16x16x32_f16(kf[kt][0], q[qt][0], z, 0, 0, 0); sa[qt][kt] = __builtin_amdgcn_mfma_f32_16x16x32_f16(kf[kt][1], q[qt][1], z, 0, 0, 0); }
#pragma unroll
    for (int qp = QLO; qp < QHI; qp += 2) {
        f16x8 pf[2];
#pragma unroll
        for (int u = 0; u < 2; ++u) { const int qt = qp + u; if (qt >= QHI) continue;
            float s[8] = {sa[qt][0][0], sa[qt][0][1], sa[qt][0][2], sa[qt][0][3], sa[qt][1][0], sa[qt][1][1], sa[qt][1][2], sa[qt][1][3]};
            if (MODE == 1) {
                if (p1 < (1 << 20)) {
#pragma unroll
                    for (int i = 0; i < 8; ++i) { const int dlt = p0 + 16 * (i >> 2) + 4 * h + (i & 3) - (16 * qt + li); s[i] = (abs(dlt) <= p1) ? s[i] : -INFINITY; }
                }
            }
            if (MODE == 2) {
                const int qc = 16 * qt + li; const int cs = min(max(qc - 8, 0), 48);
                const LAS float* bp = bias + (p1 + 15 + 4 * h - li);
#pragma unroll
                for (int i = 0; i < 8; ++i) { const int kc = p0 + 16 * (i >> 2) + 4 * h + (i & 3); const bool ok = (unsigned)(kc - cs) < 16u;
                    s[i] += bp[p0 + 16 * (i >> 2) + (i & 3) - 16 * qt]; s[i] = ok ? s[i] : -INFINITY; }
            }
            const float mxl = fmaxf(fmaxf(fmaxf(s[0], s[1]), fmaxf(s[2], s[3])), fmaxf(fmaxf(s[4], s[5]), fmaxf(s[6], s[7])));
            const float mref = (MODE == 1) ? 0.0f : st.m[qt];
            if (__builtin_amdgcn_ballot_w64(mxl > mref + 8.0f) != 0ull) {
                float mx = mxl; mx = fmaxf(mx, swz_xor<16>(mx)); mx = max_xor32(mx);
                float dl = 0.f, alpha;
                if (MODE == 1) { dl = fmaxf(mx, 0.0f); alpha = __builtin_amdgcn_exp2f(-dl); st.m[qt] += dl; }
                else { const float mnew = fmaxf(st.m[qt], mx); alpha = __builtin_amdgcn_exp2f(st.m[qt] - mnew); st.m[qt] = mnew; }
                st.l[qt] *= alpha;
#pragma unroll
                for (int dt = 0; dt < 4; ++dt) st.o[dt][qt] = st.o[dt][qt] * alpha;
                if (MODE == 1) {
#pragma unroll
                    for (int i = 0; i < 8; ++i) s[i] -= dl; }
            }
            const float mcur = (MODE == 1) ? 0.0f : st.m[qt];
            float rs = 0.f;
#pragma unroll
            for (int i = 0; i < 8; ++i) { s[i] = __builtin_amdgcn_exp2f(MODE == 1 ? s[i] : s[i] - mcur); rs += s[i]; }
            st.l[qt] += rs;
            pf[u] = (f16x8){(f16)s[0], (f16)s[1], (f16)s[2], (f16)s[3], (f16)s[4], (f16)s[5], (f16)s[6], (f16)s[7]};
        }
#pragma unroll
        for (int u = 0; u < 2; ++u) { const int qt = qp + u; if (qt >= QHI) continue;
#pragma unroll
            for (int dt = 0; dt < 4; ++dt) st.o[dt][qt] = __builtin_amdgcn_mfma_f32_16x16x32_f16(vf[dt], pf[u], st.o[dt][qt], 0, 0, 0); }
        __builtin_amdgcn_sched_barrier(0);
    }
}
__device__ __forceinline__ void attn_init(AttnSt& st, float m0, float l0) {
#pragma unroll
    for (int qt = 0; qt < 4; ++qt) { st.m[qt] = m0; st.l[qt] = l0;
#pragma unroll
        for (int dt = 0; dt < 4; ++dt) st.o[dt][qt] = (f32x4){0.f, 0.f, 0.f, 0.f}; }
}
__device__ __forceinline__ void attn_store(AttnSt& st, f16* O, size_t row0, int col0, int lane) {
    const int h = lane >> 4, li = lane & 15;
#pragma unroll
    for (int qt = 0; qt < 4; ++qt) { float l = st.l[qt]; l += swz_xor<16>(l); l = sum_xor32(l); const float inv = 1.0f / l;
        f16* rp = O + row0 * D + col0;
        const unsigned lo2 = (unsigned)(li * D + 4 * h) + (unsigned)(16 * qt * D);
#pragma unroll
        for (int dt = 0; dt < 4; ++dt) { const f32x4 v = st.o[dt][qt] * inv; u32x2 w; w.x = pkh(v[0], v[1]); w.y = pkh(v[2], v[3]); *(u32x2*)(rp + (lo2 + (unsigned)(16 * dt))) = w; } }
}
__device__ __forceinline__ void load_q(f16x8 (&q)[4][2], const f16* Q  , int lane) {
    const unsigned loff = (unsigned)((lane & 15) * 64 + 8 * (lane >> 4));
#pragma unroll
    for (int qt = 0; qt < 4; ++qt)
#pragma unroll
        for (int ks = 0; ks < 2; ++ks) q[qt][ks] = __builtin_nontemporal_load((const f16x8*)(Q + (loff + (unsigned)(qt * 1024 + ks * 32))));
}

constexpr size_t AT_QR = 0, AT_QP = 64 * MiB, AT_KR = 128 * MiB, AT_VV = 144 * MiB, AT_QC = 160 * MiB, AT_KC = 162 * MiB, AT_VC = 163 * MiB;
constexpr size_t CT_Q = 0, CT_K = 64 * MiB, CT_V = 128 * MiB, CT_QC = 192 * MiB, CT_KC = 194 * MiB, CT_VC = 196 * MiB;
template <int KIND  > struct EpiQKV {
    static constexpr bool PERM = false, SWAP = false; static constexpr int BPERM = 2;
    unsigned char* AT; const float* qg; const float* kg; const float* rope; bool need_ctx;
    __device__ __forceinline__ void operator()(const f32x4 (&acc)[2][2][4][2], const pg8::Unit& u, int wr, int wc, int fr_, int fq_) const {
        int fr = fr_, fq = fq_; asm volatile("" : "+v"(fr), "+v"(fq));
        const bool isc = u.pm >= 128; const int b = isc ? (u.pm - 128) : (u.pm >> 5); const int t0 = isc ? 0 : (u.pm & 31) * 256; const int len = isc ? NCX : T;
        int role, head, nh;
        if (KIND == 0) { role = u.pn < 4 ? 0 : (u.pn == 4 ? 1 : 2); head = (u.pn < 4 ? 4 * u.pn : 0) + wc; nh = role == 0 ? 16 : 4; }
        else { role = u.pn >> 2; head = 4 * (u.pn & 3) + wc; nh = 16; }
        if (role == 0 && isc && !need_ctx) return;
        size_t off0, off1 = 0;
        if (KIND == 0) { if (role == 0) { off0 = isc ? AT_QC : AT_QP; off1 = AT_QR; } else if (role == 1) off0 = isc ? AT_KC : AT_KR; else off0 = isc ? AT_VC : AT_VV; }
        else { if (role == 0) off0 = isc ? CT_QC : CT_Q; else if (role == 1) off0 = isc ? CT_KC : CT_K; else off0 = isc ? CT_VC : CT_V; }
        f16* dst0 = (f16*)(AT + off0) + (size_t)(b * nh + head) * len * 64; f16* dst1 = (f16*)(AT + off1) + (size_t)(b * nh + head) * len * 64;
        const float* gp = role == 0 ? qg : kg;
        f32x4 gv[2][2];
#pragma unroll
        for (int bj = 0; bj < 2; ++bj)
#pragma unroll
            for (int n = 0; n < 2; ++n) gv[bj][n] = *(const f32x4*)(gp + 32 * bj + 16 * n + 4 * fq);
        const float osc = role == 0 ? QSCALE : 1.0f;
        const bool rot = (KIND == 0) && !isc && role < 2;
#pragma unroll
        for (int ai = 0; ai < 2; ++ai)
#pragma unroll
            for (int m = 0; m < 4; ++m) {
                const int t = t0 + ai * 128 + wr * 64 + m * 16 + fr;
                f32x4 y[2][2];
#pragma unroll
                for (int bj = 0; bj < 2; ++bj)
#pragma unroll
                    for (int n = 0; n < 2; ++n) y[bj][n] = acc[ai][bj][m][n];
                if (role < 2) {
                    float ss = 0.f;
#pragma unroll
                    for (int bj = 0; bj < 2; ++bj)
#pragma unroll
                        for (int n = 0; n < 2; ++n) ss += (y[bj][n].x * y[bj][n].x + y[bj][n].y * y[bj][n].y) + (y[bj][n].z * y[bj][n].z + y[bj][n].w * y[bj][n].w);
                    ss += swz_xor<16>(ss); ss = sum_xor32(ss);
                    const float r = 1.0f / sqrtf(ss * (1.0f / 64.0f) + NORM_EPS);
#pragma unroll
                    for (int bj = 0; bj < 2; ++bj)
#pragma unroll
                        for (int n = 0; n < 2; ++n) y[bj][n] = y[bj][n] * r * gv[bj][n];
                }
                f16* p0 = dst0 + (size_t)t * 64 + 4 * fq;
                if (!(KIND == 0 && role == 1 && !isc)) {
#pragma unroll
                    for (int bj = 0; bj < 2; ++bj)
#pragma unroll
                        for (int n = 0; n < 2; ++n) { const f32x4 v = y[bj][n] * osc; u32x2 w; w.x = pkh(v.x, v.y); w.y = pkh(v.z, v.w); *(u32x2*)(p0 + 32 * bj + 16 * n) = w; }
                }
                if (rot) {
                    f16* p1 = (role == 0 ? dst1 : dst0) + (size_t)t * 64 + 4 * fq;
#pragma unroll
                    for (int bj = 0; bj < 2; ++bj) { const int pos = bj == 0 ? (t >> 6) : (t & 63);
                        const f32x4 cs = *(const f32x4*)(rope + pos * 16 + 4 * fq), sn = *(const f32x4*)(rope + 2048 + pos * 16 + 4 * fq);
                        const f32x4 r0 = (y[bj][0] * cs - y[bj][1] * sn) * osc, r1 = (y[bj][1] * cs + y[bj][0] * sn) * osc;
                        u32x2 w0, w1; w0.x = pkh(r0.x, r0.y); w0.y = pkh(r0.z, r0.w); w1.x = pkh(r1.x, r1.y); w1.y = pkh(r1.z, r1.w);
                        *(u32x2*)(p1 + 32 * bj) = w0; *(u32x2*)(p1 + 32 * bj + 16) = w1; }
                }
            }
    }
};
__device__ __forceinline__ void head_norm8(const float (&x)[8], const float* g, float (&y)[8]) {
    float ss = 0.f;
#pragma unroll
    for (int i = 0; i < 8; ++i) ss += x[i] * x[i];
    ss += swz_xor<1>(ss); ss += swz_xor<2>(ss); ss += swz_xor<4>(ss);
    const float r = 1.0f / sqrtf(ss * (1.0f / 64.0f) + NORM_EPS);
#pragma unroll
    for (int i = 0; i < 8; ++i) y[i] = x[i] * r * g[i];
}
__device__ __forceinline__ u32x4 pack8(const float (&y)[8], float sc) { u32x4 w; w.x = pkh(y[0] * sc, y[1] * sc); w.y = pkh(y[2] * sc, y[3] * sc); w.z = pkh(y[4] * sc, y[5] * sc); w.w = pkh(y[6] * sc, y[7] * sc); return w; }
__device__ __forceinline__ void phase_prep_a(const Ctx& C, int j  , bool need_ctx) {
    const int gw = C.bid * 8 + C.wave, NGW = C.G * 8, lane = C.lane;
    const f16* P = (const f16*)(C.ws + WS_P); unsigned char* AT = C.ws + WS_ATT;
    const float* rope = (const float*)(C.ws + WS_ROPE);
    const int d0 = 8 * (lane & 7), sub = lane & 7;
    float qg[8], kg[8];
#pragma unroll
    for (int i = 0; i < 8; ++i) { qg[i] = C.in[IN_A_QG][j * 64 + d0 + i]; kg[i] = C.in[IN_A_KG][j * 64 + d0 + i]; }
    for (int row = gw; row < R; row += NGW) {
        const bool isc = row >= RL; const int rc = row - RL; const int b = isc ? (rc >> 8) : (row >> 13); const int t = isc ? (rc & 255) : (row & 8191); const int len = isc ? NCX : T;
        const f16* pr = P + (size_t)row * 1536;
        const int pos = (sub < 4) ? (t >> 6) : (t & 63); const int f0 = 8 * (sub & 1);
        float cs[8], sn[8];
#pragma unroll
        for (int i = 0; i < 8; ++i) { cs[i] = rope[pos * 16 + f0 + i]; sn[i] = rope[2048 + pos * 16 + f0 + i]; }
        const bool is_x1 = !(sub & 2);
#pragma unroll
        for (int jj = 0; jj < 3; ++jj) {
            float x[8], y[8]; unpack8(*(const u32x4*)(pr + 512 * jj + 8 * lane), x);
            const bool isv = (jj == 2) && (lane >= 32);
            head_norm8(x, jj < 2 ? qg : kg, y);
            float ro[8];
#pragma unroll
            for (int i = 0; i < 8; ++i) { const float py = swz_xor<2>(y[i]); ro[i] = is_x1 ? y[i] * cs[i] - py * sn[i] : y[i] * cs[i] + py * sn[i]; }
            if (jj < 2) {
                const int hq = 8 * jj + (lane >> 3);
                if (!isc) { const size_t o = ((size_t)(b * 16 + hq) * T + t) * 64 + d0; *(u32x4*)((f16*)(AT + AT_QP) + o) = pack8(y, QSCALE); *(u32x4*)((f16*)(AT + AT_QR) + o) = pack8(ro, QSCALE); }
                else if (need_ctx) { const size_t o = ((size_t)(b * 16 + hq) * NCX + t) * 64 + d0; *(u32x4*)((f16*)(AT + AT_QC) + o) = pack8(y, QSCALE); }
            } else {
                const int hk = (lane & 31) >> 3; const size_t o = ((size_t)(b * 4 + hk) * len + t) * 64 + d0;
                f16* dst = (f16*)(AT + (isv ? (isc ? AT_VC : AT_VV) : (isc ? AT_KC : AT_KR))) + o;
                *(u32x4*)dst = isv ? pack8(x, 1.0f) : (isc ? pack8(y, 1.0f) : pack8(ro, 1.0f));
            }
        }
    }
}
__device__ __forceinline__ void phase_prep_c(const Ctx& C, bool need_ctx) {
    const int gw = C.bid * 8 + C.wave, NGW = C.G * 8, lane = C.lane;
    const f16* P = (const f16*)(C.ws + WS_P); unsigned char* AT = C.ws + WS_ATT;
    const int d0 = 8 * (lane & 7);
    float qg[8], kg[8];
#pragma unroll
    for (int i = 0; i < 8; ++i) { qg[i] = C.in[IN_C_QG][d0 + i]; kg[i] = C.in[IN_C_KG][d0 + i]; }
    for (int row = gw; row < R; row += NGW) {
        const bool isc = row >= RL; const int rc = row - RL; const int b = isc ? (rc >> 8) : (row >> 13); const int t = isc ? (rc & 255) : (row & 8191); const int len = isc ? NCX : T;
        const f16* pr = P + (size_t)row * 3072;
#pragma unroll
        for (int jj = 0; jj < 6; ++jj) {
            float x[8], y[8]; unpack8(*(const u32x4*)(pr + 512 * jj + 8 * lane), x);
            head_norm8(x, jj < 2 ? qg : kg, y);
            const int hh = 8 * (jj & 1) + (lane >> 3); const size_t o = ((size_t)(b * 16 + hh) * len + t) * 64 + d0;
            if (jj < 2) { if (!isc) *(u32x4*)((f16*)(AT + CT_Q) + o) = pack8(y, QSCALE); else if (need_ctx) *(u32x4*)((f16*)(AT + CT_QC) + o) = pack8(y, QSCALE); }
            else if (jj < 4) *(u32x4*)((f16*)(AT + (isc ? CT_KC : CT_K)) + o) = pack8(y, 1.0f);
            else *(u32x4*)((f16*)(AT + (isc ? CT_VC : CT_V)) + o) = pack8(x, 1.0f);
        }
    }
}

__device__ __forceinline__ void phase_attn_a(const Ctx& C, int j, bool need_ctx) {
    const int lane = C.lane, tid = C.tid, wave = C.wave;
    unsigned char* AT = C.ws + WS_ATT; f16* O = (f16*)(C.ws + WS_O);
    const int nctx = need_ctx ? 32 : 0, nunits = nctx + 1024;
    const int g = wave >> 1, half = wave & 1;
    const int srow = tid >> 3, sch = tid & 7;
    for (int u = C.bid; u < nunits; u += C.G) {
        const bool cu = u < nctx;
        int b, hk, i;
        if (cu) { b = u >> 3; hk = (u >> 1) & 3; i = u & 1; } else { const int v = u - nctx; b = v >> 8; i = (v >> 2) & 63; hk = v & 3; }
        const int hq = hk * 4 + g;
        const int q0 = i * 128 + half * 64;
        const f16* KRb = (const f16*)(AT + AT_KR) + (size_t)(b * 4 + hk) * T * 64; const f16* VVb = (const f16*)(AT + AT_VV) + (size_t)(b * 4 + hk) * T * 64;
        const f16* KCb = (const f16*)(AT + AT_KC) + (size_t)(b * 4 + hk) * NCX * 64; const f16* VCb = (const f16*)(AT + AT_VC) + (size_t)(b * 4 + hk) * NCX * 64;
        const f16* QRw = cu ? (const f16*)(AT + AT_QC) + ((size_t)(b * 16 + hq) * NCX + q0) * 64 : (const f16*)(AT + AT_QR) + ((size_t)(b * 16 + hq) * T + q0) * 64;
        const f16* QPw = cu ? QRw : (const f16*)(AT + AT_QP) + ((size_t)(b * 16 + hq) * T + q0) * 64;
        f16x8 q[4][2];
        load_q(q, QRw, lane);
        AttnSt st; attn_init(st, C.in[IN_A_SINK][j * 16 + hq] * LOG2E, (lane < 16) ? 1.0f : 0.0f);
        const int c_lo = cu ? 0 : (i == 0 ? 1 : 0), c_hi = cu ? 0 : (i == 63 ? 2 : 3), nl = c_hi - c_lo, nch = nl + 2;
        const unsigned soff = (unsigned)(srow * 64 + 8 * sch);
        u32x4 kreg[2], vreg[2];
#define ATTN_A_LOADCHUNK(kx) { const int k1 = min((kx), nch - 1); const bool loc1 = k1 < nl; const int kp1 = (i - 1) * 128 + 128 * (c_lo + k1); const int cc = k1 - nl;        \
            const f16* ks = loc1 ? KRb + (size_t)kp1 * 64 : KCb + (size_t)(128 * cc) * 64; const f16* vs = loc1 ? VVb + (size_t)kp1 * 64 : VCb + (size_t)(128 * cc) * 64; \
            kreg[0] = *(const u32x4*)(ks + soff); kreg[1] = *(const u32x4*)(ks + soff + 4096); vreg[0] = *(const u32x4*)(vs + soff); vreg[1] = *(const u32x4*)(vs + soff + 4096); }
        ATTN_A_LOADCHUNK(0)
#define ATTN_A_CHUNK { \
            LAS char* kb = (LAS char*)C.lds + (k & 1) * 40960; LAS char* vbuf = kb + 20480; \
            *(LAS u32x4*)(kb + srow * 160 + sch * 16) = kreg[0]; *(LAS u32x4*)(kb + (srow + 64) * 160 + sch * 16) = kreg[1]; \
            *(LAS u32x4*)(vbuf + srow * 160 + sch * 16) = vreg[0]; *(LAS u32x4*)(vbuf + (srow + 64) * 160 + sch * 16) = vreg[1]; \
            __syncthreads(); \
            ATTN_A_LOADCHUNK(k + 1)        \
            const bool loc = k < nl; const int kp0 = (i - 1) * 128 + 128 * (c_lo + k); \
            _Pragma("unroll 1") for (int blk = 0; blk < 4; ++blk) { \
                const LAS char* kblk = kb + blk * 32 * 160; const LAS char* vblk = vbuf + blk * 32 * 160; \
                const int kb0 = kp0 + 32 * blk; \
                if (loc && (kb0 + 31 < q0 - 128 || kb0 > q0 + 63 + 128)) continue; \
                f16x8 kf[2][2]; \
                _Pragma("unroll") for (int kt = 0; kt < 2; ++kt) _Pragma("unroll") for (int ks = 0; ks < 2; ++ks) kf[kt][ks] = *(const LAS f16x8*)(kblk + (16 * kt + (lane & 15)) * 160 + (lane >> 4) * 16 + ks * 64); \
                const bool edge = loc && !(kb0 >= q0 + 63 - 128 && kb0 + 31 <= q0 + 128); \
                attn_block32<0, 4, 1>(st, q, kf, vblk, lane, loc ? kb0 - q0 : 0, edge ? 128 : (1 << 24), nullptr); } }
        int k = 0;
#pragma unroll 1
        for (; k < nl; ++k) ATTN_A_CHUNK
        if (!cu) { load_q(q, QPw, lane); __builtin_amdgcn_sched_barrier(0); }
#pragma unroll 1
        for (; k < nch; ++k) ATTN_A_CHUNK
#undef ATTN_A_CHUNK
#undef ATTN_A_LOADCHUNK
        const size_t orow = cu ? (size_t)RL + b * NCX + q0 : (size_t)b * T + q0;
        attn_store(st, O, orow, hq * 64, lane);
        __syncthreads();
    }
}

__device__ __forceinline__ void load_kf(f16x8 (&kf)[2][2], const f16* Kp  , int lane) {
#pragma unroll
    for (int kt = 0; kt < 2; ++kt)
#pragma unroll
        for (int ks = 0; ks < 2; ++ks) kf[kt][ks] = *(const f16x8*)(Kp + ((unsigned)((lane & 15) * 64 + 8 * (lane >> 4)) + (unsigned)(kt * 1024 + ks * 32)));
}
__device__ __forceinline__ void load_vrows(u32x4 (&vr)[4], const f16* Vp, int lane) {
#pragma unroll
    for (int jj = 0; jj < 4; ++jj) vr[jj] = *(const u32x4*)(Vp + ((unsigned)((lane >> 3) * 64 + 8 * (lane & 7)) + (unsigned)(jj * 512)));
}
__device__ __forceinline__ void store_vrows(const u32x4 (&vr)[4], LAS char* vb, int lane) {
#pragma unroll
    for (int jj = 0; jj < 4; ++jj) *(LAS u32x4*)(vb + ((lane >> 3) + 8 * jj) * 160 + (lane & 7) * 16) = vr[jj];
}
__device__ __forceinline__ void phase_attn_c(const Ctx& C, bool need_ctx) {
    const int lane = C.lane, gw = C.bid * 8 + C.wave, NGW = C.G * 8;
    unsigned char* AT = C.ws + WS_ATT; f16* O = (f16*)(C.ws + WS_O);
    LAS char* vbase = (LAS char*)C.lds + C.wave * 10240;
    LAS float* bias = (LAS float*)(C.lds + 81920 + C.wave * 2560) + 64;
    const int nlat = NB * 16 * 128, nunits = nlat + (need_ctx ? NB * 16 * 4 : 0);
    for (int u = gw; u < nunits; u += NGW) {
        const bool cu = u >= nlat;
        int b, hh, r;
        if (cu) { const int v = u - nlat; b = v >> 6; hh = (v >> 2) & 15; r = v & 3; } else { b = u >> 11; hh = (u >> 7) & 15; r = u & 127; }
        const f16* Kc = (const f16*)(AT + CT_KC) + (size_t)(b * 16 + hh) * NCX * 64; const f16* Vc = (const f16*)(AT + CT_VC) + (size_t)(b * 16 + hh) * NCX * 64;
        const f16* Kl = (const f16*)(AT + CT_K) + (size_t)(b * 16 + hh) * T * 64; const f16* Vl = (const f16*)(AT + CT_V) + (size_t)(b * 16 + hh) * T * 64;
        f16x8 q[4][2];
        if (cu) load_q(q, (const f16*)(AT + CT_QC) + ((size_t)(b * 16 + hh) * NCX + 64 * r) * 64, lane);
        else load_q(q, (const f16*)(AT + CT_Q) + ((size_t)(b * 16 + hh) * T + 64 * r) * 64, lane);
        if (!cu) { const float* rp = C.in[IN_C_RPB] + hh * 465; for (int i2 = lane; i2 < 465; i2 += 64) bias[i2] = rp[i2] * LOG2E; }
        AttnSt st; attn_init(st, -INFINITY, 0.0f);
        const int r0 = min(max(r - 4, 0), 120);
        const int nblk = cu ? 8 : 24;
        f16x8 kf[2][2], kn[2][2]; u32x4 vr[4];
        load_kf(kf, Kc, lane); load_vrows(vr, Vc, lane); store_vrows(vr, vbase, lane);
#define ATTN_C_STEP(N, CALL) { const int n = (N); \
            const int n1 = n + 1; const bool more = n1 < nblk; \
            const f16* kp = Kc; const f16* vp = Vc; \
            if (more) { if (n1 < 8) { kp = Kc + (size_t)32 * n1 * 64; vp = Vc + (size_t)32 * n1 * 64; } else { const size_t tok = (size_t)(r0 + ((n1 - 8) >> 1)) * 64 + 32 * ((n1 - 8) & 1); kp = Kl + tok * 64; vp = Vl + tok * 64; } } \
            load_kf(kn, kp, lane); load_vrows(vr, vp, lane); \
            const LAS char* vb = vbase + (n & 1) * 5120; \
            CALL; \
            if (more) { store_vrows(vr, vbase + (n1 & 1) * 5120, lane); } \
            _Pragma("unroll") for (int a = 0; a < 2; ++a) _Pragma("unroll") for (int c2 = 0; c2 < 2; ++c2) kf[a][c2] = kn[a][c2]; }
#pragma unroll 1
        for (int nn = 0; nn < 8; ++nn) ATTN_C_STEP(nn, (attn_block32<0, 4, 0>(st, q, kf, vb, lane, 0, 0, nullptr)))
#pragma unroll 1
        for (int nn = 8; nn < nblk; nn += 2) {
            ATTN_C_STEP(nn, (attn_block32<0, 3, 2>(st, q, kf, vb, lane, 0, (r0 + ((n - 8) >> 1) - r + 7) * 31, bias)))
            ATTN_C_STEP(nn + 1, (attn_block32<1, 4, 2>(st, q, kf, vb, lane, 32, (r0 + ((n - 8) >> 1) - r + 7) * 31, bias))) }
#undef ATTN_C_STEP
        const size_t orow = cu ? (size_t)RL + b * NCX + 64 * r : (size_t)b * T + 64 * r;
        attn_store(st, O, orow, hh * 64, lane);
    }
}

constexpr int FN = 16384;
__host__ __device__ constexpr int brev_c(int k, int bits) { int r = 0; for (int i = 0; i < bits; ++i) if (k & (1 << i)) r |= 1 << (bits - 1 - i); return r; }
__device__ __forceinline__ int swz(int i) { return i ^ ((i >> 4) & 7) ^ (((i >> 7) & 1) << 4) ^ ((((i >> 7) ^ (i >> 8)) & 1) << 3); }
__device__ __forceinline__ f32x2 cmul(f32x2 x, f32x2 w) { f32x2 t, r;
    asm("v_pk_mul_f32 %0, %1, %2 op_sel_hi:[0,1]" : "=v"(t) : "v"(x), "v"(w));
    asm("v_pk_fma_f32 %0, %1, %2, %3 op_sel:[1,1,0] op_sel_hi:[1,0,1] neg_lo:[0,1,0]" : "=v"(r) : "v"(x), "v"(w), "v"(t));
    return r; }
template <bool NR, bool NI> __device__ __forceinline__ f32x2 cmulk(f32x2 x, f32x2 K) { f32x2 t, r;
    if (!NR && !NI) { asm("v_pk_mul_f32 %0, %1, %2 op_sel_hi:[0,1]" : "=v"(t) : "v"(x), "s"(K));
                      asm("v_pk_fma_f32 %0, %1, %2, %3 op_sel:[1,1,0] op_sel_hi:[1,0,1] neg_lo:[0,1,0]" : "=v"(r) : "v"(x), "s"(K), "v"(t)); }
    if (!NR && NI)  { asm("v_pk_mul_f32 %0, %1, %2 op_sel_hi:[0,1] neg_hi:[0,1]" : "=v"(t) : "v"(x), "s"(K));
                      asm("v_pk_fma_f32 %0, %1, %2, %3 op_sel:[1,1,0] op_sel_hi:[1,0,1]" : "=v"(r) : "v"(x), "s"(K), "v"(t)); }
    if (NR && !NI)  { asm("v_pk_mul_f32 %0, %1, %2 op_sel_hi:[0,1] neg_lo:[0,1]" : "=v"(t) : "v"(x), "s"(K));
                      asm("v_pk_fma_f32 %0, %1, %2, %3 op_sel:[1,1,0] op_sel_hi:[1,0,1] neg_lo:[0,1,0] neg_hi:[0,1,0]" : "=v"(r) : "v"(x), "s"(K), "v"(t)); }
    if (NR && NI)   { asm("v_pk_mul_f32 %0, %1, %2 op_sel_hi:[0,1] neg_lo:[0,1] neg_hi:[0,1]" : "=v"(t) : "v"(x), "s"(K));
                      asm("v_pk_fma_f32 %0, %1, %2, %3 op_sel:[1,1,0] op_sel_hi:[1,0,1] neg_hi:[0,1,0]" : "=v"(r) : "v"(x), "s"(K), "v"(t)); }
    return r; }
__device__ __forceinline__ f32x2 dif_sub_rot(f32x2 a, f32x2 b) { f32x2 r; asm("v_pk_add_f32 %0, %1, %2 op_sel:[1,1] op_sel_hi:[0,0] neg_lo:[0,1] neg_hi:[1,0]" : "=v"(r) : "v"(a), "v"(b)); return r; }
__device__ __forceinline__ f32x2 add_irot(f32x2 a, f32x2 b) { f32x2 r; asm("v_pk_add_f32 %0, %1, %2 op_sel:[0,1] op_sel_hi:[1,0] neg_lo:[0,1]" : "=v"(r) : "v"(a), "v"(b)); return r; }
__device__ __forceinline__ f32x2 sub_irot(f32x2 a, f32x2 b) { f32x2 r; asm("v_pk_add_f32 %0, %1, %2 op_sel:[0,1] op_sel_hi:[1,0] neg_hi:[0,1]" : "=v"(r) : "v"(a), "v"(b)); return r; }
__device__ __forceinline__ f32x2 rot_mi(f32x2 a) { f32x2 r; asm("v_pk_add_f32 %0, %1, 0 op_sel:[1,0] op_sel_hi:[0,0] neg_hi:[1,0]" : "=v"(r) : "v"(a)); return r; }
template <bool INV> __device__ __forceinline__ f32x2 tw16(f32x2 x, int r16, f32x2 K1, f32x2 K2, f32x2 K3) {
    const f32x2 K = (r16 == 1 || r16 == 7) ? K1 : (r16 == 2 || r16 == 6) ? K2 : K3;
    return r16 > 4 ? cmulk<true, !INV>(x, K) : cmulk<false, !INV>(x, K);
}
template <int RR, int LGM, bool INVERSE, bool ZHI = false, bool HALFOUT = false>
__device__ __forceinline__ void fft_pass(LAS f32x2* cx, int tid) {
    constexpr int NP = 1 << RR, mlast = 1 << LGM;
    static_assert((LGM == 10 || LGM == 6 || LGM == 2) ? RR == 4 : (LGM == 0 && RR == 2), "pass shapes with a closed-form swizzled address");
    const f32x2 K1 = (f32x2){0.92387953251128674f, 0.38268343236508977f}, K2 = (f32x2){0.70710678118654752f, 0.70710678118654752f}, K3 = (f32x2){0.38268343236508977f, 0.92387953251128674f};
#pragma unroll 1
    for (int it = tid; it < (FN >> RR); it += 512) {
        const int lo = it & (mlast - 1), hi = it >> LGM;
        int pb;
        if (LGM == 10) pb = swz(lo);
        else if (LGM == 6) pb = (hi << 10) + (lo ^ ((lo >> 4) & 3));
        else if (LGM == 2) pb = (hi << 6) + lo + (((hi & 1) | ((((hi >> 1) ^ (hi >> 2)) & 1) << 1) | (((hi >> 1) & 1) << 2)) << 2);
        else pb = swz(4 * ((it & ~48) | ((it & 16) << 1) | ((it & 32) >> 1)));
#define FFT_CK6(k) ((((k) & 1) << 2) | (((((k) >> 1) ^ ((k) >> 2)) & 1) << 3) | ((((k) >> 1) & 1) << 4))
#define FFT_ADDR(k) (LGM == 10 ? pb + ((k) << 10) : LGM == 6 ? (pb ^ FFT_CK6(k)) + ((k) << 6) : LGM == 2 ? (pb ^ (((k) << 2) | (((k) >> 2) & 3))) : (pb ^ (k)))
        f32x2 x[NP];
#pragma unroll
        for (int k = 0; k < NP; ++k) { if (ZHI && k >= NP / 2) x[k] = (f32x2){0.f, 0.f}; else x[k] = cx[FFT_ADDR(k)]; }
        f32x2 w[NP];
        if (LGM > 0) {
            const float fr = (float)lo * (1.0f / (float)(NP * mlast));
            float cs = __builtin_amdgcn_cosf(fr), sn = __builtin_amdgcn_sinf(INVERSE ? fr : -fr);
            asm volatile("s_nop 1" : "+v"(cs), "+v"(sn));
            w[1] = (f32x2){cs, sn};
#pragma unroll
            for (int r = 2; r < NP; ++r) w[r] = (r & 1) == 0 ? cmul(w[r >> 1], w[r >> 1]) : cmul(w[r - 1], w[1]);
        }
        if (INVERSE && LGM > 0) {
#pragma unroll
            for (int k = 1; k < NP; ++k) x[k] = cmul(x[k], w[brev_c(k, RR)]);
        }
        if (!INVERSE) {
#pragma unroll
            for (int hs = NP >> 1; hs >= 1; hs >>= 1) {
#pragma unroll
                for (int k0 = 0; k0 < NP; ++k0) { if (k0 & hs) continue; const int k1 = k0 + hs;
                    const int r16 = (k0 & (hs - 1)) * (8 / hs);
                    const f32x2 a = x[k0], b = x[k1];
                    if (ZHI && hs == NP / 2) {
                        if (r16 == 0) x[k1] = a; else if (r16 == 4) x[k1] = rot_mi(a); else x[k1] = tw16<false>(a, r16, K1, K2, K3);
                    } else {
                        x[k0] = a + b;
                        if (r16 == 0) x[k1] = a - b; else if (r16 == 4) x[k1] = dif_sub_rot(a, b); else x[k1] = tw16<false>(a - b, r16, K1, K2, K3);
                    } }
            }
        } else {
#pragma unroll
            for (int hs = 1; hs < NP; hs <<= 1) {
#pragma unroll
                for (int k0 = 0; k0 < NP; ++k0) { if (k0 & hs) continue; const int k1 = k0 + hs;
                    const int r16 = (k0 & (hs - 1)) * (8 / hs);
                    const f32x2 a = x[k0], b = x[k1];
                    if (r16 == 4) { x[k0] = add_irot(a, b); x[k1] = sub_irot(a, b); }
                    else { const f32x2 bt = r16 == 0 ? b : tw16<true>(b, r16, K1, K2, K3); x[k0] = a + bt; x[k1] = a - bt; } }
            }
        }
        if (!INVERSE && LGM > 0) {
#pragma unroll
            for (int k = 1; k < NP; ++k) x[k] = cmul(x[k], w[brev_c(k, RR)]);
        }
#pragma unroll
        for (int k = 0; k < NP; ++k) { if (HALFOUT && k >= NP / 2) continue; cx[FFT_ADDR(k)] = x[k]; }
#undef FFT_ADDR
#undef FFT_CK6
    }
}
__device__ __forceinline__ int fft_mid_item(int tid, int jj) {
    const int lp = (tid & 15) | ((tid & 16) << 1) | ((tid & 32) >> 1);
    return (((tid >> 6) + 8 * (jj >> 2)) << 8) + ((jj & 3) << 6) + lp;
}
constexpr int KFS = 2052;
__device__ __forceinline__ bool fft_kf_mirrored(int it) { return (it & 1) != 0 && it != 1; }
__device__ __forceinline__ int fft_kf_index(int it) {
    const int itp = (int)(__brev((unsigned)((4096 - (int)(__brev((unsigned)it) >> 20)) & 4095)) >> 20);
    return (it & 1) ? (it == 1 ? 2048 : itp >> 1) : it >> 1;
}
__device__ __forceinline__ void fft_kf_load(const u32x4* kf  , int tid, u32x4 (&kq)[8]) {
#pragma unroll
    for (int jj = 0; jj < 8; ++jj) kq[jj] = kf[fft_kf_index(fft_mid_item(tid, jj))];
}
__device__ __forceinline__ f32x2 h2f(unsigned v) { const f16x2 h = __builtin_bit_cast(f16x2, v); return (f32x2){(float)h[0], (float)h[1]}; }
__device__ __forceinline__ void fft_mid_mul(LAS f32x2* cx, const u32x4 (&kq)[8], int tid) {
#pragma unroll
    for (int jj = 0; jj < 8; ++jj) { const int it = fft_mid_item(tid, jj);
        const int pb = swz(4 * it);
        const f32x2 x0 = cx[pb], x1 = cx[pb ^ 1], x2 = cx[pb ^ 2], x3 = cx[pb ^ 3];
        const f32x2 a0 = x0 + x2, b0 = x0 - x2, a1 = x1 + x3, b1 = dif_sub_rot(x1, x3);
        f32x2 y0 = a0 + a1, y1 = a0 - a1, y2 = b0 + b1, y3 = b0 - b1;
        { const bool mir = fft_kf_mirrored(it); const unsigned cj = mir ? 0x80000000u : 0u;
          const unsigned k0 = (mir ? kq[jj][3] : kq[jj][0]) ^ cj, k1 = (mir ? kq[jj][2] : kq[jj][1]) ^ cj, k2 = (mir ? kq[jj][1] : kq[jj][2]) ^ cj, k3 = (mir ? kq[jj][0] : kq[jj][3]) ^ cj;
          y0 = cmul(y0, h2f(k0)); y1 = cmul(y1, h2f(k1)); y2 = cmul(y2, h2f(k2)); y3 = cmul(y3, h2f(k3)); }
        const f32x2 z0 = y0 + y1, z1 = y0 - y1, z2 = y2 + y3, z3 = y2 - y3;
        cx[pb] = z0 + z2; cx[pb ^ 1] = add_irot(z1, z3); cx[pb ^ 2] = z0 - z2; cx[pb ^ 3] = sub_irot(z1, z3);
    }
}
__device__ __forceinline__ void fft_forward(LAS f32x2* cx, int tid) {
    fft_pass<4, 10, false>(cx, tid); __syncthreads(); fft_pass<4, 6, false>(cx, tid); fft_pass<4, 2, false>(cx, tid); __syncthreads();
    fft_pass<2, 0, false>(cx, tid); __syncthreads();
}
__device__ __forceinline__ void fft_conv(LAS f32x2* cx, const u32x4* kf, int tid) {
    fft_pass<4, 10, false, true>(cx, tid); __syncthreads();
    u32x4 kq[8]; fft_kf_load(kf, tid, kq);
    fft_pass<4, 6, false>(cx, tid); fft_pass<4, 2, false>(cx, tid);
    fft_mid_mul(cx, kq, tid);
    fft_pass<4, 2, true>(cx, tid); fft_pass<4, 6, true>(cx, tid); __syncthreads();
}
__device__ __forceinline__ void fft_conv_tail(LAS f32x2* cx, int tid) {
    fft_pass<4, 10, true, false, true>(cx, tid); __syncthreads();
}
__device__ __forceinline__ float block_sum(const Ctx& C, float v, LAS float* scr  ) {
    v = wave_sum(v);
    __syncthreads();
    if (C.lane == 0) scr[C.wave] = v;
    __syncthreads();
    float s = 0.f;
#pragma unroll
    for (int w = 0; w < 8; ++w) s += scr[w];
    return s;
}
__device__ __forceinline__ float hy_delta(int c) {
    const float mind = -4.605170185988091f / 1.5f, maxd = -4.605170185988091f / 0.3f;
    return fabsf(mind + (float)c * ((maxd - mind) / 1023.0f));
}
__device__ __forceinline__ void phase_filter_spectra(const Ctx& C) {
    LAS f32x2* cx = (LAS f32x2*)C.lds;
    LAS float* w3c = (LAS float*)(C.lds + MISC_OFF + 256);
    LAS float* red = (LAS float*)(C.lds + MISC_OFF + 256 + 1024);
    const f16* FT = (const f16*)(C.ws + WS_FTL);
    unsigned* KF = (unsigned*)(C.ws + WS_BIG);
    for (int c = C.bid; c < 1024; c += C.G) {
        int tid = C.tid; asm volatile("" : "+v"(tid));
        __syncthreads();
        const float dl = hy_delta(c);
        float ss0 = 0.f, ss1 = 0.f;
        const int skw = ((C.bid * 37) & 127) * 64;
        const f16* f0 = FT + (size_t)c * T; const f16* f1 = f0 + (size_t)1024 * T; const f16* f2 = f0 + (size_t)2048 * T; const f16* f3 = f0 + (size_t)3072 * T;
#pragma unroll 4
        for (int jj = 0; jj < 8; ++jj) {
            const int t2 = 2 * ((jj * 512 + tid + (skw >> 1)) & 4095);
            const f16x2 h0 = __builtin_bit_cast(f16x2, __builtin_nontemporal_load((const unsigned*)(f0 + t2))), h1 = __builtin_bit_cast(f16x2, __builtin_nontemporal_load((const unsigned*)(f1 + t2))),
                        h2 = __builtin_bit_cast(f16x2, __builtin_nontemporal_load((const unsigned*)(f2 + t2))), h3 = __builtin_bit_cast(f16x2, __builtin_nontemporal_load((const unsigned*)(f3 + t2)));
#pragma unroll
            for (int q = 0; q < 2; ++q) { const int t = t2 + q;
                const float dec = expf(-((float)t / 8191.0f) * dl);
                const f32x4 a = (f32x4){(float)h0[q], (float)h1[q], (float)h2[q], (float)h3[q]} * dec;
                cx[swz(t)] = (f32x2){a[0], a[2]};
                if (t >= 1) { cx[swz(FN - t)] = (f32x2){a[1], a[3]}; ss0 += a[1] * a[1]; ss1 += a[3] * a[3]; }
                else cx[swz(8192)] = (f32x2){0.f, 0.f};
                ss0 += a[0] * a[0]; ss1 += a[2] * a[2]; }
        }
        const float n0 = 1.0f / sqrtf(block_sum(C, ss0, red) + NORM_EPS);
        const float n1 = 1.0f / sqrtf(block_sum(C, ss1, red) + NORM_EPS);
        __syncthreads();
        fft_forward(cx, tid);
        for (int jj = 0; jj < 17; ++jj) {
            const int qn = jj * 512 + tid; if (qn >= 8196) break;
            const int p = qn < 8192 ? ((qn >> 2) << 3) + (qn & 3) : 4 + (qn & 3); const int f = (int)(__brev((unsigned)p) >> 18); const int p2 = (int)(__brev((unsigned)((FN - f) & (FN - 1))) >> 18);
            const f32x2 va = cx[swz(p)], vb = cx[swz(p2)]; const float ar = va[0], ai = va[1], br = vb[0], bi = -vb[1];
            KF[((size_t)0 * 1024 + c) * (KFS * 4) + qn] = pkh(0.5f * (ar + br) * n0, 0.5f * (ai + bi) * n0);
            KF[((size_t)1 * 1024 + c) * (KFS * 4) + qn] = pkh(0.5f * (ai - bi) * n1, -0.5f * (ar - br) * n1);
        }
    }
}
__device__ __forceinline__ float short_conv(const f16* col, int t, int len, float w0, float w1, float w2, float bs) {
    const float lm = (float)col[max(t - 1, 0)], p0 = (float)col[t], lp = (float)col[min(t + 1, len - 1)];
    const float pm = t > 0 ? lm : 0.f, pp = t + 1 < len ? lp : 0.f;
    return pm * w0 + p0 * w1 + pp * w2 + bs;
}
__device__ __forceinline__ void short_conv8(const f16* col, int t0, float w0, float w1, float w2, float bs, float (&o)[8]) {
    const u32x4 m = *(const u32x4*)(col + t0);
    const float lm = (float)col[max(t0 - 1, 0)], rp = (float)col[min(t0 + 8, T - 1)];
    float x[8]; unpack8(m, x);
    const float left = t0 > 0 ? lm : 0.f, right = t0 + 8 < T ? rp : 0.f;
#pragma unroll
    for (int i = 0; i < 8; ++i) { const float pv = i ? x[i > 0 ? i - 1 : 0] : left, nx = i < 7 ? x[i < 7 ? i + 1 : 7] : right; o[i] = pv * w0 + x[i] * w1 + nx * w2 + bs; }
}
struct Raw8 { u32x4 ma, mb; f16 la, ra, lb, rb; };
__device__ __forceinline__ Raw8 sc_load(const f16* cola, const f16* colb, int t0) {
    Raw8 r; r.ma = __builtin_nontemporal_load((const u32x4*)(cola + t0)); r.mb = __builtin_nontemporal_load((const u32x4*)(colb + t0));
    r.la = cola[max(t0 - 1, 0)]; r.ra = cola[min(t0 + 8, T - 1)]; r.lb = colb[max(t0 - 1, 0)]; r.rb = colb[min(t0 + 8, T - 1)];
    return r;
}
__device__ __forceinline__ void sc_compute(const Raw8& r, int t0, float w0, float w1, float w2, float bs, f32x2 (&o)[8]) {
    float xa[8], xb[8]; unpack8(r.ma, xa); unpack8(r.mb, xb);
    f32x2 x[8];
#pragma unroll
    for (int i = 0; i < 8; ++i) x[i] = (f32x2){xa[i], xb[i]};
    const f32x2 left = t0 > 0 ? (f32x2){(float)r.la, (float)r.lb} : (f32x2){0.f, 0.f}, right = t0 + 8 < T ? (f32x2){(float)r.ra, (float)r.rb} : (f32x2){0.f, 0.f};
#pragma unroll
    for (int i = 0; i < 8; ++i) { const f32x2 pv = i ? x[i > 0 ? i - 1 : 0] : left, nx = i < 7 ? x[i < 7 ? i + 1 : 7] : right; o[i] = pv * w0 + x[i] * w1 + nx * w2 + bs; }
}
struct HcPre { float w[3][3], bsv[3], bias0, bias1; Raw8 rv[2]; };
__device__ __forceinline__ void hc_prefetch(HcPre& P, const Ctx& C, int u, int tid, int skq) {
    const f16* PT = (const f16*)(C.ws + WS_P);
    const float* sw = C.in[IN_B_SW]; const float* sb = C.in[IN_B_SB]; const float* fb = C.in[IN_B_BIAS];
    const int c = u >> 1, bp = u & 1;
#pragma unroll
    for (int s = 0; s < 3; ++s) { P.bsv[s] = sb[s * 1024 + c];
#pragma unroll
        for (int k = 0; k < 3; ++k) P.w[s][k] = sw[k * 3072 + s * 1024 + c]; }
    P.bias0 = fb[c]; P.bias1 = fb[1024 + c];
    const f16* cv0 = PT + ((size_t)(2 * bp) * 3072 + c) * T; const f16* cv1 = PT + ((size_t)(2 * bp + 1) * 3072 + c) * T;
#pragma unroll
    for (int jj = 0; jj < 2; ++jj) P.rv[jj] = sc_load(cv0, cv1, 8 * ((jj * 512 + tid + skq) & 1023));
}
__device__ __forceinline__ void phase_hyena_conv(const Ctx& C, bool need_ctx) {
    LAS f32x2* cx = (LAS f32x2*)C.lds;
    const f16* PT = (const f16*)(C.ws + WS_P); const f16* PTC = PT + (size_t)NB * 3072 * T;
    f16* ZT = (f16*)(C.ws + WS_ZT); f16* ZTC = ZT + (size_t)NB * 1024 * T;
    const u32x4* KF = (const u32x4*)(C.ws + WS_BIG);
    const float* sw = C.in[IN_B_SW]; const float* sb = C.in[IN_B_SB]; const float* fb = C.in[IN_B_BIAS];
    const int nbig = 2048, nunits = nbig + (need_ctx ? 1024 : 0);
    const int skq = ((C.bid * 37) & 31) << 5;
    HcPre cur;
    { int tid = C.tid; asm volatile("" : "+v"(tid)); hc_prefetch(cur, C, min(C.bid, nbig - 1), tid, skq); }
    for (int u = C.bid; u < nunits; u += C.G) {
        int tid = C.tid; asm volatile("" : "+v"(tid));
        __syncthreads();
        if (u < nbig) {
            const int c = u >> 1, bp = u & 1;
            float w[3][3], bsv[3];
#pragma unroll
            for (int s = 0; s < 3; ++s) { bsv[s] = cur.bsv[s];
#pragma unroll
                for (int k = 0; k < 3; ++k) w[s][k] = cur.w[s][k]; }
            const float bias0 = cur.bias0, bias1 = cur.bias1;
            const f16* colv[2]; const f16* colx1[2]; const f16* colx2[2];
#pragma unroll
            for (int bi = 0; bi < 2; ++bi) { const int b = 2 * bp + bi; colv[bi] = PT + ((size_t)b * 3072 + c) * T; colx1[bi] = PT + ((size_t)b * 3072 + 1024 + c) * T; colx2[bi] = PT + ((size_t)b * 3072 + 2048 + c) * T; }
            const float invn = 1.0f / (float)FN;
            int t0s[2], pbs[2];
#pragma unroll
            for (int jj = 0; jj < 2; ++jj) { t0s[jj] = 8 * ((jj * 512 + tid + skq) & 1023); pbs[jj] = swz(t0s[jj]); }
            Raw8 rv[2], rx1[2], rx2[2];
#pragma unroll
            for (int jj = 0; jj < 2; ++jj) rv[jj] = cur.rv[jj];
            unsigned vh[2][8], z1h[2][8];
#pragma unroll
            for (int jj = 0; jj < 2; ++jj) { f32x2 v[8]; sc_compute(rv[jj], t0s[jj], w[0][0], w[0][1], w[0][2], bsv[0], v);
#pragma unroll
                for (int i = 0; i < 8; ++i) { cx[pbs[jj] ^ i] = v[i]; vh[jj][i] = pkh(v[i][0], v[i][1]); } }
            __syncthreads();
            fft_conv(cx, KF + ((size_t)0 * 1024 + c) * KFS, tid);
#pragma unroll
            for (int jj = 0; jj < 2; ++jj) rx1[jj] = sc_load(colx1[0], colx1[1], t0s[jj]);
            fft_conv_tail(cx, tid);
#pragma unroll
            for (int jj = 0; jj < 2; ++jj) { f32x2 x1[8]; sc_compute(rx1[jj], t0s[jj], w[1][0], w[1][1], w[1][2], bsv[1], x1);
#pragma unroll
                for (int i = 0; i < 8; ++i) { const f32x2 z1 = x1[i] * (cx[pbs[jj] ^ i] * invn + bias0 * h2f(vh[jj][i])); cx[pbs[jj] ^ i] = z1; z1h[jj][i] = pkh(z1[0], z1[1]); } }
            __syncthreads();
            fft_conv(cx, KF + ((size_t)1 * 1024 + c) * KFS, tid);
#pragma unroll
            for (int jj = 0; jj < 2; ++jj) rx2[jj] = sc_load(colx2[0], colx2[1], t0s[jj]);
            fft_conv_tail(cx, tid);
            hc_prefetch(cur, C, min(u + C.G, nbig - 1), tid, skq);
            f16* za = ZT + ((size_t)(2 * bp) * 1024 + c) * T; f16* zb = ZT + ((size_t)(2 * bp + 1) * 1024 + c) * T;
#pragma unroll
            for (int jj = 0; jj < 2; ++jj) { f32x2 x2[8]; sc_compute(rx2[jj], t0s[jj], w[2][0], w[2][1], w[2][2], bsv[2], x2);
                float oa[8], ob[8];
#pragma unroll
                for (int i = 0; i < 8; ++i) { const f32x2 o = x2[i] * (cx[pbs[jj] ^ i] * invn + bias1 * h2f(z1h[jj][i])) * ZSCALE; oa[i] = o[0]; ob[i] = o[1]; }
                *(u32x4*)(za + t0s[jj]) = pack8(oa, 1.0f); *(u32x4*)(zb + t0s[jj]) = pack8(ob, 1.0f); }
        } else {
            const int c = u - nbig;
            LAS float* w3c = (LAS float*)C.lds;
            LAS float* kk = w3c + 256;
            LAS float* zz = kk + 1088;
            LAS float* red = zz + 1024;
            const float* FTC = (const float*)(C.ws + WS_FTC);
            float ss0 = 0.f, ss1 = 0.f; f32x4 a = (f32x4){0.f, 0.f, 0.f, 0.f};
            if (tid < 256) { const int t = tid;
                a = (f32x4){FTC[(size_t)c * NCX + t], FTC[(size_t)(1024 + c) * NCX + t], FTC[(size_t)(2048 + c) * NCX + t], FTC[(size_t)(3072 + c) * NCX + t]};
                a = a * expf(-((float)t / 255.0f) * hy_delta(c));
                ss0 = a[0] * a[0] + (t >= 1 ? a[1] * a[1] : 0.f); ss1 = a[2] * a[2] + (t >= 1 ? a[3] * a[3] : 0.f); }
            const float n0 = 1.0f / sqrtf(block_sum(C, ss0, red) + NORM_EPS);
            const float n1 = 1.0f / sqrtf(block_sum(C, ss1, red) + NORM_EPS);
            __syncthreads();
#define KKI(i) ((i) + ((i) >> 5))
            if (tid < 256) { const int t = tid; kk[KKI(255 + t)] = a[0] * n0; kk[544 + KKI(255 + t)] = a[2] * n1; if (t >= 1) { kk[KKI(255 - t)] = a[1] * n0; kk[544 + KKI(255 - t)] = a[3] * n1; } }
            float w[3][3], bsv[3];
#pragma unroll
            for (int s = 0; s < 3; ++s) { bsv[s] = sb[s * 1024 + c];
#pragma unroll
                for (int k = 0; k < 3; ++k) w[s][k] = sw[k * 3072 + s * 1024 + c]; }
            const int cb = (tid >> 6) & 3, t0 = (tid & 63) * 4; const bool act = tid < 256;
            float vv[4], x1v[4], x2v[4], z1[4];
#pragma unroll
            for (int i = 0; i < 4; ++i) { const int t = t0 + i;
                vv[i] = short_conv(PTC + ((size_t)cb * 3072 + c) * NCX, t, NCX, w[0][0], w[0][1], w[0][2], bsv[0]);
                x1v[i] = short_conv(PTC + ((size_t)cb * 3072 + 1024 + c) * NCX, t, NCX, w[1][0], w[1][1], w[1][2], bsv[1]);
                x2v[i] = short_conv(PTC + ((size_t)cb * 3072 + 2048 + c) * NCX, t, NCX, w[2][0], w[2][1], w[2][2], bsv[2]);
                if (act) zz[cb * 256 + t] = vv[i]; }
            __syncthreads();
#define CTX_CONV4(y, kbase) { float w0_ = kk[(kbase) + KKI(255 + t0)], w1_ = kk[(kbase) + KKI(256 + t0)], w2_ = kk[(kbase) + KKI(257 + t0)], w3_ = kk[(kbase) + KKI(258 + t0)]; \
                y[0] = 0.f; y[1] = 0.f; y[2] = 0.f; y[3] = 0.f; \
                _Pragma("unroll 8") for (int s_ = 0; s_ < 256; ++s_) { const float zv_ = zz[cb * 256 + s_]; const float nw_ = kk[(kbase) + KKI(max(254 + t0 - s_, 0))]; \
                    y[0] += zv_ * w0_; y[1] += zv_ * w1_; y[2] += zv_ * w2_; y[3] += zv_ * w3_; w3_ = w2_; w2_ = w1_; w1_ = w0_; w0_ = nw_; } }
            float y[4];
            if (act) { CTX_CONV4(y, 0)
#pragma unroll
                for (int i = 0; i < 4; ++i) z1[i] = x1v[i] * (y[i] + fb[c] * vv[i]); }
            __syncthreads();
            if (act) {
#pragma unroll
                for (int i = 0; i < 4; ++i) zz[cb * 256 + t0 + i] = z1[i]; }
            __syncthreads();
            if (act) { CTX_CONV4(y, 544)
                float o4[4];
#pragma unroll
                for (int i = 0; i < 4; ++i) o4[i] = x2v[i] * (y[i] + fb[1024 + c] * z1[i]) * ZSCALE;
                u32x2 wv; wv.x = pkh(o4[0], o4[1]); wv.y = pkh(o4[2], o4[3]);
                *(u32x2*)(ZTC + ((size_t)cb * 1024 + c) * NCX + t0) = wv; }
#undef CTX_CONV4
#undef KKI
        }
    }
}
__device__ __forceinline__ void phase_hyena_transpose(const Ctx& C, bool need_ctx) {
    const int gw = C.bid * 8 + C.wave, NGW = C.G * 8, lane = C.lane;
    LAS f16* tile = (LAS f16*)(C.lds + C.wave * 8448);
    const f16* ZT = (const f16*)(C.ws + WS_ZT); const f16* ZTC = ZT + (size_t)NB * 1024 * T; f16* O = (f16*)(C.ws + WS_O);
    const int nl = NB * 16 * 128, ntiles = nl + (need_ctx ? NB * 16 * 4 : 0);
    for (int it = gw; it < ntiles; it += NGW) {
        const bool isc = it >= nl; const int v = isc ? it - nl : it; const int ntt = isc ? 4 : 128, len = isc ? NCX : T;
        const int b = v / (16 * ntt), cb = (v / ntt) & 15, tb = v % ntt;
        const f16* src = (isc ? ZTC : ZT) + ((size_t)b * 1024 + cb * 64) * len + tb * 64;
        const int r8 = lane >> 3, c8 = 8 * (lane & 7);
        u32x4 in[8];
#pragma unroll
        for (int j = 0; j < 8; ++j) in[j] = __builtin_nontemporal_load((const u32x4*)(src + (size_t)(8 * j + r8) * len + c8));
#pragma unroll
        for (int j = 0; j < 8; ++j) { LAS unsigned* tp = (LAS unsigned*)(tile + (8 * j + r8) * 66 + c8); tp[0] = in[j].x; tp[1] = in[j].y; tp[2] = in[j].z; tp[3] = in[j].w; }
        asm volatile("s_waitcnt lgkmcnt(0)" ::: "memory");
        f16* dst = O + ((size_t)(isc ? RL + b * NCX : b * T) + tb * 64) * D + cb * 64;
#pragma unroll
        for (int j = 0; j < 8; ++j) { const int tt = 8 * j + r8; const LAS f16* cp = tile + c8 * 66 + tt;
            f16x8 o;
#pragma unroll
            for (int i = 0; i < 8; ++i) o[i] = cp[i * 66];
            *(f16x8*)(dst + (size_t)tt * D + c8) = o; }
        asm volatile("s_waitcnt lgkmcnt(0)" ::: "memory");
    }
}

constexpr int PH_PROLOGUE = 1, PH_PER_LAYER_MAX = 11;
__host__ __device__ constexpr int layer_phases(int kind) { return kind == 1 ? 10 : 8; }
__host__ __device__ constexpr int total_phases() { int n = PH_PROLOGUE; for (int i = 0; i < DEPTH; ++i) n += layer_phases(i % 3); return n + 1; }

__global__ void __launch_bounds__(512, 2) mega(Args args) {
    extern __shared__ __attribute__((aligned(16))) unsigned char lds_raw[];
    Ctx C0;
    C0.lds = (LAS unsigned char*)lds_raw; C0.tid = threadIdx.x; C0.lane = C0.tid & 63; C0.wave = __builtin_amdgcn_readfirstlane(C0.tid >> 6); C0.G = gridDim.x; C0.bid = blockIdx.x;
    C0.in = args.in; C0.out = args.out; C0.ws = args.ws;
    volatile LAS unsigned* MISC = (volatile LAS unsigned*)(C0.lds + MISC_OFF);
    if (C0.tid < 64) MISC[C0.tid] = 0u;
    __syncthreads();
    const int lo = args.ph_lo, hi = args.ph_hi;
    XcdBarrier bar; bar.bar = (unsigned*)(C0.ws + WS_CTL); bar.x = 0; bar.st = MISC + 8;
    if (hi - lo > 1) bar = xcd_barrier_post((unsigned*)(C0.ws + WS_CTL), MISC + 8);
    int pid = 0;
#ifndef PROBE_MASK
#define PROBE_MASK 0
#endif
#ifndef PROBE_KINDS
#define PROBE_KINDS 7
#endif
#define PHASE_BEGIN_G(grp) if (lo <= pid && pid < hi) { for (int rep_ = 0; rep_ < 1 + ((((PROBE_MASK) >> (grp)) & 1) && (((PROBE_KINDS) >> pkind) & 1) ? 1 : 0); ++rep_) { Ctx C = C0; asm volatile("" : "+v"(C.tid)); C.lane = C.tid & 63; C.wave = __builtin_amdgcn_readfirstlane(C.tid >> 6); \
        { unsigned long long wsl = (unsigned long long)C.ws; asm volatile("" : "+s"(wsl)); C.ws = (unsigned char*)(__attribute__((address_space(1))) unsigned char*)wsl; }
#define PHASE_END   } if (pid + 1 < hi) xcd_barrier(bar); } ++pid;

    int pkind = 0;
    PHASE_BEGIN_G(0) phase_prologue(C); PHASE_END

    for (int layer = 0; layer < DEPTH; ++layer) {
        const int kind = layer % 3, j = layer / 3; const bool last = layer == DEPTH - 1; const bool need_ctx = !last;
        pkind = kind;
        PHASE_BEGIN_G(1) phase_pn(C, layer); PHASE_END
        PHASE_BEGIN_G(2)
            if (kind == 1) { pg8::Gemm g{(const f16*)(C.ws + WS_U), (const f16*)(C.ws + WS_WB_IN), 1024, nullptr}; pg8::StaticOrder S; S.init(R, 3072, C.G, C.bid);
                pg8::EpiTransposeF16 E{(f16*)(C.ws + WS_P), (f16*)(C.ws + WS_P) + (size_t)NB * 3072 * T}; pg8::gemm_phase(C.lds, C.tid, g, S, E); }
            else if (kind == 0) { pg8::Gemm g{(const f16*)(C.ws + WS_U), (const f16*)(C.ws + WS_WA_IN) + (size_t)j * 1536 * 1024, 1024, nullptr}; pg8::StaticOrder S; S.init(R, 1536, C.G, C.bid);
                EpiQKV<0> E{C.ws + WS_ATT, C.in[IN_A_QG] + j * 64, C.in[IN_A_KG] + j * 64, (const float*)(C.ws + WS_ROPE), need_ctx}; pg8::gemm_phase(C.lds, C.tid, g, S, E); }
            else { pg8::Gemm g{(const f16*)(C.ws + WS_U), (const f16*)(C.ws + WS_WC_IN), 1024, nullptr}; pg8::StaticOrder S; S.init(R, 3072, C.G, C.bid);
                EpiQKV<2> E{C.ws + WS_ATT, C.in[IN_C_QG], C.in[IN_C_KG], (const float*)(C.ws + WS_ROPE), need_ctx}; pg8::gemm_phase(C.lds, C.tid, g, S, E); }
            if (cv_n1(layer, C.G)) { const int rank = C.bid - (256 - cv_idle1(layer));
                if (rank >= 0) {
                    if (kind == 1) {
                        int kf = 256; asm volatile("" : "+s"(kf));
                        pg8::Gemm g{(const f16*)(C.ws + WS_H2A), (const f16*)(C.ws + WS_W3T), kf, nullptr}; pg8::StaticOrder S; S.init(T + NCX, 4096, cv_idle1(layer), rank);
                        pg8::EpiFilterT E{(f16*)(C.ws + WS_FTL), (float*)(C.ws + WS_FTC)}; pg8::gemm_phase(C.lds, C.tid, g, S, E); }
                    convert_items(C, layer, cv_n0(layer, C.G) + rank * CV_IPB1, CV_IPB1); } }
            else if (kind == 1) { int kf = 256; asm volatile("" : "+s"(kf));
                pg8::Gemm g{(const f16*)(C.ws + WS_H2A), (const f16*)(C.ws + WS_W3T), kf, nullptr}; pg8::StaticOrder S; S.init(T + NCX, 4096, C.G, C.bid);
                pg8::EpiFilterT E{(f16*)(C.ws + WS_FTL), (float*)(C.ws + WS_FTC)}; pg8::gemm_phase(C.lds, C.tid, g, S, E); }
        PHASE_END
        if (kind == 1) { PHASE_BEGIN_G(3) phase_filter_spectra(C); PHASE_END }
        PHASE_BEGIN_G(4)
            if (kind == 0) phase_attn_a(C, j, need_ctx); else if (kind == 1) phase_hyena_conv(C, need_ctx); else phase_attn_c(C, need_ctx);
        PHASE_END
        if (kind == 1) { PHASE_BEGIN_G(5) phase_hyena_transpose(C, need_ctx); PHASE_END }
        PHASE_BEGIN_G(6)
            { const f16* W = kind == 0 ? (const f16*)(C.ws + WS_WA_OUT) + (size_t)j * 1024 * 1024 : (kind == 1 ? (const f16*)(C.ws + WS_WB_OUT) : (const f16*)(C.ws + WS_WC_OUT));
              pg8::Gemm g{(const f16*)(C.ws + WS_O), W, 1024, nullptr}; pg8::StaticOrder S; S.init(need_ctx ? R : RL, 1024, C.G, C.bid);
              pg8::EpiResidual E{C.in[IN_X], C.in[IN_CTX], (f16*)(C.ws + WS_HH), layer == 0,
                                 (const float*)(C.ws + WS_MOD) + (size_t)layer * 5 * 6144 + 2 * 1024, kind == 1 ? ZUNSCALE : 1.0f};
              pg8::gemm_phase(C.lds, C.tid, g, S, E);
              if (cv_n2(layer, C.G) && C.bid >= 16) convert_items(C, layer, cv_n0(layer, C.G) + cv_n1(layer, C.G) + (C.bid - 16) * CV_IPB2, CV_IPB2); }
        PHASE_END
        PHASE_BEGIN_G(7) phase_pf(C, layer); PHASE_END
        PHASE_BEGIN_G(8) phase_topk_convert(C, layer); PHASE_END
        PHASE_BEGIN_G(10)
            { int kq = 512  ; asm volatile("" : "+s"(kq));
              pg8::Gemm g{(const f16*)(C.ws + WS_U), (const f16*)(C.ws + ((layer & 1) ? WS_WEGU2 : WS_WEGU)), kq, (const int*)(C.ws + WS_ROWIDX)}; pg8::GroupedOrder S; S.init(last ? 16 : 17, 16, C.G, C.bid); pg8::EpiSwiGLU E{C.ws + WS_BIG};
              pg8::gemm_phase<pg8::EpiSwiGLU, pg8::GroupedOrder, true, true>(C.lds, C.tid, g, S, E); }
        PHASE_END
        PHASE_BEGIN_G(11)
            { int kq = 1024  ; asm volatile("" : "+s"(kq));
              pg8::Gemm g{(const f16*)(C.ws + WS_BIG), (const f16*)(C.ws + ((layer & 1) ? WS_WED2 : WS_WED)), kq, nullptr}; pg8::GroupedOrder S; S.init(last ? 16 : 17, 4, C.G, C.bid); pg8::EpiStoreF8 E{C.ws + WS_ATT, 1024, YE_SCALE};
              pg8::gemm_phase<pg8::EpiStoreF8, pg8::GroupedOrder, false, true>(C.lds, C.tid, g, S, E);
              if (cv_n0(layer + 1, C.G) && layer + 1 < DEPTH && (C.bid >> 3) >= 8) convert_items(C, layer + 1, (((C.bid & 7) * 24) + ((C.bid >> 3) - 8)) * CV_IPB0, CV_IPB0); }
        PHASE_END
    }
    PHASE_BEGIN_G(1) phase_pn(C, DEPTH); PHASE_END
}

extern "C" void kernel_launch(void* const* d_in, const int* in_sizes, int n_in, void* d_out, int out_size, void* d_ws, size_t ws_size, hipStream_t stream) {
    static int grid = 0;
    if (grid == 0) {
        if (n_in != 34 || out_size != RL * D || ws_size < WS_END) { fprintf(stderr, "kernel_launch: unexpected problem (n_in %d, out %d, ws %zu < %zu)\n", n_in, out_size, ws_size, (size_t)WS_END); grid = -1; return; }
        int dev = 0, cus = 0;
        if (hipGetDevice(&dev) != hipSuccess || hipDeviceGetAttribute(&cus, hipDeviceAttributeMultiprocessorCount, dev) != hipSuccess) { grid = -1; return; }
        if (hipFuncSetAttribute((const void*)mega, hipFuncAttributeMaxDynamicSharedMemorySize, LDS_BYTES) != hipSuccess) { fprintf(stderr, "kernel_launch: hipFuncSetAttribute failed\n"); grid = -1; return; }
        int per_cu = 0;
        (void)hipOccupancyMaxActiveBlocksPerMultiprocessor(&per_cu, (const void*)mega, 512, LDS_BYTES);
        (void)hipGetLastError();
        grid = cus;
    }
    if (grid < 0) return;
    (void)hipMemsetAsync((char*)d_ws + WS_CTL, 0, CTL_ZERO_BYTES, stream);
    Args a{};
    for (int i = 0; i < 34; ++i) a.in[i] = (const float*)d_in[i];
    a.out = (float*)d_out; a.ws = (unsigned char*)d_ws;
    const int NPH = total_phases();
#if ONE_LAUNCH
    a.ph_lo = 0; a.ph_hi = NPH;
    hipLaunchKernelGGL(mega, dim3(grid), dim3(512), LDS_BYTES, stream, a);
#else
    for (int p = 0; p < NPH; ++p) { a.ph_lo = p; a.ph_hi = p + 1; hipLaunchKernelGGL(mega, dim3(grid), dim3(512), LDS_BYTES, stream, a); }
#endif
}
```
